# Optimizing an MI355X kernel written in HIP

```python
import jax, jax.numpy as jnp
from jax import lax
import numpy as np

D_MODEL = 1024
BATCH = 32
SEQ = 256
DEPTH = 1
DEC_BATCH = 4
DEC_SEQ = 1024
PAST_LEN = 256

GRID_W = 64
N_DIR = 2
HG_WIDTH = 512
HG_HEADS = 4
HG_DK = 128
HG_DV = HG_WIDTH // HG_HEADS
HG_CHUNK = 16
LRU_WIDTH = 512
LRU_BLOCKS = 8
LRU_BLOCK = LRU_WIDTH // LRU_BLOCKS
LRU_C = 8.0
CONV_W = 4
CONV_LEFT = 2
D_FF = 4 * D_MODEL
EPS = 1e-6
POS_BASE = 10000.0
HG_QF = N_DIR * HG_HEADS * HG_DK
SPLITS = (HG_QF, 2 * HG_QF, 2 * HG_QF + HG_WIDTH, 2 * HG_QF + 2 * HG_WIDTH,
          2 * HG_QF + 2 * HG_WIDTH + LRU_WIDTH)
IN_COLS = 2 * HG_QF + 2 * HG_WIDTH + 2 * LRU_WIDTH
MIX_WIDTH = HG_WIDTH + LRU_WIDTH

kernel_name = "hybrid_hgrn2_rglru_diffusion_step"


def rms_norm(x, gain):
    xf = x.astype(jnp.float32)
    y = xf * lax.rsqrt(jnp.mean(xf * xf, axis=-1, keepdims=True) + EPS)
    return (y * gain.astype(jnp.float32)).astype(x.dtype)


def grid_pos_embed(n_tok, dtype):
    rows = n_tok // GRID_W
    rr, cc = jnp.meshgrid(jnp.arange(rows), jnp.arange(GRID_W), indexing='ij')
    quarter = D_MODEL // 4
    omega = 1.0 / (POS_BASE ** (jnp.arange(quarter, dtype=jnp.float32) / quarter))

    def emb(pos):
        ang = pos.reshape(-1, 1).astype(jnp.float32) * omega
        return jnp.concatenate([jnp.sin(ang), jnp.cos(ang)], axis=-1)

    return jnp.concatenate([emb(rr), emb(cc)], axis=-1).astype(dtype)


def hgrn2_chunkwise(q, logf, v, s0):
    B, T, H, K = q.shape
    C = HG_CHUNK
    N = T // C
    k = -jnp.expm1(logf)
    qc, kc, vc, lf = [a.reshape(B, N, C, H, -1) for a in (q, k, v, logf)]
    b = jnp.cumsum(lf, axis=2)
    mask = jnp.tril(jnp.ones((C, C), dtype=bool))[None, None, :, :, None, None]
    rel = b[:, :, :, None] - b[:, :, None, :]
    decay = jnp.where(mask, jnp.exp(jnp.minimum(rel, 0.0)), 0.0)
    attn = jnp.einsum('bnthk,bnshk,bntshk->bnhts', qc, kc, decay)
    o_intra = jnp.einsum('bnhts,bnshv->bnthv', attn, vc)
    b_last = b[:, :, -1]
    k_dec = kc * jnp.exp(b_last[:, :, None] - b)
    d_state = jnp.einsum('bnshk,bnshv->bnhkv', k_dec, vc)
    chunk_decay = jnp.exp(b_last)

    def step(s, inp):
        dec, ds = inp
        return dec[..., None] * s + ds, s

    s_fin, s_in = lax.scan(step, s0, (jnp.moveaxis(chunk_decay, 1, 0),
                                      jnp.moveaxis(d_state, 1, 0)))
    s_in = jnp.moveaxis(s_in, 0, 1)
    o_inter = jnp.einsum('bnthk,bnhkv->bnthv', qc * jnp.exp(b), s_in)
    return (o_intra + o_inter).reshape(B, T, H, -1), s_fin


def block_diag(x, w, bias):
    xb = x.reshape(x.shape[0], x.shape[1], LRU_BLOCKS, LRU_BLOCK)
    return jnp.einsum('btnd,nde->btne', xb, w).reshape(x.shape) + bias


def rglru_scan(x, wa, ba, wx, bx, lam, h0):
    r = jax.nn.sigmoid(block_diag(x, wa, ba))
    i = jax.nn.sigmoid(block_diag(x, wx, bx))
    log_a = -LRU_C * r * jax.nn.softplus(-lam)
    a = jnp.exp(log_a)
    u = jnp.sqrt(-jnp.expm1(2.0 * log_a)) * (i * x)
    u = u.at[:, 0].add(a[:, 0] * h0)

    def comb(left, right):
        a1, b1 = left
        a2, b2 = right
        return a1 * a2, a2 * b1 + b2

    _, h = lax.associative_scan(comb, (a, u), axis=1)
    return h, h[:, -1]


def dwconv_centred(x, w, bias):
    T = x.shape[1]
    xp = jnp.pad(x, ((0, 0), (CONV_LEFT, CONV_W - 1 - CONV_LEFT), (0, 0)))
    out = bias
    for j in range(CONV_W):
        out = out + xp[:, j:j + T] * w[j]
    return out


def mixer(h, p, l, hg_s0, lru_s0):
    f32 = jnp.float32
    B, T, _ = h.shape
    proj = h @ p['w_in'][l]
    hq, hf, hi, hgate, lx, lg = jnp.split(proj, SPLITS, axis=-1)
    q = jax.nn.silu(hq.astype(f32)).reshape(B, T, N_DIR, HG_HEADS, HG_DK)
    lb = jnp.cumsum(jax.nn.softmax(p['hg_lb_logits'].astype(f32), axis=0), axis=0)[l]
    fz = hf.astype(f32).reshape(B, T, N_DIR, HG_HEADS, HG_DK)
    logf = jnp.log(lb + (1.0 - lb) * jax.nn.sigmoid(fz))
    v = hi.astype(f32).reshape(B, T, HG_HEADS, HG_DV)
    o_f, s_f = hgrn2_chunkwise(q[:, :, 0], logf[:, :, 0], v, hg_s0[:, 0])
    o_b, s_b = hgrn2_chunkwise(jnp.flip(q[:, :, 1], 1), jnp.flip(logf[:, :, 1], 1),
                               jnp.flip(v, 1), hg_s0[:, 1])
    o = o_f + jnp.flip(o_b, 1)
    o = rms_norm(o, p['hg_norm_gain'][l]) * jax.nn.silu(hgate.astype(f32)).reshape(B, T, HG_HEADS, HG_DV)
    hg_out = o.reshape(B, T, HG_WIDTH)
    xc = dwconv_centred(lx.astype(f32), p['conv_w'][l].astype(f32), p['conv_b'][l].astype(f32))
    h_f, e_f = rglru_scan(xc, p['lru_wa'][l, 0].astype(f32), p['lru_ba'][l, 0].astype(f32),
                          p['lru_wx'][l, 0].astype(f32), p['lru_bx'][l, 0].astype(f32),
                          p['lru_lambda'][l, 0].astype(f32), lru_s0[:, 0])
    h_b, e_b = rglru_scan(jnp.flip(xc, 1), p['lru_wa'][l, 1].astype(f32), p['lru_ba'][l, 1].astype(f32),
                          p['lru_wx'][l, 1].astype(f32), p['lru_bx'][l, 1].astype(f32),
                          p['lru_lambda'][l, 1].astype(f32), lru_s0[:, 1])
    lru_out = (h_f + jnp.flip(h_b, 1)) * jax.nn.gelu(lg.astype(f32))
    mix = jnp.concatenate([hg_out, lru_out], axis=-1).astype(h.dtype) @ p['w_out'][l]
    return mix, jnp.stack([s_f, s_b], axis=1), jnp.stack([e_f, e_b], axis=1)


def run_trunk(x, cond, p, hg_init, lru_init):
    hg_fin, lru_fin = [], []
    for l in range(DEPTH):
        m = (jax.nn.silu(cond.astype(jnp.float32)) @ p['w_ada'][l].astype(jnp.float32)
             + p['b_ada'][l].astype(jnp.float32))[:, None, :].astype(x.dtype)
        sh1, sc1, g1, sh2, sc2, g2 = jnp.split(m, 6, axis=-1)
        h = rms_norm(x, p['norm1_gain'][l]) * (1.0 + sc1) + sh1
        mix, s_hg, s_lru = mixer(h, p, l, hg_init[:, l].astype(jnp.float32),
                                 lru_init[:, l].astype(jnp.float32))
        x = x + g1 * mix
        h = rms_norm(x, p['norm2_gain'][l]) * (1.0 + sc2) + sh2
        ff = jnp.square(jax.nn.relu(h @ p['w_ff1'][l])) @ p['w_ff2'][l]
        x = x + g2 * ff
        hg_fin.append(s_hg)
        lru_fin.append(s_lru)
    y = rms_norm(x, p['final_gain'])
    return y, jnp.stack(hg_fin, axis=1), jnp.stack(lru_fin, axis=1)


def setup_inputs(seed: int = 0) -> dict:
    key = jax.random.key(seed)
    ks = jax.random.split(key, 26)

    def nrm(k, shape, s):
        return jax.random.normal(k, shape, jnp.float32) * s

    a8 = jax.random.uniform(ks[20], (DEPTH, N_DIR, LRU_WIDTH), jnp.float32, minval=0.9, maxval=0.999)
    a = a8 ** (1.0 / LRU_C)
    lam = jnp.log(a) - jnp.log1p(-a)
    return {
        'x_prompt': nrm(ks[0], (BATCH, SEQ, D_MODEL), 1.0),
        'x_sample': nrm(ks[1], (DEC_BATCH, DEC_SEQ, D_MODEL), 1.0),
        'c': nrm(ks[2], (DEC_BATCH, D_MODEL), 1.0),
        'state_hgrn': nrm(ks[3], (DEC_BATCH, DEPTH, N_DIR, HG_HEADS, HG_DK, HG_DV), 0.3),
        'state_rglru': nrm(ks[4], (DEC_BATCH, DEPTH, N_DIR, LRU_WIDTH), 0.5),
        'c_ctx': nrm(ks[5], (D_MODEL,), 1.0),
        'w_ada': nrm(ks[6], (DEPTH, D_MODEL, 6 * D_MODEL), 0.5 * D_MODEL ** -0.5),
        'b_ada': nrm(ks[7], (DEPTH, 6 * D_MODEL), 0.02),
        'norm1_gain': 1.0 + nrm(ks[8], (DEPTH, D_MODEL), 0.02),
        'norm2_gain': 1.0 + nrm(ks[9], (DEPTH, D_MODEL), 0.02),
        'w_in': nrm(ks[10], (DEPTH, D_MODEL, IN_COLS), D_MODEL ** -0.5),
        'hg_lb_logits': nrm(ks[11], (DEPTH + 1, N_DIR, HG_HEADS, HG_DK), 0.5),
        'hg_norm_gain': 1.0 + nrm(ks[12], (DEPTH, HG_HEADS, HG_DV), 0.02),
        'conv_w': nrm(ks[13], (DEPTH, CONV_W, LRU_WIDTH), CONV_W ** -0.5),
        'conv_b': nrm(ks[14], (DEPTH, LRU_WIDTH), 0.02),
        'lru_wa': nrm(ks[15], (DEPTH, N_DIR, LRU_BLOCKS, LRU_BLOCK, LRU_BLOCK), LRU_BLOCK ** -0.5),
        'lru_ba': nrm(ks[16], (DEPTH, N_DIR, LRU_WIDTH), 0.02),
        'lru_wx': nrm(ks[17], (DEPTH, N_DIR, LRU_BLOCKS, LRU_BLOCK, LRU_BLOCK), LRU_BLOCK ** -0.5),
        'lru_bx': nrm(ks[18], (DEPTH, N_DIR, LRU_WIDTH), 0.02),
        'lru_lambda': lam,
        'w_out': nrm(ks[21], (DEPTH, MIX_WIDTH, D_MODEL), MIX_WIDTH ** -0.5),
        'w_ff1': nrm(ks[22], (DEPTH, D_MODEL, D_FF), D_MODEL ** -0.5),
        'w_ff2': nrm(ks[23], (DEPTH, D_FF, D_MODEL), D_FF ** -0.5),
        'final_gain': 1.0 + nrm(ks[24], (D_MODEL,), 0.02),
    }


def reference(x_prompt, x_sample, c, state_hgrn, state_rglru, c_ctx, w_ada, b_ada,
              norm1_gain, norm2_gain, w_in, hg_lb_logits, hg_norm_gain, conv_w, conv_b,
              lru_wa, lru_ba, lru_wx, lru_bx, lru_lambda, w_out, w_ff1, w_ff2, final_gain):
    p = {'w_ada': w_ada, 'b_ada': b_ada, 'norm1_gain': norm1_gain, 'norm2_gain': norm2_gain,
         'w_in': w_in, 'hg_lb_logits': hg_lb_logits, 'hg_norm_gain': hg_norm_gain,
         'conv_w': conv_w, 'conv_b': conv_b, 'lru_wa': lru_wa, 'lru_ba': lru_ba,
         'lru_wx': lru_wx, 'lru_bx': lru_bx, 'lru_lambda': lru_lambda, 'w_out': w_out,
         'w_ff1': w_ff1, 'w_ff2': w_ff2, 'final_gain': final_gain}
    bp = x_prompt.shape[0]
    hg_zero = jnp.zeros((bp, DEPTH, N_DIR, HG_HEADS, HG_DK, HG_DV), jnp.float32)
    lru_zero = jnp.zeros((bp, DEPTH, N_DIR, LRU_WIDTH), jnp.float32)
    y_prompt, hg_ctx, lru_ctx = run_trunk(x_prompt, c_ctx[None, :], p, hg_zero, lru_zero)
    new_state_hgrn = hg_ctx.astype(x_prompt.dtype)
    new_state_rglru = lru_ctx.astype(x_prompt.dtype)
    xs = x_sample + grid_pos_embed(x_sample.shape[1], x_sample.dtype)[None]
    y_sample, _, _ = run_trunk(xs, c, p, state_hgrn, state_rglru)
    return (y_prompt, y_sample, new_state_hgrn, new_state_rglru)
```

```cpp
#include <hip/hip_runtime.h>
#include <cstdio>
#include <cstdint>

#ifndef MK_N_LAUNCHES
#define MK_N_LAUNCHES 11
#endif

#define DI __device__ __forceinline__
#define GAS __attribute__((address_space(1)))
#define LAS __attribute__((address_space(3)))
typedef unsigned short bf16;
typedef unsigned v4u __attribute__((ext_vector_type(4)));
typedef unsigned v2u __attribute__((ext_vector_type(2)));
typedef float f32x2 __attribute__((ext_vector_type(2)));
typedef float f32x4 __attribute__((ext_vector_type(4)));
typedef float f32x16 __attribute__((ext_vector_type(16)));
typedef short bf16x8 __attribute__((ext_vector_type(8)));
typedef short s16x4 __attribute__((ext_vector_type(4)));
typedef __bf16 bf2_t __attribute__((ext_vector_type(2)));

DI unsigned pk2(float lo, float hi) { f32x2 v = {lo, hi}; return __builtin_bit_cast(unsigned, __builtin_convertvector(v, bf2_t)); }
DI float bflo(unsigned w) { return __uint_as_float(w << 16); }
DI float bfhi(unsigned w) { return __uint_as_float(w & 0xffff0000u); }
DI float sigm(float x) { return __builtin_amdgcn_rcpf(1.0f + __expf(-x)); }
DI float silu_f(float x) { return x * sigm(x); }
DI float gelu_tanh_f(float x) { const float u = 0.7978845608028654f * (x + 0.044715f * x * x * x); return x * sigm(2.0f * u); }
DI float wave_sum(float v) {
#pragma unroll
    for (int o = 1; o < 64; o <<= 1) v += __shfl_xor(v, o);
    return v;
}
#define LDS_WAIT() asm volatile("s_waitcnt lgkmcnt(0)" ::: "memory")
#define VM_WAIT() asm volatile("s_waitcnt vmcnt(0)" ::: "memory")

constexpr int D = 1024, NTOK = 12288, NCTX = 8192, TCTX = 256, TLAT = 1024;
constexpr int INC = 4096, DFF = 4096, NCH = NTOK / 32;
constexpr float EPS = 1e-6f;
constexpr int NWAVES = 8;

constexpr size_t MiB = 1u << 20;
constexpr size_t WS_CTL = 0, CTL_ZERO_BYTES = 64 * 1024;
constexpr size_t WS_WIN = 1 * MiB, WS_WOUT = 9 * MiB, WS_WFF1 = 11 * MiB, WS_WFF2 = 19 * MiB;
constexpr size_t WS_MOD = 27 * MiB;
constexpr size_t WS_WL = 27 * MiB + 256 * 1024;
constexpr size_t WS_ACT = 28 * MiB;
constexpr size_t WS_XS = 52 * MiB;
constexpr size_t WS_QF = 68 * MiB;
constexpr size_t WS_OF = 68 * MiB, WS_OB = 80 * MiB, WS_HF = 92 * MiB, WS_HB = 104 * MiB;
constexpr size_t WS_V = 116 * MiB;
constexpr size_t WS_GL = 128 * MiB;
constexpr size_t WS_LX = 152 * MiB;
constexpr size_t WS_QE = 164 * MiB, WS_KE = 188 * MiB;
constexpr size_t WS_KDT = 212 * MiB;
constexpr size_t WS_DEC = 236 * MiB;
constexpr size_t WS_VT = 238 * MiB;
constexpr size_t WS_HID = 68 * MiB;
constexpr size_t WS_END = 250 * MiB;

constexpr int RING_OFF = 0, RING_BYTES = 131072;
constexpr int LDSCTL_OFF = RING_BYTES;
constexpr int CT_OFF = RING_BYTES + 1024;
constexpr int LDS_BYTES = 160 * 1024;
static_assert(CT_OFF + 5 * 1024 * 4 <= LDS_BYTES, "LDS map");

#define XB_TMO      128
#define XB_XCNT(j)  (256  + 64 * (j))
#define XB_XSUB(j)  (1280 + 64 * (j))
#define XB_XGEN(j)  (2304 + 64 * (j))
#define XB_TOP      3328
#define XB_TOPGEN   3392
#define XCD_BAR_WORDS 3456
#define XB_SPIN_CAP (1u << 18)
static_assert(XCD_BAR_WORDS * 4 <= CTL_ZERO_BYTES, "barrier words inside the memset region");

DI unsigned xb_ld(unsigned* p)              { return __hip_atomic_load(p, __ATOMIC_RELAXED, __HIP_MEMORY_SCOPE_AGENT); }
DI unsigned xb_add(unsigned* p, unsigned v) { return __hip_atomic_fetch_add(p, v, __ATOMIC_RELAXED, __HIP_MEMORY_SCOPE_AGENT); }
DI unsigned xb_xcc_id() { return (unsigned)__builtin_amdgcn_s_getreg((3 << 11) | 20) & 0xFu; }
#define XB_SPIN(cond, bar) do { unsigned _sp = 0; while (cond) { __builtin_amdgcn_s_sleep(1); \
    if ((++_sp & 255u) == 0u) { if (xb_ld(&(bar)[XB_TMO])) break; if (_sp > XB_SPIN_CAP) { atomicAdd(&(bar)[XB_TMO], 1u); break; } } } } while (0)

struct XcdBarrier { unsigned* bar; unsigned x; volatile LAS unsigned* st; };

DI XcdBarrier xcd_barrier_post(unsigned* bar, volatile LAS unsigned* st) {
    XcdBarrier b; b.bar = bar; b.x = xb_xcc_id(); b.st = st;
    if (threadIdx.x == 0) (void)xb_add(&bar[XB_XCNT(b.x)], 1u);
    return b;
}
DI void xcd_barrier_complete(unsigned* bar, unsigned x, unsigned& nloc, unsigned& nx) {
    const unsigned G = gridDim.x * gridDim.y * gridDim.z;
    unsigned sum, cnt, mine, sp = 0u;
    for (;;) {
        sum = 0u; cnt = 0u; mine = 0u;
#pragma unroll
        for (unsigned j = 0; j < 16; ++j) { const unsigned c = xb_ld(&bar[XB_XCNT(j)]); sum += c; cnt += (c > 0u) ? 1u : 0u; mine = (j == x) ? c : mine; }
        if (sum == G) break;
        __builtin_amdgcn_s_sleep(1);
        if ((++sp & 255u) == 0u) { if (xb_ld(&bar[XB_TMO])) break; if (sp > XB_SPIN_CAP) { atomicAdd(&bar[XB_TMO], 1u); break; } }
    }
    nloc = mine > 0u ? mine : 1u; nx = cnt > 0u ? cnt : 1u;
}
DI void xcd_barrier(const XcdBarrier& b) {
    asm volatile("s_waitcnt vmcnt(0)" ::: "memory");
    __syncthreads();
    if (threadIdx.x == 0) {
        unsigned* bar = b.bar;
        __builtin_amdgcn_s_waitcnt(0);
        unsigned nloc = b.st[0], nx = b.st[1];
        if (nloc == 0u) { xcd_barrier_complete(bar, b.x, nloc, nx); b.st[0] = nloc; b.st[1] = nx; }
        const unsigned old = xb_add(&bar[XB_XSUB(b.x)], 1u);
        const unsigned gen = old / nloc;
        if (old + 1u == (gen + 1u) * nloc) {
            __builtin_amdgcn_fence(__ATOMIC_RELEASE, "agent");
            asm volatile("s_waitcnt vmcnt(0)" ::: "memory");
            const unsigned og = xb_add(&bar[XB_TOP], 1u);
            const unsigned tg = og / nx;
            if (og + 1u == (tg + 1u) * nx) xb_add(&bar[XB_TOPGEN], 1u);
            else XB_SPIN(xb_ld(&bar[XB_TOPGEN]) == tg, bar);
            __builtin_amdgcn_fence(__ATOMIC_ACQUIRE, "agent");
            xb_add(&bar[XB_XGEN(b.x)], 1u);
            asm volatile("s_waitcnt vmcnt(0)" ::: "memory");
        } else {
            XB_SPIN(xb_ld(&bar[XB_XGEN(b.x)]) == gen, bar);
            __builtin_amdgcn_fence(__ATOMIC_ACQUIRE, "agent");
            asm volatile("s_waitcnt vmcnt(0)" ::: "memory");
        }
    }
    __syncthreads();
}

namespace pg8 {
#define PG8_LAS __attribute__((address_space(3)))
typedef unsigned short bf16_t;
typedef short bf16x8 __attribute__((ext_vector_type(8)));
typedef float f32x4 __attribute__((ext_vector_type(4)));
typedef unsigned u32x4 __attribute__((ext_vector_type(4)));
constexpr int BM = 256, BK = 64, HALF = 128, HTB = HALF * BK * 2  , STAGE_BYTES = 8 * HTB, NXCD = 8, WGM = 8;

__host__ __device__ __forceinline__ int lds_byte(int r, int c) { const int st = (r >> 4) * 2 + (c >> 5), rr = r & 15, cc = c & 31, ob = rr * 64 + cc * 2; return st * 1024 + (ob ^ (((ob >> 9) & 1) << 5)); }
__host__ __device__ __forceinline__ void stage_rc(int b, int& R, int& C) { const int st = b / 1024, sb = b % 1024, swz = sb ^ (((sb >> 9) & 1) << 5); R = (st >> 1) * 16 + swz / 64; C = (st & 1) * 32 + (swz % 64) / 2; }
__host__ __device__ __forceinline__ int perm32(int rho) { const int n = rho >> 4, i = rho & 15; return 8 * (i >> 2) + 4 * n + (i & 3); }

struct Unit { int pm, pn; };
struct Gemm { const bf16_t* A; const bf16_t* Bt; int M, N, K; };

struct StaticOrder {
    int nM, nN, nwg, G, c;
    __host__ __device__ void init(int M, int N, int G_, int c_) { nM = M / BM; nN = N / BM; nwg = nM * nN; G = G_; c = c_; }
    __host__ __device__ bool next(int i, Unit& u) const {
        const long L = (long)i * G + c; if (L >= nwg) return false;
        int wgid = (int)L; { const int q = nwg / NXCD, r = nwg % NXCD, xcd = wgid % NXCD, off = wgid / NXCD; wgid = (xcd < r ? xcd * (q + 1) : r * (q + 1) + (xcd - r) * q) + off; }
        const int nig = WGM * nN, gid = wgid / nig, fm = gid * WGM, gsz = (nM - fm) < WGM ? (nM - fm) : WGM;
        u.pm = fm + ((wgid % nig) % gsz); u.pn = (wgid % nig) / gsz; return true;
    }
    __device__ __forceinline__ void a_ready(const Unit&) const {}
    __device__ __forceinline__ void done(const Unit&) const {}
};

__device__ __forceinline__ unsigned cvt_pk_bf16(float lo, float hi) { return pk2(lo, hi); }
__device__ __forceinline__ int cond_of_pm(int pm) { return pm < 32 ? 0 : 1 + ((pm - 32) >> 2); }

struct EpiRoute {
    static constexpr bool PERM = true, AFTER_DRAIN = false;
    bf16_t *QF, *V, *GL, *LX;
    __device__ __forceinline__ void operator()(const f32x4 (&acc)[2][2][4][2], const Unit& u, int wr, int wc, int fr, int fq) const {
        const int pn = u.pn; bf16_t* base; int ldc, colt;
        if (pn < 8) { base = QF; ldc = 2048; colt = pn * 256; }
        else if (pn < 10) { base = V; ldc = 512; colt = (pn - 8) * 256; }
        else if (pn < 12) { base = GL; ldc = 1024; colt = (pn - 10) * 256; }
        else if (pn < 14) { base = LX; ldc = 512; colt = (pn - 12) * 256; }
        else { base = GL; ldc = 1024; colt = 512 + (pn - 14) * 256; }
        const int row0 = u.pm * BM + wr * 64 + fr, col0 = colt + wc * 32 + 8 * fq;
#pragma unroll
        for (int ai = 0; ai < 2; ++ai)
#pragma unroll
            for (int m = 0; m < 4; ++m) { bf16_t* rowp = base + (size_t)(row0 + ai * HALF + m * 16) * ldc + col0;
#pragma unroll
                for (int bj = 0; bj < 2; ++bj) { const f32x4 v0 = acc[ai][bj][m][0], v1 = acc[ai][bj][m][1];
                    u32x4 w; w.x = cvt_pk_bf16(v0[0], v0[1]); w.y = cvt_pk_bf16(v0[2], v0[3]); w.z = cvt_pk_bf16(v1[0], v1[1]); w.w = cvt_pk_bf16(v1[2], v1[3]);
                    *(u32x4*)(rowp + bj * HALF) = w; } }
    }
};
struct EpiRelu2 {
    static constexpr bool PERM = true, AFTER_DRAIN = false;
    bf16_t* O; int ldc;
    __device__ __forceinline__ void operator()(const f32x4 (&acc)[2][2][4][2], const Unit& u, int wr, int wc, int fr, int fq) const {
        const int row0 = u.pm * BM + wr * 64 + fr, col0 = u.pn * BM + wc * 32 + 8 * fq;
#pragma unroll
        for (int ai = 0; ai < 2; ++ai)
#pragma unroll
            for (int m = 0; m < 4; ++m) { bf16_t* rowp = O + (size_t)(row0 + ai * HALF + m * 16) * ldc + col0;
#pragma unroll
                for (int bj = 0; bj < 2; ++bj) { f32x4 v0 = acc[ai][bj][m][0], v1 = acc[ai][bj][m][1];
#pragma unroll
                    for (int j = 0; j < 4; ++j) { const float a = fmaxf(v0[j], 0.f), b = fmaxf(v1[j], 0.f); v0[j] = a * a; v1[j] = b * b; }
                    u32x4 w; w.x = cvt_pk_bf16(v0[0], v0[1]); w.y = cvt_pk_bf16(v0[2], v0[3]); w.z = cvt_pk_bf16(v1[0], v1[1]); w.w = cvt_pk_bf16(v1[2], v1[3]);
                    *(u32x4*)(rowp + bj * HALF) = w; } }
    }
};
struct EpiResid {
    static constexpr bool PERM = false, AFTER_DRAIN = false;
    const float* resA; const float* resB; float* out; const float* gate;
    __device__ __forceinline__ void operator()(const f32x4 (&acc)[2][2][4][2], const Unit& u, int wr, int wc, int fr, int fq) const {
        const int row0 = u.pm * BM + wr * 64 + fr, col0 = u.pn * BM + wc * 32 + 4 * fq;
        const float* g = gate + cond_of_pm(u.pm) * 6144 + col0;
        const float* res = (u.pm < 32) ? resA + (size_t)row0 * 1024 : resB + (size_t)(row0 - 8192) * 1024;
        f32x4 gv[2][2];
#pragma unroll
        for (int bj = 0; bj < 2; ++bj)
#pragma unroll
            for (int n = 0; n < 2; ++n) gv[bj][n] = *(const f32x4*)(g + bj * HALF + n * 16);
#pragma unroll
        for (int ai = 0; ai < 2; ++ai)
#pragma unroll
            for (int m = 0; m < 4; ++m) { const size_t ro = (size_t)(ai * HALF + m * 16) * 1024 + col0; float* rowp = out + (size_t)row0 * 1024 + ro;
#pragma unroll
                for (int bj = 0; bj < 2; ++bj)
#pragma unroll
                    for (int n = 0; n < 2; ++n) { const f32x4 rv = *(const f32x4*)(res + ro + bj * HALF + n * 16); *(f32x4*)(rowp + bj * HALF + n * 16) = rv + gv[bj][n] * acc[ai][bj][m][n]; } }
    }
};

template <class Epi, class Sched, bool ALIGN_EPI = false, bool SP2 = false>
__device__ __forceinline__ void gemm_phase(PG8_LAS unsigned char* lds, const Gemm g, const Sched& S, const Epi& E) {
    const int tid = threadIdx.x, wid = __builtin_amdgcn_readfirstlane(tid >> 6), lane = tid & 63, wr = wid >> 2, wc = wid & 3, fr = lane & 15, fq = lane >> 4;
    const int K = g.K, nt = K / BK;
    unsigned voffA[2], voffB[2];
#pragma unroll
    for (int i = 0; i < 2; ++i) { int R, C; stage_rc(tid * 16 + i * 8192, R, C); const int Rb = Epi::PERM ? ((R & ~31) + perm32(R & 31)) : R;
        voffA[i] = (unsigned)(R * K + C) * 2u; voffB[i] = (unsigned)(Rb * K + C) * 2u; }
    const size_t kstep = (size_t)(BK * 2);
    const size_t hstep = (size_t)HALF * K * 2;
    const size_t tstep = 2 * hstep;
    const unsigned ldsw = (unsigned)wid * 1024u;
    const int aoff = lds_byte(wr * 64 + fr, fq * 8), boff = lds_byte(wc * 32 + fr, fq * 8);
#define PG8_SA(b, h) (((b) * 2 + (h)) * HTB)
#define PG8_SB(b, h) ((4 + (b) * 2 + (h)) * HTB)
#define PG8_STAGE(bufoff, gbase, voff) do { _Pragma("unroll") for (int _i = 0; _i < 2; ++_i) \
        __builtin_amdgcn_global_load_lds((const unsigned*)((const char*)(gbase) + (voff)[_i]), (PG8_LAS unsigned*)(lds + (bufoff) + ldsw + _i * 8192), 16, 0, 0); } while (0)
#define PG8_LDA(dst, b, h) do { _Pragma("unroll") for (int m = 0; m < 4; ++m) _Pragma("unroll") for (int k = 0; k < 2; ++k) dst[m][k] = *(const PG8_LAS bf16x8*)(lds + PG8_SA(b, h) + aoff + m * 2048 + k * 1024); } while (0)
#define PG8_LDB(dst, b, h) do { _Pragma("unroll") for (int n = 0; n < 2; ++n) _Pragma("unroll") for (int k = 0; k < 2; ++k) dst[n][k] = *(const PG8_LAS bf16x8*)(lds + PG8_SB(b, h) + boff + n * 2048 + k * 1024); } while (0)
#define PG8_MMA(ai, bj, At, Bt) do { __builtin_amdgcn_s_setprio(1); _Pragma("unroll") for (int m = 0; m < 4; ++m) _Pragma("unroll") for (int n = 0; n < 2; ++n) _Pragma("unroll") for (int k = 0; k < 2; ++k) \
        acc[ai][bj][m][n] = __builtin_amdgcn_mfma_f32_16x16x32_bf16(Bt[n][k], At[m][k], acc[ai][bj][m][n], 0, 0, 0); __builtin_amdgcn_s_setprio(0); } while (0)
#define PG8_WAIT_V(n) asm volatile("s_waitcnt vmcnt(" #n ")" ::: "memory")
#define PG8_WAIT_L(n) asm volatile("s_waitcnt lgkmcnt(" #n ")" ::: "memory")
#define PG8_BAR __builtin_amdgcn_s_barrier()
#define PG8_SCHED __builtin_amdgcn_sched_barrier(0)
    Unit cur, nxt; int ui = 0;
    if (!S.next(0, cur)) return;
    f32x4 acc[2][2][4][2];
#pragma unroll
    for (int a = 0; a < 2; ++a)
#pragma unroll
        for (int b = 0; b < 2; ++b)
#pragma unroll
            for (int m = 0; m < 4; ++m)
#pragma unroll
                for (int n = 0; n < 2; ++n) acc[a][b][m][n] = (f32x4){0.f, 0.f, 0.f, 0.f};
    bf16x8 At[4][2], B0[2][2], B1[2][2];
    const char* cA = (const char*)g.A + (size_t)cur.pm * tstep; const char* cB = (const char*)g.Bt + (size_t)cur.pn * tstep;
    S.a_ready(cur);
    if constexpr (SP2) {
        PG8_STAGE(PG8_SB(0, 0), cB, voffB); PG8_STAGE(PG8_SB(0, 1), cB + hstep, voffB); PG8_STAGE(PG8_SA(0, 0), cA, voffA); PG8_STAGE(PG8_SA(0, 1), cA + hstep, voffA);
        if (wr == 1) PG8_BAR;
        PG8_WAIT_V(2); PG8_BAR;
        PG8_STAGE(PG8_SB(1, 0), cB + kstep, voffB); PG8_STAGE(PG8_SA(1, 0), cA + kstep, voffA); PG8_STAGE(PG8_SB(1, 1), cB + hstep + kstep, voffB);
        PG8_WAIT_V(6); PG8_BAR;
    } else {
        PG8_STAGE(PG8_SB(0, 0), cB, voffB); PG8_STAGE(PG8_SA(0, 0), cA, voffA); PG8_STAGE(PG8_SB(0, 1), cB + hstep, voffB); PG8_STAGE(PG8_SA(0, 1), cA + hstep, voffA);
        if (wr == 1) PG8_BAR;
        PG8_WAIT_V(4); PG8_BAR;
        PG8_STAGE(PG8_SB(1, 0), cB + kstep, voffB); PG8_STAGE(PG8_SA(1, 0), cA + kstep, voffA); PG8_STAGE(PG8_SB(1, 1), cB + hstep + kstep, voffB);
        PG8_WAIT_V(6); PG8_BAR;
    }
    for (;;) {
        const bool has_next = S.next(ui + 1, nxt);
        const char* nA = has_next ? (const char*)g.A + (size_t)nxt.pm * tstep : cA; const char* nB = has_next ? (const char*)g.Bt + (size_t)nxt.pn * tstep : cB;
        for (int t = 0; t < nt; t += 2) {
            const bool last = (t == nt - 2);
            const char* a1 = cA + (size_t)(t + 1) * kstep;
            const char* a2 = last ? nA : cA + (size_t)(t + 2) * kstep; const char* b2 = last ? nB : cB + (size_t)(t + 2) * kstep;
            const char* a3 = a2 + kstep; const char* b3 = b2 + kstep;
            if (last && has_next) S.a_ready(nxt);
            if constexpr (SP2) {
            PG8_LDB(B0, 0, 0); PG8_LDB(B1, 0, 1); PG8_SCHED; PG8_LDA(At, 0, 0); PG8_STAGE(PG8_SA(1, 1), a1 + hstep, voffA);
            PG8_WAIT_V(8); PG8_WAIT_L(0); PG8_BAR; PG8_MMA(0, 0, At, B0); PG8_MMA(0, 1, At, B1); PG8_BAR; PG8_SCHED;
            PG8_LDA(At, 0, 1); PG8_STAGE(PG8_SB(0, 0), b2, voffB); PG8_STAGE(PG8_SB(0, 1), b2 + hstep, voffB); PG8_STAGE(PG8_SA(0, 0), a2, voffA);
            PG8_WAIT_V(8); PG8_WAIT_L(0); PG8_BAR; PG8_MMA(1, 0, At, B0); PG8_MMA(1, 1, At, B1); PG8_BAR; PG8_SCHED;
            PG8_LDB(B0, 1, 0); PG8_LDB(B1, 1, 1); PG8_SCHED; PG8_LDA(At, 1, 0); PG8_STAGE(PG8_SA(0, 1), a2 + hstep, voffA);
            PG8_WAIT_V(8); PG8_WAIT_L(0); PG8_BAR; PG8_MMA(0, 0, At, B0); PG8_MMA(0, 1, At, B1); PG8_BAR; PG8_SCHED;
            PG8_LDA(At, 1, 1); PG8_STAGE(PG8_SB(1, 0), b3, voffB); PG8_STAGE(PG8_SB(1, 1), b3 + hstep, voffB); PG8_STAGE(PG8_SA(1, 0), a3, voffA);
            PG8_WAIT_V(8); PG8_WAIT_L(0); PG8_BAR; PG8_MMA(1, 0, At, B0); PG8_MMA(1, 1, At, B1); PG8_BAR; PG8_SCHED;
            } else {
            PG8_LDB(B0, 0, 0); PG8_SCHED; PG8_LDA(At, 0, 0); PG8_STAGE(PG8_SA(1, 1), a1 + hstep, voffA);
            PG8_WAIT_L(8); PG8_BAR; PG8_WAIT_L(0); PG8_MMA(0, 0, At, B0); PG8_BAR; PG8_SCHED;
            PG8_LDB(B1, 0, 1); PG8_STAGE(PG8_SB(0, 0), b2, voffB);
            PG8_BAR; PG8_WAIT_L(0); PG8_MMA(0, 1, At, B1); PG8_BAR;
            PG8_LDA(At, 0, 1); PG8_STAGE(PG8_SA(0, 0), a2, voffA);
            PG8_BAR; PG8_WAIT_L(0); PG8_MMA(1, 0, At, B0); PG8_BAR; PG8_SCHED;
            PG8_STAGE(PG8_SB(0, 1), b2 + hstep, voffB);
            PG8_WAIT_V(6); PG8_BAR; PG8_MMA(1, 1, At, B1); PG8_BAR;
            PG8_LDB(B0, 1, 0); PG8_SCHED; PG8_LDA(At, 1, 0); PG8_STAGE(PG8_SA(0, 1), a2 + hstep, voffA);
            PG8_WAIT_L(8); PG8_BAR; PG8_WAIT_L(0); PG8_MMA(0, 0, At, B0); PG8_BAR; PG8_SCHED;
            PG8_LDB(B1, 1, 1); PG8_STAGE(PG8_SB(1, 0), b3, voffB);
            PG8_BAR; PG8_WAIT_L(0); PG8_MMA(0, 1, At, B1); PG8_BAR;
            PG8_LDA(At, 1, 1); PG8_STAGE(PG8_SA(1, 0), a3, voffA);
            PG8_BAR; PG8_WAIT_L(0); PG8_MMA(1, 0, At, B0); PG8_BAR; PG8_SCHED;
            PG8_STAGE(PG8_SB(1, 1), b3 + hstep, voffB);
            PG8_WAIT_V(6); PG8_BAR; PG8_MMA(1, 1, At, B1); PG8_BAR;
            }
        }
        if constexpr (ALIGN_EPI) { if (wr == 0) PG8_BAR; }
        if constexpr (!Epi::AFTER_DRAIN) { E(acc, cur, wr, wc, fr, fq); S.done(cur); }
        if (!has_next) break;
#pragma unroll
        for (int a = 0; a < 2; ++a)
#pragma unroll
            for (int b = 0; b < 2; ++b)
#pragma unroll
                for (int m = 0; m < 4; ++m)
#pragma unroll
                    for (int n = 0; n < 2; ++n) acc[a][b][m][n] = (f32x4){0.f, 0.f, 0.f, 0.f};
        cur = nxt; cA = nA; cB = nB; ++ui;
        if constexpr (ALIGN_EPI) { if (wr == 1) PG8_BAR; }
    }
    PG8_WAIT_V(0);
    if constexpr (!ALIGN_EPI) { if (wr == 0) PG8_BAR; }
    PG8_BAR;
    if constexpr (Epi::AFTER_DRAIN) { E.fused(acc, cur, wr, wc, fr, fq, lds, wid, lane); S.done(cur); }
#undef PG8_SA
#undef PG8_SB
#undef PG8_STAGE
#undef PG8_LDA
#undef PG8_LDB
#undef PG8_MMA
#undef PG8_WAIT_V
#undef PG8_WAIT_L
#undef PG8_BAR
#undef PG8_SCHED
}
}

#ifndef PG8_SP2
#define PG8_SP2 true
#endif
#ifndef PG8_ALIGN
#define PG8_ALIGN true
#endif

struct Frame {
    LAS unsigned char* lds;
    int tid, lane, wave, vcu, G;
    const float *x_prompt, *x_sample, *cvec, *state_hgrn, *state_rglru, *c_ctx, *w_ada, *b_ada, *norm1_gain, *norm2_gain, *w_in, *lb_logits, *hg_norm_gain,
                *conv_w, *conv_b, *lru_wa, *lru_ba, *lru_wx, *lru_bx, *lru_lambda, *w_out, *w_ff1, *w_ff2, *final_gain;
    float* out;
    bf16 *Win_t, *Wout_t, *Wff1_t, *Wff2_t, *WL;
    float* MOD; float* XS; float* DEC;
    bf16 *ACT, *QF, *V, *GL, *LX, *QE, *KE, *KDT, *VT, *OF, *OB, *HF, *HB, *HID;
    unsigned* GATES;
};
constexpr size_t OUT_SHG = (size_t)NTOK * 1024, OUT_SLRU = OUT_SHG + (size_t)32 * 2 * 4 * 128 * 128;

DI void p0_transpose_item(const float* W, int K, int N, bf16* WT, LAS float* scr, int item, int lane) {
    const int nblk = N / 32, kb = item / nblk, nb = item % nblk, k0 = 64 * kb, n0 = 32 * nb;
#pragma unroll 8
    for (int i = 0; i < 32; ++i) { const int kk = 2 * i + (lane >> 5); scr[kk * 33 + (lane & 31)] = W[(size_t)(k0 + kk) * N + n0 + (lane & 31)]; }
    LDS_WAIT(); asm volatile("" ::: "memory");
    const int c = lane & 7;
#pragma unroll
    for (int j = 0; j < 4; ++j) { const int n = (lane >> 3) + 8 * j; const LAS float* s = scr + (8 * c) * 33 + n;
        v4u o; o.x = pk2(s[0 * 33], s[1 * 33]); o.y = pk2(s[2 * 33], s[3 * 33]); o.z = pk2(s[4 * 33], s[5 * 33]); o.w = pk2(s[6 * 33], s[7 * 33]);
        *(GAS v4u*)(WT + (size_t)(n0 + n) * K + k0 + 8 * c) = o; }
    LDS_WAIT(); asm volatile("" ::: "memory");
}
DI void p0_prologue(Frame& F) {
    LAS float* ct = (LAS float*)(F.lds + CT_OFF);
    for (int i = F.tid; i < 5 * 1024; i += NWAVES * 64) { const int j = i >> 10, k = i & 1023; const float c = (j == 0) ? F.c_ctx[k] : F.cvec[(j - 1) * 1024 + k]; ct[i] = silu_f(c); }
    __syncthreads();
    LAS float* scr = (LAS float*)(F.lds + RING_OFF + F.wave * 16384);
    const int gw = F.wave * F.G + F.vcu, NGW = F.G * NWAVES;
    constexpr int I_GEMV = 6144 / 16, I_WL = 32, I_IN = (D / 64) * (INC / 32), I_OUT = (D / 64) * (D / 32), I_F1 = (D / 64) * (DFF / 32), I_F2 = (DFF / 64) * (D / 32);
    constexpr int NITEMS = I_GEMV + I_WL + I_IN + I_OUT + I_F1 + I_F2;
    for (int it = gw; it < NITEMS; it += NGW) {
        int r = it;
        if (r < I_GEMV) {
            const int n0 = 16 * r, col = F.lane & 15, kq = F.lane >> 4;
            const float* wp = F.w_ada + n0 + col;
            float acc[5] = {0.f, 0.f, 0.f, 0.f, 0.f};
            for (int k = kq; k < 1024; k += 32) {
                float w[8];
#pragma unroll
                for (int u = 0; u < 8; ++u) w[u] = wp[(size_t)(k + 4 * u) * 6144];
#pragma unroll
                for (int u = 0; u < 8; ++u)
#pragma unroll
                    for (int j = 0; j < 5; ++j) acc[j] += ct[j * 1024 + k + 4 * u] * w[u];
            }
#pragma unroll
            for (int j = 0; j < 5; ++j) { acc[j] += __shfl_xor(acc[j], 16); acc[j] += __shfl_xor(acc[j], 32); }
            if (kq == 0) { const float b = F.b_ada[n0 + col];
#pragma unroll
                for (int j = 0; j < 5; ++j) F.MOD[j * 6144 + n0 + col] = acc[j] + b; }
            continue;
        }
        r -= I_GEMV;
        if (r < I_WL) {
            const int mat = r >> 4; const float* src = (mat ? F.lru_wx : F.lru_wa) + (size_t)(r & 15) * 4096; bf16* dst = F.WL + (size_t)r * 4096;
            for (int e = F.lane; e < 4096; e += 64) { const int o = e >> 6, i = e & 63; dst[o * 64 + i] = (bf16)(pk2(src[i * 64 + o], 0.f) & 0xffffu); }
            continue;
        }
        r -= I_WL;
        if (r < I_IN) { p0_transpose_item(F.w_in, D, INC, F.Win_t, scr, r, F.lane); continue; } r -= I_IN;
        if (r < I_OUT) { p0_transpose_item(F.w_out, D, D, F.Wout_t, scr, r, F.lane); continue; } r -= I_OUT;
        if (r < I_F1) { p0_transpose_item(F.w_ff1, D, DFF, F.Wff1_t, scr, r, F.lane); continue; } r -= I_F1;
        p0_transpose_item(F.w_ff2, DFF, D, F.Wff2_t, scr, r, F.lane);
    }
}

DI int cond_of_row(int m) { return m < NCTX ? 0 : 1 + ((m - NCTX) >> 10); }
DI void store_row_bf16(bf16* orow, int lane, const f32x4 (&v)[4]) {
    GAS v2u* o8 = (GAS v2u*)orow + lane;
#pragma unroll
    for (int j = 0; j < 4; ++j) { v2u w; w.x = pk2(v[j].x, v[j].y); w.y = pk2(v[j].z, v[j].w); o8[64 * j] = w; }
}
DI void p1_rows(Frame& F) {
    const int gw = F.vcu * NWAVES + F.wave, NGW = F.G * NWAVES;
    for (int m = gw; m < NTOK; m += NGW) {
        const float* xrow = m < NCTX ? F.x_prompt + (size_t)m * D : F.x_sample + (size_t)(m - NCTX) * D;
        const GAS f32x4* xr = (const GAS f32x4*)xrow + F.lane;
        f32x4 v[4];
#pragma unroll
        for (int j = 0; j < 4; ++j) v[j] = xr[64 * j];
        if (m >= NCTX) {
            const int t = (m - NCTX) & 1023; const float rr = (float)(t >> 6), cc = (float)(t & 63);
#pragma unroll
            for (int e = 0; e < 4; ++e) {
                const float om = exp2f(-(float)(4 * F.lane + e) * (13.287712379549449f / 256.0f));
                const float ar = rr * om * 0.15915494309189535f, ac = cc * om * 0.15915494309189535f;
                v[0][e] += __builtin_amdgcn_sinf(ar); v[1][e] += __builtin_amdgcn_cosf(ar); v[2][e] += __builtin_amdgcn_sinf(ac); v[3][e] += __builtin_amdgcn_cosf(ac);
            }
            GAS f32x4* xo = (GAS f32x4*)(F.XS + (size_t)(m - NCTX) * D) + F.lane;
#pragma unroll
            for (int j = 0; j < 4; ++j) xo[64 * j] = v[j];
        }
        float s = 0.f;
#pragma unroll
        for (int j = 0; j < 4; ++j) s += (v[j].x * v[j].x + v[j].y * v[j].y) + (v[j].z * v[j].z + v[j].w * v[j].w);
        const float rstd = 1.0f / sqrtf(wave_sum(s) * (1.f / D) + EPS);
        const float* mod = F.MOD + cond_of_row(m) * 6144;
#pragma unroll
        for (int j = 0; j < 4; ++j) {
            const int c = 256 * j + 4 * F.lane;
            const f32x4 g = *(const f32x4*)(F.norm1_gain + c), sh = *(const f32x4*)(mod + c), sc = *(const f32x4*)(mod + 1024 + c);
            v[j] = v[j] * rstd * g * (1.0f + sc) + sh;
        }
        store_row_bf16(F.ACT + (size_t)m * D, F.lane, v);
    }
}
DI void p7_rows(Frame& F) {
    const int gw = F.vcu * NWAVES + F.wave, NGW = F.G * NWAVES;
    for (int m = gw; m < NTOK; m += NGW) {
        const GAS f32x4* xr = (const GAS f32x4*)(F.out + (size_t)m * D) + F.lane;
        f32x4 v[4]; float s = 0.f;
#pragma unroll
        for (int j = 0; j < 4; ++j) { v[j] = xr[64 * j]; s += (v[j].x * v[j].x + v[j].y * v[j].y) + (v[j].z * v[j].z + v[j].w * v[j].w); }
        const float rstd = 1.0f / sqrtf(wave_sum(s) * (1.f / D) + EPS);
        const float* mod = F.MOD + cond_of_row(m) * 6144;
#pragma unroll
        for (int j = 0; j < 4; ++j) {
            const int c = 256 * j + 4 * F.lane;
            const f32x4 g = *(const f32x4*)(F.norm2_gain + c), sh = *(const f32x4*)(mod + 3072 + c), sc = *(const f32x4*)(mod + 4096 + c);
            v[j] = v[j] * rstd * g * (1.0f + sc) + sh;
        }
        store_row_bf16(F.ACT + (size_t)m * D, F.lane, v);
    }
}
DI void p10_rows(Frame& F) {
    const int gw = F.vcu * NWAVES + F.wave, NGW = F.G * NWAVES;
    for (int m = gw; m < NTOK; m += NGW) {
        GAS f32x4* xr = (GAS f32x4*)(F.out + (size_t)m * D) + F.lane;
        f32x4 v[4]; float s = 0.f;
#pragma unroll
        for (int j = 0; j < 4; ++j) { v[j] = xr[64 * j]; s += (v[j].x * v[j].x + v[j].y * v[j].y) + (v[j].z * v[j].z + v[j].w * v[j].w); }
        const float rstd = 1.0f / sqrtf(wave_sum(s) * (1.f / D) + EPS);
#pragma unroll
        for (int j = 0; j < 4; ++j) { const f32x4 g = *(const f32x4*)(F.final_gain + 256 * j + 4 * F.lane); xr[64 * j] = v[j] * rstd * g; }
    }
}
DI void p5_rows(Frame& F) {
    const int gw = F.vcu * NWAVES + F.wave, NGW = F.G * NWAVES;
    const int c8 = 8 * F.lane;
    for (int m = gw; m < NTOK; m += NGW) {
        const v4u a = *(const GAS v4u*)(F.OF + (size_t)m * 512 + c8), b = *(const GAS v4u*)(F.OB + (size_t)m * 512 + c8);
        const v4u gt = *(const GAS v4u*)(F.GL + (size_t)m * 1024 + c8), lg = *(const GAS v4u*)(F.GL + (size_t)m * 1024 + 512 + c8);
        const v4u hf = *(const GAS v4u*)(F.HF + (size_t)m * 512 + c8), hb = *(const GAS v4u*)(F.HB + (size_t)m * 512 + c8);
        float o[8], s = 0.f;
#pragma unroll
        for (int j = 0; j < 4; ++j) { o[2 * j] = bflo(a[j]) + bflo(b[j]); o[2 * j + 1] = bfhi(a[j]) + bfhi(b[j]); s += o[2 * j] * o[2 * j] + o[2 * j + 1] * o[2 * j + 1]; }
        s += __shfl_xor(s, 1); s += __shfl_xor(s, 2); s += __shfl_xor(s, 4); s += __shfl_xor(s, 8);
        const float rstd = 1.0f / sqrtf(s * (1.f / 128.f) + EPS);
        const f32x4 g0 = *(const f32x4*)(F.hg_norm_gain + c8), g1 = *(const f32x4*)(F.hg_norm_gain + c8 + 4);
        v4u w1, w2;
#pragma unroll
        for (int j = 0; j < 4; ++j) {
            const float ga = (j < 2) ? g0[2 * j] : g1[2 * j - 4], gb = (j < 2) ? g0[2 * j + 1] : g1[2 * j - 3];
            w1[j] = pk2(o[2 * j] * rstd * ga * silu_f(bflo(gt[j])), o[2 * j + 1] * rstd * gb * silu_f(bfhi(gt[j])));
            w2[j] = pk2((bflo(hf[j]) + bflo(hb[j])) * gelu_tanh_f(bflo(lg[j])), (bfhi(hf[j]) + bfhi(hb[j])) * gelu_tanh_f(bfhi(lg[j])));
        }
        *(GAS v4u*)(F.ACT + (size_t)m * D + c8) = w1;
        *(GAS v4u*)(F.ACT + (size_t)m * D + 512 + c8) = w2;
    }
}

template <int DIR>
DI void hg_prep_item(Frame& F, int cg, int head) {
    const int m0 = cg * 32, k0 = 2 * F.lane, hk = head * 128 + k0, col = DIR * 512 + hk;
    const f32x2 L0 = *(const f32x2*)(F.lb_logits + DIR * 512 + hk), L1 = *(const f32x2*)(F.lb_logits + 1024 + DIR * 512 + hk);
    const float lba = __builtin_amdgcn_rcpf(1.0f + __expf(L1.x - L0.x)), lbb = __builtin_amdgcn_rcpf(1.0f + __expf(L1.y - L0.y));
    float lf0[32], lf1[32], kk0[32], kk1[32]; unsigned qw[32];
    float bl0 = 0.f, bl1 = 0.f;
#pragma unroll
    for (int i = 0; i < 32; ++i) {
        const int t = DIR ? 31 - i : i; const size_t ro = (size_t)(m0 + t) * 2048 + col;
        const unsigned fw = *(const GAS unsigned*)(F.QF + ro + 1024); qw[i] = *(const GAS unsigned*)(F.QF + ro);
        const float f0 = lba + (1.0f - lba) * sigm(bflo(fw)), f1 = lbb + (1.0f - lbb) * sigm(bfhi(fw));
        lf0[i] = __logf(f0); lf1[i] = __logf(f1); kk0[i] = 1.0f - f0; kk1[i] = 1.0f - f1;
        bl0 += lf0[i]; bl1 += lf1[i];
    }
    float b0 = 0.f, b1 = 0.f; unsigned kd0[16], kd1[16];
#pragma unroll
    for (int ip = 0; ip < 16; ++ip) {
        float d0[2], d1[2];
#pragma unroll
        for (int s = 0; s < 2; ++s) {
            const int i = 2 * ip + s, t = DIR ? 31 - i : i;
            b0 += lf0[i]; b1 += lf1[i];
            const float q0 = silu_f(bflo(qw[i])), q1 = silu_f(bfhi(qw[i]));
            const size_t oo = ((size_t)DIR * NTOK + m0 + t) * 512 + hk;
            *(GAS unsigned*)(F.QE + oo) = pk2(q0 * __expf(b0), q1 * __expf(b1));
            *(GAS unsigned*)(F.KE + oo) = pk2(kk0[i] * __expf(-b0), kk1[i] * __expf(-b1));
            d0[s] = kk0[i] * __expf(bl0 - b0); d1[s] = kk1[i] * __expf(bl1 - b1);
        }
        const int p = DIR ? 15 - ip : ip;
        kd0[p] = DIR ? pk2(d0[1], d0[0]) : pk2(d0[0], d0[1]);
        kd1[p] = DIR ? pk2(d1[1], d1[0]) : pk2(d1[0], d1[1]);
    }
    GAS v4u* r0 = (GAS v4u*)(F.KDT + ((size_t)DIR * 512 + hk) * NTOK + m0); GAS v4u* r1 = (GAS v4u*)(F.KDT + ((size_t)DIR * 512 + hk + 1) * NTOK + m0);
#pragma unroll
    for (int j = 0; j < 4; ++j) { r0[j] = (v4u){kd0[4 * j], kd0[4 * j + 1], kd0[4 * j + 2], kd0[4 * j + 3]}; r1[j] = (v4u){kd1[4 * j], kd1[4 * j + 1], kd1[4 * j + 2], kd1[4 * j + 3]}; }
    *(f32x2*)(F.DEC + ((size_t)DIR * NCH + cg) * 512 + hk) = (f32x2){__expf(bl0), __expf(bl1)};
}
DI void vt_item(Frame& F, int cg, int head) {
    const int m0 = cg * 32, hv = head * 128 + 2 * F.lane;
    unsigned w[32];
#pragma unroll
    for (int t = 0; t < 32; ++t) w[t] = *(const GAS unsigned*)(F.V + (size_t)(m0 + t) * 512 + hv);
    GAS v4u* r0 = (GAS v4u*)(F.VT + (size_t)hv * NTOK + m0); GAS v4u* r1 = (GAS v4u*)(F.VT + (size_t)(hv + 1) * NTOK + m0);
#pragma unroll
    for (int j = 0; j < 4; ++j) {
        v4u a, b;
#pragma unroll
        for (int e = 0; e < 4; ++e) { const unsigned x = w[8 * j + 2 * e], y = w[8 * j + 2 * e + 1]; a[e] = (x & 0xffffu) | (y << 16); b[e] = (x >> 16) | (y & 0xffff0000u); }
        r0[j] = a; r1[j] = b;
    }
}
#define MFMA32(a, b, c) __builtin_amdgcn_mfma_f32_32x32x16_bf16((a), (b), (c), 0, 0, 0)
DI void lru_gate_item(Frame& F, int tg, int n) {
    const int m0 = 64 * tg, r = F.lane & 31, h = F.lane >> 5;
    const int T = m0 < NCTX ? TCTX : TLAT, tseq0 = m0 < NCTX ? (m0 & (TCTX - 1)) : ((m0 - NCTX) & (TLAT - 1));
    bf16x8 xa[2][4];
#pragma unroll
    for (int ks = 0; ks < 4; ++ks) {
        const int c0 = 64 * n + 16 * ks + 8 * h;
        f32x4 w[4][2];
#pragma unroll
        for (int j = 0; j < 4; ++j) { w[j][0] = *(const f32x4*)(F.conv_w + j * 512 + c0); w[j][1] = *(const f32x4*)(F.conv_w + j * 512 + c0 + 4); }
        const f32x4 cb0 = *(const f32x4*)(F.conv_b + c0), cb1 = *(const f32x4*)(F.conv_b + c0 + 4);
#pragma unroll
        for (int mt = 0; mt < 2; ++mt) {
            const int tk = 32 * mt + r, m = m0 + tk, ts = tseq0 + tk;
            f32x4 a0 = cb0, a1 = cb1;
#pragma unroll
            for (int j = 0; j < 4; ++j) {
                const int tt = ts + j - 2; const bool ok = (tt >= 0) && (tt < T);
                const v4u lw = *(const GAS v4u*)(F.LX + (size_t)(ok ? m + j - 2 : m) * 512 + c0);
                const float z = ok ? 1.0f : 0.0f;
                a0 += (f32x4){bflo(lw.x), bfhi(lw.x), bflo(lw.y), bfhi(lw.y)} * (w[j][0] * z);
                a1 += (f32x4){bflo(lw.z), bfhi(lw.z), bflo(lw.w), bfhi(lw.w)} * (w[j][1] * z);
            }
            const v4u p = {pk2(a0.x, a0.y), pk2(a0.z, a0.w), pk2(a1.x, a1.y), pk2(a1.z, a1.w)};
            xa[mt][ks] = __builtin_bit_cast(bf16x8, p);
        }
    }
    f32x16 zero;
#pragma unroll
    for (int i = 0; i < 16; ++i) zero[i] = 0.f;
#pragma unroll
    for (int nt = 0; nt < 2; ++nt) {
        f32x16 xcC[2] = {zero, zero};
#pragma unroll
        for (int s = 0; s < 2; ++s) {
            bf16x8 bI;
#pragma unroll
            for (int j = 0; j < 8; ++j) bI[j] = (16 * s + 8 * h + j == r) ? (short)0x3F80 : (short)0;
#pragma unroll
            for (int mt = 0; mt < 2; ++mt) xcC[mt] = MFMA32(xa[mt][2 * nt + s], bI, xcC[mt]);
        }
        const int c = 64 * n + 32 * nt + r;
#pragma unroll
        for (int d = 0; d < 2; ++d) {
            f32x16 accA[2] = {zero, zero}, accX[2] = {zero, zero};
            const bf16* wa = F.WL + ((size_t)((0 * 2 + d) * 8 + n) * 64 + 32 * nt + r) * 64 + 8 * h;
            const bf16* wx = F.WL + ((size_t)((1 * 2 + d) * 8 + n) * 64 + 32 * nt + r) * 64 + 8 * h;
#pragma unroll
            for (int ks = 0; ks < 4; ++ks) {
                const bf16x8 ba_ = *(const GAS bf16x8*)(wa + 16 * ks), bx_ = *(const GAS bf16x8*)(wx + 16 * ks);
#pragma unroll
                for (int mt = 0; mt < 2; ++mt) { accA[mt] = MFMA32(xa[mt][ks], ba_, accA[mt]); accX[mt] = MFMA32(xa[mt][ks], bx_, accX[mt]); }
            }
            const float bias_a = F.lru_ba[d * 512 + c], bias_x = F.lru_bx[d * 512 + c];
            const float e = __expf(-F.lru_lambda[d * 512 + c]);
            const float sp8 = -8.0f * e * (1.0f - e * (0.5f - e * (0.33333333f - 0.25f * e)));
#pragma unroll
            for (int mt = 0; mt < 2; ++mt)
#pragma unroll
                for (int rg = 0; rg < 16; ++rg) {
                    const int tok = m0 + 32 * mt + (rg & 3) + 8 * (rg >> 2) + 4 * h;
                    const float rr = sigm(accA[mt][rg] + bias_a), ii = sigm(accX[mt][rg] + bias_x);
                    const float la = sp8 * rr, y = 2.0f * la;
                    const float em = -y * (1.0f + y * (0.5f + y * (0.16666667f + y * (0.041666668f + y * 0.0083333333f))));
                    const float u = __builtin_sqrtf(em) * ii * xcC[mt][rg];
                    const _Float16 lh = (_Float16)la;
                    F.GATES[((size_t)tok * 2 + d) * 512 + c] = (unsigned)__builtin_bit_cast(unsigned short, lh) | (pk2(0.f, u) & 0xffff0000u);
                }
        }
    }
}
DI void p3_prep(Frame& F) {
    const int gw = F.wave * F.G + F.vcu, NGW = F.G * NWAVES;
    constexpr int I_G = (NTOK / 64) * 8, I_HG = NCH * 8, I_VT = NCH * 4;
    for (int it = gw; it < I_G + I_HG + I_VT; it += NGW) {
        int r = it;
        if (r < I_G) { lru_gate_item(F, r >> 3, r & 7); continue; } r -= I_G;
        if (r < I_HG) { const int head = r & 3, dir = (r >> 2) & 1, cg = r >> 3; if (dir) hg_prep_item<1>(F, cg, head); else hg_prep_item<0>(F, cg, head); continue; } r -= I_HG;
        vt_item(F, r >> 2, r & 3);
    }
}

DI bf16x8 ld2x8(const bf16* p) {
    const v2u a = *(const GAS v2u*)p, b = *(const GAS v2u*)(p + 8);
    const v4u w = {a.x, a.y, b.x, b.y}; return __builtin_bit_cast(bf16x8, w);
}
DI bf16x8 pack8(const f32x16& x, int s) {
    const v4u w = {pk2(x[8 * s], x[8 * s + 1]), pk2(x[8 * s + 2], x[8 * s + 3]), pk2(x[8 * s + 4], x[8 * s + 5]), pk2(x[8 * s + 6], x[8 * s + 7])};
    return __builtin_bit_cast(bf16x8, w);
}
DI void hg_scan_item(Frame& F, int sq, int d, int head, int vs) {
    const int r = F.lane & 31, h = F.lane >> 5;
    const bool lat = sq >= 32;
    const int T = lat ? TLAT : TCTX, base = lat ? NCTX + (sq - 32) * TLAT : sq * TCTX, nch = T / 32;
    const int hk = head * 128;
    f32x16 S[4];
    if (lat) {
        const float* s0 = F.state_hgrn + ((size_t)((sq - 32) * 2 + d) * 4 + head) * 128 * 128 + 32 * vs;
        const unsigned so = (unsigned)(4 * h * 128 + r);
#pragma unroll
        for (int i = 0; i < 4; ++i)
#pragma unroll
            for (int rg = 0; rg < 16; ++rg) S[i][rg] = s0[so + (unsigned)((32 * i + (rg & 3) + 8 * (rg >> 2)) * 128)];
    } else {
#pragma unroll
        for (int i = 0; i < 4; ++i)
#pragma unroll
            for (int rg = 0; rg < 16; ++rg) S[i][rg] = 0.f;
    }
    const unsigned qoff = (unsigned)(r * 512 + 4 * h), voff = (unsigned)((32 * vs + r) * NTOK + 4 * h), kdoff = (unsigned)(r * NTOK + 4 * h), ooff = (unsigned)(r * 512 + 32 * vs + 4 * h), doff = (unsigned)(4 * h);
    const bf16* QEd = F.QE + (size_t)d * NTOK * 512 + hk; const bf16* KEd = F.KE + (size_t)d * NTOK * 512 + hk;
    const bf16* KDd = F.KDT + ((size_t)d * 512 + hk) * NTOK; const float* DECd = F.DEC + (size_t)d * NCH * 512 + hk;
    const bf16* VTd = F.VT + (size_t)hk * NTOK;
    bf16* OUTd = (d ? F.OB : F.OF) + hk;
    for (int ci = 0; ci < nch; ++ci) {
        const int c = d ? nch - 1 - ci : ci, m0 = base + 32 * c, cg = m0 >> 5;
        const bf16* qb = QEd + (size_t)m0 * 512; const bf16* kb = KEd + (size_t)m0 * 512; const bf16* vb = VTd + m0; const bf16* kdb = KDd + m0;
        bf16x8 qf[8], vf[2];
        f32x16 X;
#pragma unroll
        for (int i = 0; i < 16; ++i) X[i] = 0.f;
#pragma unroll
        for (int ks = 0; ks < 8; ++ks) { qf[ks] = ld2x8(qb + qoff + 16 * ks); X = MFMA32(ld2x8(kb + qoff + 16 * ks), qf[ks], X); }
        vf[0] = ld2x8(vb + voff); vf[1] = ld2x8(vb + voff + 16);
#pragma unroll
        for (int rg = 0; rg < 16; ++rg) { const int s = (rg & 3) + 8 * (rg >> 2) + 4 * h; const bool keep = d ? (s >= r) : (s <= r); X[rg] = keep ? X[rg] : 0.f; }
        f32x16 O;
#pragma unroll
        for (int i = 0; i < 16; ++i) O[i] = 0.f;
        O = MFMA32(vf[0], pack8(X, 0), O); O = MFMA32(vf[1], pack8(X, 1), O);
#pragma unroll
        for (int i = 0; i < 4; ++i) { O = MFMA32(pack8(S[i], 0), qf[2 * i], O); O = MFMA32(pack8(S[i], 1), qf[2 * i + 1], O); }
        {
            bf16* op = OUTd + (size_t)m0 * 512;
#pragma unroll
            for (int g = 0; g < 4; ++g) { const v2u w = {pk2(O[4 * g], O[4 * g + 1]), pk2(O[4 * g + 2], O[4 * g + 3])}; *(GAS v2u*)(op + ooff + 8 * g) = w; }
        }
        const float* dp = DECd + (size_t)cg * 512;
#pragma unroll
        for (int i = 0; i < 4; ++i) {
#pragma unroll
            for (int g = 0; g < 4; ++g) { const f32x4 dv = *(const GAS f32x4*)(dp + doff + 32 * i + 8 * g);
#pragma unroll
                for (int j = 0; j < 4; ++j) S[i][4 * g + j] *= dv[j]; }
            const bf16* kd = kdb + (size_t)(32 * i) * NTOK;
            S[i] = MFMA32(ld2x8(kd + kdoff), vf[0], S[i]); S[i] = MFMA32(ld2x8(kd + kdoff + 16), vf[1], S[i]);
        }
    }
    if (!lat) {
        float* so = F.out + OUT_SHG + ((size_t)(sq * 2 + d) * 4 + head) * 128 * 128 + 32 * vs;
        const unsigned sof = (unsigned)(4 * h * 128 + r);
#pragma unroll
        for (int i = 0; i < 4; ++i)
#pragma unroll
            for (int rg = 0; rg < 16; ++rg) so[sof + (unsigned)((32 * i + (rg & 3) + 8 * (rg >> 2)) * 128)] = S[i][rg];
    }
}
DI void lru_scan_item(Frame& F, int sq, int d, int cgp) {
    const bool lat = sq >= 32;
    const int T = lat ? TLAT : TCTX, base = lat ? NCTX + (sq - 32) * TLAT : sq * TCTX, c = 64 * cgp + F.lane;
    float hs = lat ? F.state_rglru[(size_t)((sq - 32) * 2 + d) * 512 + c] : 0.f;
    const unsigned* gp = F.GATES + (size_t)d * 512 + c; bf16* op = (d ? F.HB : F.HF) + c;
    constexpr int U = 32;
    unsigned g[U], gn[U];
#pragma unroll
    for (int u = 0; u < U; ++u) { const int t = d ? T - 1 - u : u; g[u] = *(const GAS unsigned*)(gp + (size_t)(base + t) * 1024); }
    for (int i0 = 0; i0 < T; i0 += U) {
        if (i0 + U < T) {
#pragma unroll
            for (int u = 0; u < U; ++u) { const int t = d ? T - 1 - (i0 + U + u) : i0 + U + u; gn[u] = *(const GAS unsigned*)(gp + (size_t)(base + t) * 1024); }
        }
#pragma unroll
        for (int u = 0; u < U; ++u) {
            const int t = d ? T - 1 - (i0 + u) : i0 + u;
            const float la = (float)__builtin_bit_cast(_Float16, (unsigned short)(g[u] & 0xffffu));
            hs = __expf(la) * hs + bfhi(g[u]);
            op[(size_t)(base + t) * 512] = (bf16)(pk2(hs, 0.f) & 0xffffu);
        }
#pragma unroll
        for (int u = 0; u < U; ++u) g[u] = gn[u];
    }
    if (!lat) F.out[OUT_SLRU + (size_t)(sq * 2 + d) * 512 + c] = hs;
}
DI void p4_scans(Frame& F) {
    const int sub = F.wave & 3;
    for (int vh = (F.wave >> 2) * F.G + F.vcu; vh < 32 + 256 + 144; vh += 2 * F.G) {
        if (vh < 32) { hg_scan_item(F, 32 + (vh >> 3), (vh >> 2) & 1, vh & 3, sub); continue; }
        const int idx = vh - 32;
        if (idx < 256) { hg_scan_item(F, idx >> 3, (idx >> 2) & 1, idx & 3, sub); continue; }
        const int li = (idx - 256) * 4 + sub;
        if (li < 64) lru_scan_item(F, 32 + (li >> 4), (li >> 3) & 1, li & 7);
        else { const int l2 = li - 64; lru_scan_item(F, l2 >> 4, (l2 >> 3) & 1, l2 & 7); }
    }
}

constexpr int N_PHASES = 11;
struct Args { const float* in[24]; float* out; unsigned char* ws; int ph_lo, ph_hi, li, pad; };
__global__ void __launch_bounds__(NWAVES * 64, 2) mk_fwd(Args args) {
    extern __shared__ __attribute__((aligned(16))) unsigned char lds[];
    Frame F;
    F.lds = (LAS unsigned char*)lds;
    F.tid = threadIdx.x; F.lane = F.tid & 63; F.wave = __builtin_amdgcn_readfirstlane(F.tid >> 6);
    F.G = gridDim.x; { const int bx = blockIdx.x; F.vcu = (F.G % 8 == 0) ? (bx % 8) * (F.G / 8) + bx / 8 : bx; }
    unsigned char* ws = args.ws;
    F.x_prompt = args.in[0]; F.x_sample = args.in[1]; F.cvec = args.in[2]; F.state_hgrn = args.in[3]; F.state_rglru = args.in[4]; F.c_ctx = args.in[5];
    F.w_ada = args.in[6]; F.b_ada = args.in[7]; F.norm1_gain = args.in[8]; F.norm2_gain = args.in[9]; F.w_in = args.in[10]; F.lb_logits = args.in[11];
    F.hg_norm_gain = args.in[12]; F.conv_w = args.in[13]; F.conv_b = args.in[14]; F.lru_wa = args.in[15]; F.lru_ba = args.in[16]; F.lru_wx = args.in[17];
    F.lru_bx = args.in[18]; F.lru_lambda = args.in[19]; F.w_out = args.in[20]; F.w_ff1 = args.in[21]; F.w_ff2 = args.in[22]; F.final_gain = args.in[23];
    F.out = args.out;
    F.Win_t = (bf16*)(ws + WS_WIN); F.Wout_t = (bf16*)(ws + WS_WOUT); F.Wff1_t = (bf16*)(ws + WS_WFF1); F.Wff2_t = (bf16*)(ws + WS_WFF2); F.WL = (bf16*)(ws + WS_WL);
    F.MOD = (float*)(ws + WS_MOD); F.XS = (float*)(ws + WS_XS); F.DEC = (float*)(ws + WS_DEC);
    F.ACT = (bf16*)(ws + WS_ACT); F.QF = (bf16*)(ws + WS_QF); F.V = (bf16*)(ws + WS_V); F.GL = (bf16*)(ws + WS_GL); F.LX = (bf16*)(ws + WS_LX);
    F.QE = (bf16*)(ws + WS_QE); F.KE = (bf16*)(ws + WS_KE); F.KDT = (bf16*)(ws + WS_KDT); F.VT = (bf16*)(ws + WS_VT);
    F.OF = (bf16*)(ws + WS_OF); F.OB = (bf16*)(ws + WS_OB); F.HF = (bf16*)(ws + WS_HF); F.HB = (bf16*)(ws + WS_HB); F.HID = (bf16*)(ws + WS_HID);
    F.GATES = (unsigned*)args.out;
    volatile LAS unsigned* MISC = (volatile LAS unsigned*)(F.lds + LDSCTL_OFF);
    for (int u = F.tid; u < 128; u += NWAVES * 64) MISC[u] = 0u;
    __syncthreads();
    const int lo = args.ph_lo, hi = args.ph_hi;
    XcdBarrier bar; bar.bar = (unsigned*)(ws + WS_CTL); bar.x = 0; bar.st = nullptr;
    if (hi - lo > 1) bar = xcd_barrier_post((unsigned*)(ws + WS_CTL), MISC + 8);
#define IN(k) (lo <= (k) && (k) < hi)
#define SEAM(k) do { if (IN(k) && IN((k) + 1)) xcd_barrier(bar); } while (0)

    if (IN(0)) { p0_prologue(F); __syncthreads(); } SEAM(0);
    if (IN(1)) { p1_rows(F); } SEAM(1);
    if (IN(2)) {
        pg8::Gemm g{F.ACT, F.Win_t, NTOK, INC, D}; pg8::StaticOrder S; S.init(NTOK, INC, F.G, (int)blockIdx.x);
        pg8::EpiRoute E{F.QF, F.V, F.GL, F.LX};
        pg8::gemm_phase<pg8::EpiRoute, pg8::StaticOrder, PG8_ALIGN, PG8_SP2>(F.lds + RING_OFF, g, S, E);
    } SEAM(2);
    if (IN(3)) { p3_prep(F); } SEAM(3);
    if (IN(4)) { p4_scans(F); } SEAM(4);
    if (IN(5)) { p5_rows(F); } SEAM(5);
    if (IN(6)) {
        pg8::Gemm g{F.ACT, F.Wout_t, NTOK, D, D}; pg8::StaticOrder S; S.init(NTOK, D, F.G, (int)blockIdx.x);
        pg8::EpiResid E{F.x_prompt, F.XS, F.out, F.MOD + 2048};
        pg8::gemm_phase<pg8::EpiResid, pg8::StaticOrder, PG8_ALIGN, PG8_SP2>(F.lds + RING_OFF, g, S, E);
    } SEAM(6);
    if (IN(7)) { p7_rows(F); } SEAM(7);
    if (IN(8)) {
        pg8::Gemm g{F.ACT, F.Wff1_t, NTOK, DFF, D}; pg8::StaticOrder S; S.init(NTOK, DFF, F.G, (int)blockIdx.x);
        pg8::EpiRelu2 E{F.HID, DFF};
        pg8::gemm_phase<pg8::EpiRelu2, pg8::StaticOrder, PG8_ALIGN, PG8_SP2>(F.lds + RING_OFF, g, S, E);
    } SEAM(8);
    if (IN(9)) {
        pg8::Gemm g{F.HID, F.Wff2_t, NTOK, D, DFF}; pg8::StaticOrder S; S.init(NTOK, D, F.G, (int)blockIdx.x);
        pg8::EpiResid E{F.out, F.out + (size_t)NCTX * D, F.out, F.MOD + 5120};
        pg8::gemm_phase<pg8::EpiResid, pg8::StaticOrder, PG8_ALIGN, PG8_SP2>(F.lds + RING_OFF, g, S, E);
    } SEAM(9);
    if (IN(10)) { p10_rows(F); }
#undef IN
#undef SEAM
}

extern "C" void kernel_launch(void* const* d_in, const int* in_sizes, int n_in, void* d_out, int out_size, void* d_ws, size_t ws_size, hipStream_t stream) {
    static int grid = 0;
    if (grid == 0) {
        if (n_in != 24 || in_sizes[0] != NCTX * D || ws_size < WS_END) { fprintf(stderr, "kernel_launch: unexpected shapes (n_in %d, in0 %d, out %d, ws %zu)\n", n_in, n_in > 0 ? in_sizes[0] : -1, out_size, ws_size); grid = -1; return; }
        int dev = 0, cus = 0, per_cu = 0;
        if (hipGetDevice(&dev) != hipSuccess || hipDeviceGetAttribute(&cus, hipDeviceAttributeMultiprocessorCount, dev) != hipSuccess) { grid = -1; return; }
        if (hipFuncSetAttribute((const void*)mk_fwd, hipFuncAttributeMaxDynamicSharedMemorySize, LDS_BYTES) != hipSuccess) { fprintf(stderr, "kernel_launch: hipFuncSetAttribute failed\n"); grid = -1; return; }
        if (hipOccupancyMaxActiveBlocksPerMultiprocessor(&per_cu, (const void*)mk_fwd, NWAVES * 64, LDS_BYTES) != hipSuccess || per_cu < 1)
            fprintf(stderr, "kernel_launch: occupancy query reports %d workgroups per CU\n", per_cu);
        (void)hipGetLastError();
        grid = cus;
    }
    if (grid < 0) return;
    if (hipMemsetAsync((char*)d_ws + WS_CTL, 0, CTL_ZERO_BYTES, stream) != hipSuccess) return;
    Args a{};
    for (int i = 0; i < 24; ++i) a.in[i] = (const float*)d_in[i];
    a.out = (float*)d_out; a.ws = (unsigned char*)d_ws;
    constexpr int NL = MK_N_LAUNCHES;
    for (int li = 0; li < NL; ++li) {
        a.ph_lo = (NL == 1) ? 0 : li; a.ph_hi = (NL == 1) ? N_PHASES : li + 1; a.li = li;
        hipLaunchKernelGGL(mk_fwd, dim3(grid), dim3(NWAVES * 64), LDS_BYTES, stream, a);
    }
}
```

```cpp
#include <hip/hip_runtime.h>
#include <cstdio>
#include <cstdint>

#ifndef MK_N_LAUNCHES
#define MK_N_LAUNCHES 1
#endif

#define DI __device__ __forceinline__
#define GAS __attribute__((address_space(1)))
#define LAS __attribute__((address_space(3)))
typedef unsigned short bf16;
typedef unsigned v4u __attribute__((ext_vector_type(4)));
typedef unsigned v2u __attribute__((ext_vector_type(2)));
typedef float f32x2 __attribute__((ext_vector_type(2)));
typedef float f32x4 __attribute__((ext_vector_type(4)));
typedef float f32x16 __attribute__((ext_vector_type(16)));
typedef short bf16x8 __attribute__((ext_vector_type(8)));
typedef short s16x4 __attribute__((ext_vector_type(4)));
typedef __bf16 bf2_t __attribute__((ext_vector_type(2)));

DI unsigned pk2(float lo, float hi) { f32x2 v = {lo, hi}; return __builtin_bit_cast(unsigned, __builtin_convertvector(v, bf2_t)); }
DI float bflo(unsigned w) { return __uint_as_float(w << 16); }
DI float bfhi(unsigned w) { return __uint_as_float(w & 0xffff0000u); }
DI float sigm(float x) { return __builtin_amdgcn_rcpf(1.0f + __expf(-x)); }
DI float silu_f(float x) { return x * sigm(x); }
DI float gelu_tanh_f(float x) { const float u = 0.7978845608028654f * (x + 0.044715f * x * x * x); return x * sigm(2.0f * u); }
DI float wave_sum(float v) {
#pragma unroll
    for (int o = 1; o < 64; o <<= 1) v += __shfl_xor(v, o);
    return v;
}
#define LDS_WAIT() asm volatile("s_waitcnt lgkmcnt(0)" ::: "memory")
#define VM_WAIT() asm volatile("s_waitcnt vmcnt(0)" ::: "memory")

constexpr int D = 1024, NTOK = 12288, NCTX = 8192, TCTX = 256, TLAT = 1024;
constexpr int INC = 4096, DFF = 4096, NCH = NTOK / 32;
constexpr float EPS = 1e-6f;
constexpr int NWAVES = 8;

constexpr size_t MiB = 1u << 20;
constexpr size_t WS_CTL = 0, CTL_ZERO_BYTES = 64 * 1024;
constexpr size_t WS_WIN = 1 * MiB, WS_WOUT = 9 * MiB, WS_WFF1 = 11 * MiB, WS_WFF2 = 19 * MiB;
constexpr size_t WS_MOD = 27 * MiB;
constexpr size_t WS_WL = 27 * MiB + 256 * 1024;
constexpr size_t WS_ACT = 28 * MiB;
constexpr size_t WS_XS = 52 * MiB;
constexpr size_t WS_QF = 68 * MiB;
constexpr size_t WS_OF = 68 * MiB, WS_OB = 80 * MiB, WS_HF = 92 * MiB, WS_HB = 104 * MiB;
constexpr size_t WS_V = 116 * MiB;
constexpr size_t WS_GL = 128 * MiB;
constexpr size_t WS_LX = 152 * MiB;
constexpr size_t WS_QE = 164 * MiB, WS_KE = 188 * MiB;
constexpr size_t WS_KDT = 212 * MiB;
constexpr size_t WS_DEC = 236 * MiB;
constexpr size_t WS_VT = 238 * MiB;
constexpr size_t WS_HID = 68 * MiB;
constexpr size_t WS_END = 250 * MiB;

constexpr int RING_OFF = 0, RING_BYTES = 131072;
constexpr int LDSCTL_OFF = RING_BYTES;
constexpr int CT_OFF = RING_BYTES + 1024;
constexpr int LDS_BYTES = 160 * 1024;
static_assert(CT_OFF + 5 * 1024 * 4 <= LDS_BYTES, "LDS map");

#define XB_TMO      128
#define XB_XCNT(j)  (256  + 64 * (j))
#define XB_XSUB(j)  (1280 + 64 * (j))
#define XB_XGEN(j)  (2304 + 64 * (j))
#define XB_TOP      3328
#define XB_TOPGEN   3392
#define XCD_BAR_WORDS 3456
#define XB_SPIN_CAP (1u << 18)
static_assert(XCD_BAR_WORDS * 4 <= CTL_ZERO_BYTES, "barrier words inside the memset region");

DI unsigned xb_ld(unsigned* p)              { return __hip_atomic_load(p, __ATOMIC_RELAXED, __HIP_MEMORY_SCOPE_AGENT); }
DI unsigned xb_add(unsigned* p, unsigned v) { return __hip_atomic_fetch_add(p, v, __ATOMIC_RELAXED, __HIP_MEMORY_SCOPE_AGENT); }
DI unsigned xb_xcc_id() { return (unsigned)__builtin_amdgcn_s_getreg((3 << 11) | 20) & 0xFu; }
#define XB_SPIN(cond, bar) do { unsigned _sp = 0; while (cond) { __builtin_amdgcn_s_sleep(1); \
    if ((++_sp & 255u) == 0u) { if (xb_ld(&(bar)[XB_TMO])) break; if (_sp > XB_SPIN_CAP) { atomicAdd(&(bar)[XB_TMO], 1u); break; } } } } while (0)

struct XcdBarrier { unsigned* bar; unsigned x; volatile LAS unsigned* st; };

DI XcdBarrier xcd_barrier_post(unsigned* bar, volatile LAS unsigned* st) {
    XcdBarrier b; b.bar = bar; b.x = xb_xcc_id(); b.st = st;
    if (threadIdx.x == 0) (void)xb_add(&bar[XB_XCNT(b.x)], 1u);
    return b;
}
DI void xcd_barrier_complete(unsigned* bar, unsigned x, unsigned& nloc, unsigned& nx) {
    const unsigned G = gridDim.x * gridDim.y * gridDim.z;
    unsigned sum, cnt, mine, sp = 0u;
    for (;;) {
        sum = 0u; cnt = 0u; mine = 0u;
#pragma unroll
        for (unsigned j = 0; j < 16; ++j) { const unsigned c = xb_ld(&bar[XB_XCNT(j)]); sum += c; cnt += (c > 0u) ? 1u : 0u; mine = (j == x) ? c : mine; }
        if (sum == G) break;
        __builtin_amdgcn_s_sleep(1);
        if ((++sp & 255u) == 0u) { if (xb_ld(&bar[XB_TMO])) break; if (sp > XB_SPIN_CAP) { atomicAdd(&bar[XB_TMO], 1u); break; } }
    }
    nloc = mine > 0u ? mine : 1u; nx = cnt > 0u ? cnt : 1u;
}
DI void xcd_barrier(const XcdBarrier& b) {
    asm volatile("s_waitcnt vmcnt(0)" ::: "memory");
    __syncthreads();
    if (threadIdx.x == 0) {
        unsigned* bar = b.bar;
        __builtin_amdgcn_s_waitcnt(0);
        unsigned nloc = b.st[0], nx = b.st[1];
        if (nloc == 0u) { xcd_barrier_complete(bar, b.x, nloc, nx); b.st[0] = nloc; b.st[1] = nx; }
        const unsigned old = xb_add(&bar[XB_XSUB(b.x)], 1u);
        const unsigned gen = old / nloc;
        if (old + 1u == (gen + 1u) * nloc) {
            __builtin_amdgcn_fence(__ATOMIC_RELEASE, "agent");
            asm volatile("s_waitcnt vmcnt(0)" ::: "memory");
            const unsigned og = xb_add(&bar[XB_TOP], 1u);
            const unsigned tg = og / nx;
            if (og + 1u == (tg + 1u) * nx) xb_add(&bar[XB_TOPGEN], 1u);
            else XB_SPIN(xb_ld(&bar[XB_TOPGEN]) == tg, bar);
            __builtin_amdgcn_fence(__ATOMIC_ACQUIRE, "agent");
            xb_add(&bar[XB_XGEN(b.x)], 1u);
            asm volatile("s_waitcnt vmcnt(0)" ::: "memory");
        } else {
            XB_SPIN(xb_ld(&bar[XB_XGEN(b.x)]) == gen, bar);
            __builtin_amdgcn_fence(__ATOMIC_ACQUIRE, "agent");
            asm volatile("s_waitcnt vmcnt(0)" ::: "memory");
        }
    }
    __syncthreads();
}

namespace pg8 {
#define PG8_LAS __attribute__((address_space(3)))
typedef unsigned short bf16_t;
typedef short bf16x8 __attribute__((ext_vector_type(8)));
typedef float f32x4 __attribute__((ext_vector_type(4)));
typedef unsigned u32x4 __attribute__((ext_vector_type(4)));
constexpr int BM = 256, BK = 64, HALF = 128, HTB = HALF * BK * 2  , STAGE_BYTES = 8 * HTB, NXCD = 8, WGM = 8;

__host__ __device__ __forceinline__ int lds_byte(int r, int c) { const int st = (r >> 4) * 2 + (c >> 5), rr = r & 15, cc = c & 31, ob = rr * 64 + cc * 2; return st * 1024 + (ob ^ (((ob >> 9) & 1) << 5)); }
__host__ __device__ __forceinline__ void stage_rc(int b, int& R, int& C) { const int st = b / 1024, sb = b % 1024, swz = sb ^ (((sb >> 9) & 1) << 5); R = (st >> 1) * 16 + swz / 64; C = (st & 1) * 32 + (swz % 64) / 2; }
__host__ __device__ __forceinline__ int perm32(int rho) { const int n = rho >> 4, i = rho & 15; return 8 * (i >> 2) + 4 * n + (i & 3); }

struct Unit { int pm, pn; };
struct Gemm { const bf16_t* A; const bf16_t* Bt; int M, N, K; };

struct StaticOrder {
    int nM, nN, nwg, G, c;
    __host__ __device__ void init(int M, int N, int G_, int c_) { nM = M / BM; nN = N / BM; nwg = nM * nN; G = G_; c = c_; }
    __host__ __device__ bool next(int i, Unit& u) const {
        const long L = (long)i * G + c; if (L >= nwg) return false;
        int wgid = (int)L; { const int q = nwg / NXCD, r = nwg % NXCD, xcd = wgid % NXCD, off = wgid / NXCD; wgid = (xcd < r ? xcd * (q + 1) : r * (q + 1) + (xcd - r) * q) + off; }
        const int nig = WGM * nN, gid = wgid / nig, fm = gid * WGM, gsz = (nM - fm) < WGM ? (nM - fm) : WGM;
        u.pm = fm + ((wgid % nig) % gsz); u.pn = (wgid % nig) / gsz; return true;
    }
    __device__ __forceinline__ void a_ready(const Unit&) const {}
    __device__ __forceinline__ void done(const Unit&) const {}
};

__device__ __forceinline__ unsigned cvt_pk_bf16(float lo, float hi) { return pk2(lo, hi); }
__device__ __forceinline__ int cond_of_pm(int pm) { return pm < 32 ? 0 : 1 + ((pm - 32) >> 2); }

struct EpiRoute {
    static constexpr bool PERM = true, AFTER_DRAIN = false;
    bf16_t *QF, *V, *GL, *LX;
    __device__ __forceinline__ void operator()(const f32x4 (&acc)[2][2][4][2], const Unit& u, int wr, int wc, int fr, int fq) const {
        const int pn = u.pn; bf16_t* base; int ldc, colt;
        if (pn < 8) { base = QF; ldc = 2048; colt = pn * 256; }
        else if (pn < 10) { base = V; ldc = 512; colt = (pn - 8) * 256; }
        else if (pn < 12) { base = GL; ldc = 1024; colt = (pn - 10) * 256; }
        else if (pn < 14) { base = LX; ldc = 512; colt = (pn - 12) * 256; }
        else { base = GL; ldc = 1024; colt = 512 + (pn - 14) * 256; }
        const int row0 = u.pm * BM + wr * 64 + fr, col0 = colt + wc * 32 + 8 * fq;
#pragma unroll
        for (int ai = 0; ai < 2; ++ai)
#pragma unroll
            for (int m = 0; m < 4; ++m) { bf16_t* rowp = base + (size_t)(row0 + ai * HALF + m * 16) * ldc + col0;
#pragma unroll
                for (int bj = 0; bj < 2; ++bj) { const f32x4 v0 = acc[ai][bj][m][0], v1 = acc[ai][bj][m][1];
                    u32x4 w; w.x = cvt_pk_bf16(v0[0], v0[1]); w.y = cvt_pk_bf16(v0[2], v0[3]); w.z = cvt_pk_bf16(v1[0], v1[1]); w.w = cvt_pk_bf16(v1[2], v1[3]);
                    *(u32x4*)(rowp + bj * HALF) = w; } }
    }
};
struct EpiRelu2 {
    static constexpr bool PERM = true, AFTER_DRAIN = false;
    bf16_t* O; int ldc;
    __device__ __forceinline__ void operator()(const f32x4 (&acc)[2][2][4][2], const Unit& u, int wr, int wc, int fr, int fq) const {
        const int row0 = u.pm * BM + wr * 64 + fr, col0 = u.pn * BM + wc * 32 + 8 * fq;
#pragma unroll
        for (int ai = 0; ai < 2; ++ai)
#pragma unroll
            for (int m = 0; m < 4; ++m) { bf16_t* rowp = O + (size_t)(row0 + ai * HALF + m * 16) * ldc + col0;
#pragma unroll
                for (int bj = 0; bj < 2; ++bj) { f32x4 v0 = acc[ai][bj][m][0], v1 = acc[ai][bj][m][1];
#pragma unroll
                    for (int j = 0; j < 4; ++j) { const float a = fmaxf(v0[j], 0.f), b = fmaxf(v1[j], 0.f); v0[j] = a * a; v1[j] = b * b; }
                    u32x4 w; w.x = cvt_pk_bf16(v0[0], v0[1]); w.y = cvt_pk_bf16(v0[2], v0[3]); w.z = cvt_pk_bf16(v1[0], v1[1]); w.w = cvt_pk_bf16(v1[2], v1[3]);
                    *(u32x4*)(rowp + bj * HALF) = w; } }
    }
};
struct EpiResid {
    static constexpr bool PERM = false, AFTER_DRAIN = false;
    const float* resA; const float* resB; float* out; const float* gate;
    __device__ __forceinline__ void operator()(const f32x4 (&acc)[2][2][4][2], const Unit& u, int wr, int wc, int fr, int fq) const {
        const int row0 = u.pm * BM + wr * 64 + fr, col0 = u.pn * BM + wc * 32 + 4 * fq;
        const float* g = gate + cond_of_pm(u.pm) * 6144 + col0;
        const float* res = (u.pm < 32) ? resA + (size_t)row0 * 1024 : resB + (size_t)(row0 - 8192) * 1024;
        f32x4 gv[2][2];
#pragma unroll
        for (int bj = 0; bj < 2; ++bj)
#pragma unroll
            for (int n = 0; n < 2; ++n) gv[bj][n] = *(const f32x4*)(g + bj * HALF + n * 16);
#pragma unroll
        for (int ai = 0; ai < 2; ++ai)
#pragma unroll
            for (int m = 0; m < 4; ++m) { const size_t ro = (size_t)(ai * HALF + m * 16) * 1024 + col0; float* rowp = out + (size_t)row0 * 1024 + ro;
#pragma unroll
                for (int bj = 0; bj < 2; ++bj)
#pragma unroll
                    for (int n = 0; n < 2; ++n) { const f32x4 rv = *(const f32x4*)(res + ro + bj * HALF + n * 16); *(f32x4*)(rowp + bj * HALF + n * 16) = rv + gv[bj][n] * acc[ai][bj][m][n]; } }
    }
};

template <class Epi, class Sched, bool ALIGN_EPI = false, bool SP2 = false>
__device__ __forceinline__ void gemm_phase(PG8_LAS unsigned char* lds, const Gemm g, const Sched& S, const Epi& E) {
    const int tid = threadIdx.x, wid = __builtin_amdgcn_readfirstlane(tid >> 6), lane = tid & 63, wr = wid >> 2, wc = wid & 3, fr = lane & 15, fq = lane >> 4;
    const int K = g.K, nt = K / BK;
    unsigned voffA[2], voffB[2];
#pragma unroll
    for (int i = 0; i < 2; ++i) { int R, C; stage_rc(tid * 16 + i * 8192, R, C); const int Rb = Epi::PERM ? ((R & ~31) + perm32(R & 31)) : R;
        voffA[i] = (unsigned)(R * K + C) * 2u; voffB[i] = (unsigned)(Rb * K + C) * 2u; }
    const size_t kstep = (size_t)(BK * 2);
    const size_t hstep = (size_t)HALF * K * 2;
    const size_t tstep = 2 * hstep;
    const unsigned ldsw = (unsigned)wid * 1024u;
    const int aoff = lds_byte(wr * 64 + fr, fq * 8), boff = lds_byte(wc * 32 + fr, fq * 8);
#define PG8_SA(b, h) (((b) * 2 + (h)) * HTB)
#define PG8_SB(b, h) ((4 + (b) * 2 + (h)) * HTB)
#define PG8_STAGE(bufoff, gbase, voff) do { _Pragma("unroll") for (int _i = 0; _i < 2; ++_i) \
        __builtin_amdgcn_global_load_lds((const unsigned*)((const char*)(gbase) + (voff)[_i]), (PG8_LAS unsigned*)(lds + (bufoff) + ldsw + _i * 8192), 16, 0, 0); } while (0)
#define PG8_LDA(dst, b, h) do { _Pragma("unroll") for (int m = 0; m < 4; ++m) _Pragma("unroll") for (int k = 0; k < 2; ++k) dst[m][k] = *(const PG8_LAS bf16x8*)(lds + PG8_SA(b, h) + aoff + m * 2048 + k * 1024); } while (0)
#define PG8_LDB(dst, b, h) do { _Pragma("unroll") for (int n = 0; n < 2; ++n) _Pragma("unroll") for (int k = 0; k < 2; ++k) dst[n][k] = *(const PG8_LAS bf16x8*)(lds + PG8_SB(b, h) + boff + n * 2048 + k * 1024); } while (0)
#define PG8_MMA(ai, bj, At, Bt) do { __builtin_amdgcn_s_setprio(1); _Pragma("unroll") for (int m = 0; m < 4; ++m) _Pragma("unroll") for (int n = 0; n < 2; ++n) _Pragma("unroll") for (int k = 0; k < 2; ++k) \
        acc[ai][bj][m][n] = __builtin_amdgcn_mfma_f32_16x16x32_bf16(Bt[n][k], At[m][k], acc[ai][bj][m][n], 0, 0, 0); __builtin_amdgcn_s_setprio(0); } while (0)
#define PG8_WAIT_V(n) asm volatile("s_waitcnt vmcnt(" #n ")" ::: "memory")
#define PG8_WAIT_L(n) asm volatile("s_waitcnt lgkmcnt(" #n ")" ::: "memory")
#define PG8_BAR __builtin_amdgcn_s_barrier()
#define PG8_SCHED __builtin_amdgcn_sched_barrier(0)
    Unit cur, nxt; int ui = 0;
    if (!S.next(0, cur)) return;
    f32x4 acc[2][2][4][2];
#pragma unroll
    for (int a = 0; a < 2; ++a)
#pragma unroll
        for (int b = 0; b < 2; ++b)
#pragma unroll
            for (int m = 0; m < 4; ++m)
#pragma unroll
                for (int n = 0; n < 2; ++n) acc[a][b][m][n] = (f32x4){0.f, 0.f, 0.f, 0.f};
    bf16x8 At[4][2], B0[2][2], B1[2][2];
    const char* cA = (const char*)g.A + (size_t)cur.pm * tstep; const char* cB = (const char*)g.Bt + (size_t)cur.pn * tstep;
    S.a_ready(cur);
    if constexpr (SP2) {
        PG8_STAGE(PG8_SB(0, 0), cB, voffB); PG8_STAGE(PG8_SB(0, 1), cB + hstep, voffB); PG8_STAGE(PG8_SA(0, 0), cA, voffA); PG8_STAGE(PG8_SA(0, 1), cA + hstep, voffA);
        if (wr == 1) PG8_BAR;
        PG8_WAIT_V(2); PG8_BAR;
        PG8_STAGE(PG8_SB(1, 0), cB + kstep, voffB); PG8_STAGE(PG8_SA(1, 0), cA + kstep, voffA); PG8_STAGE(PG8_SB(1, 1), cB + hstep + kstep, voffB);
        PG8_WAIT_V(6); PG8_BAR;
    } else {
        PG8_STAGE(PG8_SB(0, 0), cB, voffB); PG8_STAGE(PG8_SA(0, 0), cA, voffA); PG8_STAGE(PG8_SB(0, 1), cB + hstep, voffB); PG8_STAGE(PG8_SA(0, 1), cA + hstep, voffA);
        if (wr == 1) PG8_BAR;
        PG8_WAIT_V(4); PG8_BAR;
        PG8_STAGE(PG8_SB(1, 0), cB + kstep, voffB); PG8_STAGE(PG8_SA(1, 0), cA + kstep, voffA); PG8_STAGE(PG8_SB(1, 1), cB + hstep + kstep, voffB);
        PG8_WAIT_V(6); PG8_BAR;
    }
    for (;;) {
        const bool has_next = S.next(ui + 1, nxt);
        const char* nA = has_next ? (const char*)g.A + (size_t)nxt.pm * tstep : cA; const char* nB = has_next ? (const char*)g.Bt + (size_t)nxt.pn * tstep : cB;
        for (int t = 0; t < nt; t += 2) {
            const bool last = (t == nt - 2);
            const char* a1 = cA + (size_t)(t + 1) * kstep;
            const char* a2 = last ? nA : cA + (size_t)(t + 2) * kstep; const char* b2 = last ? nB : cB + (size_t)(t + 2) * kstep;
            const char* a3 = a2 + kstep; const char* b3 = b2 + kstep;
            if (last && has_next) S.a_ready(nxt);
            if constexpr (SP2) {
            PG8_LDB(B0, 0, 0); PG8_LDB(B1, 0, 1); PG8_SCHED; PG8_LDA(At, 0, 0); PG8_STAGE(PG8_SA(1, 1), a1 + hstep, voffA);
            PG8_WAIT_V(8); PG8_WAIT_L(0); PG8_BAR; PG8_MMA(0, 0, At, B0); PG8_MMA(0, 1, At, B1); PG8_BAR; PG8_SCHED;
            PG8_LDA(At, 0, 1); PG8_STAGE(PG8_SB(0, 0), b2, voffB); PG8_STAGE(PG8_SB(0, 1), b2 + hstep, voffB); PG8_STAGE(PG8_SA(0, 0), a2, voffA);
            PG8_WAIT_V(8); PG8_WAIT_L(0); PG8_BAR; PG8_MMA(1, 0, At, B0); PG8_MMA(1, 1, At, B1); PG8_BAR; PG8_SCHED;
            PG8_LDB(B0, 1, 0); PG8_LDB(B1, 1, 1); PG8_SCHED; PG8_LDA(At, 1, 0); PG8_STAGE(PG8_SA(0, 1), a2 + hstep, voffA);
            PG8_WAIT_V(8); PG8_WAIT_L(0); PG8_BAR; PG8_MMA(0, 0, At, B0); PG8_MMA(0, 1, At, B1); PG8_BAR; PG8_SCHED;
            PG8_LDA(At, 1, 1); PG8_STAGE(PG8_SB(1, 0), b3, voffB); PG8_STAGE(PG8_SB(1, 1), b3 + hstep, voffB); PG8_STAGE(PG8_SA(1, 0), a3, voffA);
            PG8_WAIT_V(8); PG8_WAIT_L(0); PG8_BAR; PG8_MMA(1, 0, At, B0); PG8_MMA(1, 1, At, B1); PG8_BAR; PG8_SCHED;
            } else {
            PG8_LDB(B0, 0, 0); PG8_SCHED; PG8_LDA(At, 0, 0); PG8_STAGE(PG8_SA(1, 1), a1 + hstep, voffA);
            PG8_WAIT_L(8); PG8_BAR; PG8_WAIT_L(0); PG8_MMA(0, 0, At, B0); PG8_BAR; PG8_SCHED;
            PG8_LDB(B1, 0, 1); PG8_STAGE(PG8_SB(0, 0), b2, voffB);
            PG8_BAR; PG8_WAIT_L(0); PG8_MMA(0, 1, At, B1); PG8_BAR;
            PG8_LDA(At, 0, 1); PG8_STAGE(PG8_SA(0, 0), a2, voffA);
            PG8_BAR; PG8_WAIT_L(0); PG8_MMA(1, 0, At, B0); PG8_BAR; PG8_SCHED;
            PG8_STAGE(PG8_SB(0, 1), b2 + hstep, voffB);
            PG8_WAIT_V(6); PG8_BAR; PG8_MMA(1, 1, At, B1); PG8_BAR;
            PG8_LDB(B0, 1, 0); PG8_SCHED; PG8_LDA(At, 1, 0); PG8_STAGE(PG8_SA(0, 1), a2 + hstep, voffA);
            PG8_WAIT_L(8); PG8_BAR; PG8_WAIT_L(0); PG8_MMA(0, 0, At, B0); PG8_BAR; PG8_SCHED;
            PG8_LDB(B1, 1, 1); PG8_STAGE(PG8_SB(1, 0), b3, voffB);
            PG8_BAR; PG8_WAIT_L(0); PG8_MMA(0, 1, At, B1); PG8_BAR;
            PG8_LDA(At, 1, 1); PG8_STAGE(PG8_SA(1, 0), a3, voffA);
            PG8_BAR; PG8_WAIT_L(0); PG8_MMA(1, 0, At, B0); PG8_BAR; PG8_SCHED;
            PG8_STAGE(PG8_SB(1, 1), b3 + hstep, voffB);
            PG8_WAIT_V(6); PG8_BAR; PG8_MMA(1, 1, At, B1); PG8_BAR;
            }
        }
        if constexpr (ALIGN_EPI) { if (wr == 0) PG8_BAR; }
        if constexpr (!Epi::AFTER_DRAIN) { E(acc, cur, wr, wc, fr, fq); S.done(cur); }
        if (!has_next) break;
#pragma unroll
        for (int a = 0; a < 2; ++a)
#pragma unroll
            for (int b = 0; b < 2; ++b)
#pragma unroll
                for (int m = 0; m < 4; ++m)
#pragma unroll
                    for (int n = 0; n < 2; ++n) acc[a][b][m][n] = (f32x4){0.f, 0.f, 0.f, 0.f};
        cur = nxt; cA = nA; cB = nB; ++ui;
        if constexpr (ALIGN_EPI) { if (wr == 1) PG8_BAR; }
    }
    PG8_WAIT_V(0);
    if constexpr (!ALIGN_EPI) { if (wr == 0) PG8_BAR; }
    PG8_BAR;
    if constexpr (Epi::AFTER_DRAIN) { E.fused(acc, cur, wr, wc, fr, fq, lds, wid, lane); S.done(cur); }
#undef PG8_SA
#undef PG8_SB
#undef PG8_STAGE
#undef PG8_LDA
#undef PG8_LDB
#undef PG8_MMA
#undef PG8_WAIT_V
#undef PG8_WAIT_L
#undef PG8_BAR
#undef PG8_SCHED
}
}

#ifndef PG8_SP2
#define PG8_SP2 true
#endif
#ifndef PG8_ALIGN
#define PG8_ALIGN true
#endif

struct Frame {
    LAS unsigned char* lds;
    int tid, lane, wave, vcu, G;
    const float *x_prompt, *x_sample, *cvec, *state_hgrn, *state_rglru, *c_ctx, *w_ada, *b_ada, *norm1_gain, *norm2_gain, *w_in, *lb_logits, *hg_norm_gain,
                *conv_w, *conv_b, *lru_wa, *lru_ba, *lru_wx, *lru_bx, *lru_lambda, *w_out, *w_ff1, *w_ff2, *final_gain;
    float* out;
    bf16 *Win_t, *Wout_t, *Wff1_t, *Wff2_t, *WL;
    float* MOD; float* XS; float* DEC;
    bf16 *ACT, *QF, *V, *GL, *LX, *QE, *KE, *KDT, *VT, *OF, *OB, *HF, *HB, *HID;
    unsigned* GATES;
};
constexpr size_t OUT_SHG = (size_t)NTOK * 1024, OUT_SLRU = OUT_SHG + (size_t)32 * 2 * 4 * 128 * 128;

DI void p0_transpose_item(const float* W, int K, int N, bf16* WT, LAS float* scr, int item, int lane) {
    const int nblk = N / 32, kb = item / nblk, nb = item % nblk, k0 = 64 * kb, n0 = 32 * nb;
#pragma unroll 8
    for (int i = 0; i < 32; ++i) { const int kk = 2 * i + (lane >> 5); scr[kk * 33 + (lane & 31)] = W[(size_t)(k0 + kk) * N + n0 + (lane & 31)]; }
    LDS_WAIT(); asm volatile("" ::: "memory");
    const int c = lane & 7;
#pragma unroll
    for (int j = 0; j < 4; ++j) { const int n = (lane >> 3) + 8 * j; const LAS float* s = scr + (8 * c) * 33 + n;
        v4u o; o.x = pk2(s[0 * 33], s[1 * 33]); o.y = pk2(s[2 * 33], s[3 * 33]); o.z = pk2(s[4 * 33], s[5 * 33]); o.w = pk2(s[6 * 33], s[7 * 33]);
        *(GAS v4u*)(WT + (size_t)(n0 + n) * K + k0 + 8 * c) = o; }
    LDS_WAIT(); asm volatile("" ::: "memory");
}
DI void p0_prologue(Frame& F) {
    LAS float* ct = (LAS float*)(F.lds + CT_OFF);
    for (int i = F.tid; i < 5 * 1024; i += NWAVES * 64) { const int j = i >> 10, k = i & 1023; const float c = (j == 0) ? F.c_ctx[k] : F.cvec[(j - 1) * 1024 + k]; ct[i] = silu_f(c); }
    __syncthreads();
    LAS float* scr = (LAS float*)(F.lds + RING_OFF + F.wave * 16384);
    const int gw = F.wave * F.G + F.vcu, NGW = F.G * NWAVES;
    constexpr int I_GEMV = 6144 / 16, I_WL = 32, I_IN = (D / 64) * (INC / 32), I_OUT = (D / 64) * (D / 32), I_F1 = (D / 64) * (DFF / 32), I_F2 = (DFF / 64) * (D / 32);
    constexpr int NITEMS = I_GEMV + I_WL + I_IN + I_OUT + I_F1 + I_F2;
    for (int it = gw; it < NITEMS; it += NGW) {
        int r = it;
        if (r < I_GEMV) {
            const int n0 = 16 * r, col = F.lane & 15, kq = F.lane >> 4;
            const float* wp = F.w_ada + n0 + col;
            float acc[5] = {0.f, 0.f, 0.f, 0.f, 0.f};
            for (int k = kq; k < 1024; k += 32) {
                float w[8];
#pragma unroll
                for (int u = 0; u < 8; ++u) w[u] = wp[(size_t)(k + 4 * u) * 6144];
#pragma unroll
                for (int u = 0; u < 8; ++u)
#pragma unroll
                    for (int j = 0; j < 5; ++j) acc[j] += ct[j * 1024 + k + 4 * u] * w[u];
            }
#pragma unroll
            for (int j = 0; j < 5; ++j) { acc[j] += __shfl_xor(acc[j], 16); acc[j] += __shfl_xor(acc[j], 32); }
            if (kq == 0) { const float b = F.b_ada[n0 + col];
#pragma unroll
                for (int j = 0; j < 5; ++j) F.MOD[j * 6144 + n0 + col] = acc[j] + b; }
            continue;
        }
        r -= I_GEMV;
        if (r < I_WL) {
            const int mat = r >> 4; const float* src = (mat ? F.lru_wx : F.lru_wa) + (size_t)(r & 15) * 4096; bf16* dst = F.WL + (size_t)r * 4096;
            for (int e = F.lane; e < 4096; e += 64) { const int o = e >> 6, i = e & 63; dst[o * 64 + i] = (bf16)(pk2(src[i * 64 + o], 0.f) & 0xffffu); }
            continue;
        }
        r -= I_WL;
        if (r < I_IN) { p0_transpose_item(F.w_in, D, INC, F.Win_t, scr, r, F.lane); continue; } r -= I_IN;
        if (r < I_OUT) { p0_transpose_item(F.w_out, D, D, F.Wout_t, scr, r, F.lane); continue; } r -= I_OUT;
        if (r < I_F1) { p0_transpose_item(F.w_ff1, D, DFF, F.Wff1_t, scr, r, F.lane); continue; } r -= I_F1;
        p0_transpose_item(F.w_ff2, DFF, D, F.Wff2_t, scr, r, F.lane);
    }
}

DI int cond_of_row(int m) { return m < NCTX ? 0 : 1 + ((m - NCTX) >> 10); }
DI void store_row_bf16(bf16* orow, int lane, const f32x4 (&v)[4]) {
    GAS v2u* o8 = (GAS v2u*)orow + lane;
#pragma unroll
    for (int j = 0; j < 4; ++j) { v2u w; w.x = pk2(v[j].x, v[j].y); w.y = pk2(v[j].z, v[j].w); o8[64 * j] = w; }
}
DI void p1_rows(Frame& F) {
    const int gw = F.vcu * NWAVES + F.wave, NGW = F.G * NWAVES;
    for (int m = gw; m < NTOK; m += NGW) {
        const float* xrow = m < NCTX ? F.x_prompt + (size_t)m * D : F.x_sample + (size_t)(m - NCTX) * D;
        const GAS f32x4* xr = (const GAS f32x4*)xrow + F.lane;
        f32x4 v[4];
#pragma unroll
        for (int j = 0; j < 4; ++j) v[j] = xr[64 * j];
        if (m >= NCTX) {
            const int t = (m - NCTX) & 1023; const float rr = (float)(t >> 6), cc = (float)(t & 63);
#pragma unroll
            for (int e = 0; e < 4; ++e) {
                const float om = exp2f(-(float)(4 * F.lane + e) * (13.287712379549449f / 256.0f));
                const float ar = rr * om * 0.15915494309189535f, ac = cc * om * 0.15915494309189535f;
                v[0][e] += __builtin_amdgcn_sinf(ar); v[1][e] += __builtin_amdgcn_cosf(ar); v[2][e] += __builtin_amdgcn_sinf(ac); v[3][e] += __builtin_amdgcn_cosf(ac);
            }
            GAS f32x4* xo = (GAS f32x4*)(F.XS + (size_t)(m - NCTX) * D) + F.lane;
#pragma unroll
            for (int j = 0; j < 4; ++j) xo[64 * j] = v[j];
        }
        float s = 0.f;
#pragma unroll
        for (int j = 0; j < 4; ++j) s += (v[j].x * v[j].x + v[j].y * v[j].y) + (v[j].z * v[j].z + v[j].w * v[j].w);
        const float rstd = 1.0f / sqrtf(wave_sum(s) * (1.f / D) + EPS);
        const float* mod = F.MOD + cond_of_row(m) * 6144;
#pragma unroll
        for (int j = 0; j < 4; ++j) {
            const int c = 256 * j + 4 * F.lane;
            const f32x4 g = *(const f32x4*)(F.norm1_gain + c), sh = *(const f32x4*)(mod + c), sc = *(const f32x4*)(mod + 1024 + c);
            v[j] = v[j] * rstd * g * (1.0f + sc) + sh;
        }
        store_row_bf16(F.ACT + (size_t)m * D, F.lane, v);
    }
}
DI void p7_rows(Frame& F) {
    const int gw = F.vcu * NWAVES + F.wave, NGW = F.G * NWAVES;
    for (int m = gw; m < NTOK; m += NGW) {
        const GAS f32x4* xr = (const GAS f32x4*)(F.out + (size_t)m * D) + F.lane;
        f32x4 v[4]; float s = 0.f;
#pragma unroll
        for (int j = 0; j < 4; ++j) { v[j] = xr[64 * j]; s += (v[j].x * v[j].x + v[j].y * v[j].y) + (v[j].z * v[j].z + v[j].w * v[j].w); }
        const float rstd = 1.0f / sqrtf(wave_sum(s) * (1.f / D) + EPS);
        const float* mod = F.MOD + cond_of_row(m) * 6144;
#pragma unroll
        for (int j = 0; j < 4; ++j) {
            const int c = 256 * j + 4 * F.lane;
            const f32x4 g = *(const f32x4*)(F.norm2_gain + c), sh = *(const f32x4*)(mod + 3072 + c), sc = *(const f32x4*)(mod + 4096 + c);
            v[j] = v[j] * rstd * g * (1.0f + sc) + sh;
        }
        store_row_bf16(F.ACT + (size_t)m * D, F.lane, v);
    }
}
DI void p10_rows(Frame& F) {
    const int gw = F.vcu * NWAVES + F.wave, NGW = F.G * NWAVES;
    for (int m = gw; m < NTOK; m += NGW) {
        GAS f32x4* xr = (GAS f32x4*)(F.out + (size_t)m * D) + F.lane;
        f32x4 v[4]; float s = 0.f;
#pragma unroll
        for (int j = 0; j < 4; ++j) { v[j] = xr[64 * j]; s += (v[j].x * v[j].x + v[j].y * v[j].y) + (v[j].z * v[j].z + v[j].w * v[j].w); }
        const float rstd = 1.0f / sqrtf(wave_sum(s) * (1.f / D) + EPS);
#pragma unroll
        for (int j = 0; j < 4; ++j) { const f32x4 g = *(const f32x4*)(F.final_gain + 256 * j + 4 * F.lane); xr[64 * j] = v[j] * rstd * g; }
    }
}
DI void p5_rows(Frame& F) {
    const int gw = F.vcu * NWAVES + F.wave, NGW = F.G * NWAVES;
    const int c8 = 8 * F.lane;
    for (int m = gw; m < NTOK; m += NGW) {
        const v4u a = *(const GAS v4u*)(F.OF + (size_t)m * 512 + c8), b = *(const GAS v4u*)(F.OB + (size_t)m * 512 + c8);
        const v4u gt = *(const GAS v4u*)(F.GL + (size_t)m * 1024 + c8), lg = *(const GAS v4u*)(F.GL + (size_t)m * 1024 + 512 + c8);
        const v4u hf = *(const GAS v4u*)(F.HF + (size_t)m * 512 + c8), hb = *(const GAS v4u*)(F.HB + (size_t)m * 512 + c8);
        float o[8], s = 0.f;
#pragma unroll
        for (int j = 0; j < 4; ++j) { o[2 * j] = bflo(a[j]) + bflo(b[j]); o[2 * j + 1] = bfhi(a[j]) + bfhi(b[j]); s += o[2 * j] * o[2 * j] + o[2 * j + 1] * o[2 * j + 1]; }
        s += __shfl_xor(s, 1); s += __shfl_xor(s, 2); s += __shfl_xor(s, 4); s += __shfl_xor(s, 8);
        const float rstd = 1.0f / sqrtf(s * (1.f / 128.f) + EPS);
        const f32x4 g0 = *(const f32x4*)(F.hg_norm_gain + c8), g1 = *(const f32x4*)(F.hg_norm_gain + c8 + 4);
        v4u w1, w2;
#pragma unroll
        for (int j = 0; j < 4; ++j) {
            const float ga = (j < 2) ? g0[2 * j] : g1[2 * j - 4], gb = (j < 2) ? g0[2 * j + 1] : g1[2 * j - 3];
            w1[j] = pk2(o[2 * j] * rstd * ga * silu_f(bflo(gt[j])), o[2 * j + 1] * rstd * gb * silu_f(bfhi(gt[j])));
            w2[j] = pk2((bflo(hf[j]) + bflo(hb[j])) * gelu_tanh_f(bflo(lg[j])), (bfhi(hf[j]) + bfhi(hb[j])) * gelu_tanh_f(bfhi(lg[j])));
        }
        *(GAS v4u*)(F.ACT + (size_t)m * D + c8) = w1;
        *(GAS v4u*)(F.ACT + (size_t)m * D + 512 + c8) = w2;
    }
}

template <int DIR>
DI void hg_prep_item(Frame& F, int cg, int head) {
    const int m0 = cg * 32, k0 = 2 * F.lane, hk = head * 128 + k0, col = DIR * 512 + hk;
    const f32x2 L0 = *(const f32x2*)(F.lb_logits + DIR * 512 + hk), L1 = *(const f32x2*)(F.lb_logits + 1024 + DIR * 512 + hk);
    const float lba = __builtin_amdgcn_rcpf(1.0f + __expf(L1.x - L0.x)), lbb = __builtin_amdgcn_rcpf(1.0f + __expf(L1.y - L0.y));
    float lf0[32], lf1[32], kk0[32], kk1[32]; unsigned qw[32];
    float bl0 = 0.f, bl1 = 0.f;
#pragma unroll
    for (int i = 0; i < 32; ++i) {
        const int t = DIR ? 31 - i : i; const size_t ro = (size_t)(m0 + t) * 2048 + col;
        const unsigned fw = *(const GAS unsigned*)(F.QF + ro + 1024); qw[i] = *(const GAS unsigned*)(F.QF + ro);
        const float f0 = lba + (1.0f - lba) * sigm(bflo(fw)), f1 = lbb + (1.0f - lbb) * sigm(bfhi(fw));
        lf0[i] = __logf(f0); lf1[i] = __logf(f1); kk0[i] = 1.0f - f0; kk1[i] = 1.0f - f1;
        bl0 += lf0[i]; bl1 += lf1[i];
    }
    float b0 = 0.f, b1 = 0.f; unsigned kd0[16], kd1[16];
#pragma unroll
    for (int ip = 0; ip < 16; ++ip) {
        float d0[2], d1[2];
#pragma unroll
        for (int s = 0; s < 2; ++s) {
            const int i = 2 * ip + s, t = DIR ? 31 - i : i;
            b0 += lf0[i]; b1 += lf1[i];
            const float q0 = silu_f(bflo(qw[i])), q1 = silu_f(bfhi(qw[i]));
            const size_t oo = ((size_t)DIR * NTOK + m0 + t) * 512 + hk;
            *(GAS unsigned*)(F.QE + oo) = pk2(q0 * __expf(b0), q1 * __expf(b1));
            *(GAS unsigned*)(F.KE + oo) = pk2(kk0[i] * __expf(-b0), kk1[i] * __expf(-b1));
            d0[s] = kk0[i] * __expf(bl0 - b0); d1[s] = kk1[i] * __expf(bl1 - b1);
        }
        const int p = DIR ? 15 - ip : ip;
        kd0[p] = DIR ? pk2(d0[1], d0[0]) : pk2(d0[0], d0[1]);
        kd1[p] = DIR ? pk2(d1[1], d1[0]) : pk2(d1[0], d1[1]);
    }
    GAS v4u* r0 = (GAS v4u*)(F.KDT + ((size_t)DIR * 512 + hk) * NTOK + m0); GAS v4u* r1 = (GAS v4u*)(F.KDT + ((size_t)DIR * 512 + hk + 1) * NTOK + m0);
#pragma unroll
    for (int j = 0; j < 4; ++j) { r0[j] = (v4u){kd0[4 * j], kd0[4 * j + 1], kd0[4 * j + 2], kd0[4 * j + 3]}; r1[j] = (v4u){kd1[4 * j], kd1[4 * j + 1], kd1[4 * j + 2], kd1[4 * j + 3]}; }
    *(f32x2*)(F.DEC + ((size_t)DIR * NCH + cg) * 512 + hk) = (f32x2){__expf(bl0), __expf(bl1)};
}
DI void vt_item(Frame& F, int cg, int head) {
    const int m0 = cg * 32, hv = head * 128 + 2 * F.lane;
    unsigned w[32];
#pragma unroll
    for (int t = 0; t < 32; ++t) w[t] = *(const GAS unsigned*)(F.V + (size_t)(m0 + t) * 512 + hv);
    GAS v4u* r0 = (GAS v4u*)(F.VT + (size_t)hv * NTOK + m0); GAS v4u* r1 = (GAS v4u*)(F.VT + (size_t)(hv + 1) * NTOK + m0);
#pragma unroll
    for (int j = 0; j < 4; ++j) {
        v4u a, b;
#pragma unroll
        for (int e = 0; e < 4; ++e) { const unsigned x = w[8 * j + 2 * e], y = w[8 * j + 2 * e + 1]; a[e] = (x & 0xffffu) | (y << 16); b[e] = (x >> 16) | (y & 0xffff0000u); }
        r0[j] = a; r1[j] = b;
    }
}
#define MFMA32(a, b, c) __builtin_amdgcn_mfma_f32_32x32x16_bf16((a), (b), (c), 0, 0, 0)
DI void lru_gate_item(Frame& F, int tg, int n) {
    const int m0 = 64 * tg, r = F.lane & 31, h = F.lane >> 5;
    const int T = m0 < NCTX ? TCTX : TLAT, tseq0 = m0 < NCTX ? (m0 & (TCTX - 1)) : ((m0 - NCTX) & (TLAT - 1));
    bf16x8 xa[2][4];
#pragma unroll
    for (int ks = 0; ks < 4; ++ks) {
        const int c0 = 64 * n + 16 * ks + 8 * h;
        f32x4 w[4][2];
#pragma unroll
        for (int j = 0; j < 4; ++j) { w[j][0] = *(const f32x4*)(F.conv_w + j * 512 + c0); w[j][1] = *(const f32x4*)(F.conv_w + j * 512 + c0 + 4); }
        const f32x4 cb0 = *(const f32x4*)(F.conv_b + c0), cb1 = *(const f32x4*)(F.conv_b + c0 + 4);
#pragma unroll
        for (int mt = 0; mt < 2; ++mt) {
            const int tk = 32 * mt + r, m = m0 + tk, ts = tseq0 + tk;
            f32x4 a0 = cb0, a1 = cb1;
#pragma unroll
            for (int j = 0; j < 4; ++j) {
                const int tt = ts + j - 2; const bool ok = (tt >= 0) && (tt < T);
                const v4u lw = *(const GAS v4u*)(F.LX + (size_t)(ok ? m + j - 2 : m) * 512 + c0);
                const float z = ok ? 1.0f : 0.0f;
                a0 += (f32x4){bflo(lw.x), bfhi(lw.x), bflo(lw.y), bfhi(lw.y)} * (w[j][0] * z);
                a1 += (f32x4){bflo(lw.z), bfhi(lw.z), bflo(lw.w), bfhi(lw.w)} * (w[j][1] * z);
            }
            const v4u p = {pk2(a0.x, a0.y), pk2(a0.z, a0.w), pk2(a1.x, a1.y), pk2(a1.z, a1.w)};
            xa[mt][ks] = __builtin_bit_cast(bf16x8, p);
        }
    }
    f32x16 zero;
#pragma unroll
    for (int i = 0; i < 16; ++i) zero[i] = 0.f;
#pragma unroll
    for (int nt = 0; nt < 2; ++nt) {
        f32x16 xcC[2] = {zero, zero};
#pragma unroll
        for (int s = 0; s < 2; ++s) {
            bf16x8 bI;
#pragma unroll
            for (int j = 0; j < 8; ++j) bI[j] = (16 * s + 8 * h + j == r) ? (short)0x3F80 : (short)0;
#pragma unroll
            for (int mt = 0; mt < 2; ++mt) xcC[mt] = MFMA32(xa[mt][2 * nt + s], bI, xcC[mt]);
        }
        const int c = 64 * n + 32 * nt + r;
#pragma unroll
        for (int d = 0; d < 2; ++d) {
            f32x16 accA[2] = {zero, zero}, accX[2] = {zero, zero};
            const bf16* wa = F.WL + ((size_t)((0 * 2 + d) * 8 + n) * 64 + 32 * nt + r) * 64 + 8 * h;
            const bf16* wx = F.WL + ((size_t)((1 * 2 + d) * 8 + n) * 64 + 32 * nt + r) * 64 + 8 * h;
#pragma unroll
            for (int ks = 0; ks < 4; ++ks) {
                const bf16x8 ba_ = *(const GAS bf16x8*)(wa + 16 * ks), bx_ = *(const GAS bf16x8*)(wx + 16 * ks);
#pragma unroll
                for (int mt = 0; mt < 2; ++mt) { accA[mt] = MFMA32(xa[mt][ks], ba_, accA[mt]); accX[mt] = MFMA32(xa[mt][ks], bx_, accX[mt]); }
            }
            const float bias_a = F.lru_ba[d * 512 + c], bias_x = F.lru_bx[d * 512 + c];
            const float e = __expf(-F.lru_lambda[d * 512 + c]);
            const float sp8 = -8.0f * e * (1.0f - e * (0.5f - e * (0.33333333f - 0.25f * e)));
#pragma unroll
            for (int mt = 0; mt < 2; ++mt)
#pragma unroll
                for (int rg = 0; rg < 16; ++rg) {
                    const int tok = m0 + 32 * mt + (rg & 3) + 8 * (rg >> 2) + 4 * h;
                    const float rr = sigm(accA[mt][rg] + bias_a), ii = sigm(accX[mt][rg] + bias_x);
                    const float la = sp8 * rr, y = 2.0f * la;
                    const float em = -y * (1.0f + y * (0.5f + y * (0.16666667f + y * (0.041666668f + y * 0.0083333333f))));
                    const float u = __builtin_sqrtf(em) * ii * xcC[mt][rg];
                    const _Float16 lh = (_Float16)la;
                    F.GATES[((size_t)tok * 2 + d) * 512 + c] = (unsigned)__builtin_bit_cast(unsigned short, lh) | (pk2(0.f, u) & 0xffff0000u);
                }
        }
    }
}
DI void p3_prep(Frame& F) {
    const int gw = F.wave * F.G + F.vcu, NGW = F.G * NWAVES;
    constexpr int I_G = (NTOK / 64) * 8, I_HG = NCH * 8, I_VT = NCH * 4;
    for (int it = gw; it < I_G + I_HG + I_VT; it += NGW) {
        int r = it;
        if (r < I_G) { lru_gate_item(F, r >> 3, r & 7); continue; } r -= I_G;
        if (r < I_HG) { const int head = r & 3, dir = (r >> 2) & 1, cg = r >> 3; if (dir) hg_prep_item<1>(F, cg, head); else hg_prep_item<0>(F, cg, head); continue; } r -= I_HG;
        vt_item(F, r >> 2, r & 3);
    }
}

DI bf16x8 ld2x8(const bf16* p) {
    const v2u a = *(const GAS v2u*)p, b = *(const GAS v2u*)(p + 8);
    const v4u w = {a.x, a.y, b.x, b.y}; return __builtin_bit_cast(bf16x8, w);
}
DI bf16x8 pack8(const f32x16& x, int s) {
    const v4u w = {pk2(x[8 * s], x[8 * s + 1]), pk2(x[8 * s + 2], x[8 * s + 3]), pk2(x[8 * s + 4], x[8 * s + 5]), pk2(x[8 * s + 6], x[8 * s + 7])};
    return __builtin_bit_cast(bf16x8, w);
}
DI void hg_scan_item(Frame& F, int sq, int d, int head, int vs) {
    const int r = F.lane & 31, h = F.lane >> 5;
    const bool lat = sq >= 32;
    const int T = lat ? TLAT : TCTX, base = lat ? NCTX + (sq - 32) * TLAT : sq * TCTX, nch = T / 32;
    const int hk = head * 128;
    f32x16 S[4];
    if (lat) {
        const float* s0 = F.state_hgrn + ((size_t)((sq - 32) * 2 + d) * 4 + head) * 128 * 128 + 32 * vs;
        const unsigned so = (unsigned)(4 * h * 128 + r);
#pragma unroll
        for (int i = 0; i < 4; ++i)
#pragma unroll
            for (int rg = 0; rg < 16; ++rg) S[i][rg] = s0[so + (unsigned)((32 * i + (rg & 3) + 8 * (rg >> 2)) * 128)];
    } else {
#pragma unroll
        for (int i = 0; i < 4; ++i)
#pragma unroll
            for (int rg = 0; rg < 16; ++rg) S[i][rg] = 0.f;
    }
    const unsigned qoff = (unsigned)(r * 512 + 4 * h), voff = (unsigned)((32 * vs + r) * NTOK + 4 * h), kdoff = (unsigned)(r * NTOK + 4 * h), ooff = (unsigned)(r * 512 + 32 * vs + 4 * h), doff = (unsigned)(4 * h);
    const bf16* QEd = F.QE + (size_t)d * NTOK * 512 + hk; const bf16* KEd = F.KE + (size_t)d * NTOK * 512 + hk;
    const bf16* KDd = F.KDT + ((size_t)d * 512 + hk) * NTOK; const float* DECd = F.DEC + (size_t)d * NCH * 512 + hk;
    const bf16* VTd = F.VT + (size_t)hk * NTOK;
    bf16* OUTd = (d ? F.OB : F.OF) + hk;
    for (int ci = 0; ci < nch; ++ci) {
        const int c = d ? nch - 1 - ci : ci, m0 = base + 32 * c, cg = m0 >> 5;
        const bf16* qb = QEd + (size_t)m0 * 512; const bf16* kb = KEd + (size_t)m0 * 512; const bf16* vb = VTd + m0; const bf16* kdb = KDd + m0;
        bf16x8 qf[8], vf[2];
        f32x16 X;
#pragma unroll
        for (int i = 0; i < 16; ++i) X[i] = 0.f;
#pragma unroll
        for (int ks = 0; ks < 8; ++ks) { qf[ks] = ld2x8(qb + qoff + 16 * ks); X = MFMA32(ld2x8(kb + qoff + 16 * ks), qf[ks], X); }
        vf[0] = ld2x8(vb + voff); vf[1] = ld2x8(vb + voff + 16);
#pragma unroll
        for (int rg = 0; rg < 16; ++rg) { const int s = (rg & 3) + 8 * (rg >> 2) + 4 * h; const bool keep = d ? (s >= r) : (s <= r); X[rg] = keep ? X[rg] : 0.f; }
        f32x16 O;
#pragma unroll
        for (int i = 0; i < 16; ++i) O[i] = 0.f;
        O = MFMA32(vf[0], pack8(X, 0), O); O = MFMA32(vf[1], pack8(X, 1), O);
#pragma unroll
        for (int i = 0; i < 4; ++i) { O = MFMA32(pack8(S[i], 0), qf[2 * i], O); O = MFMA32(pack8(S[i], 1), qf[2 * i + 1], O); }
        {
            bf16* op = OUTd + (size_t)m0 * 512;
#pragma unroll
            for (int g = 0; g < 4; ++g) { const v2u w = {pk2(O[4 * g], O[4 * g + 1]), pk2(O[4 * g + 2], O[4 * g + 3])}; *(GAS v2u*)(op + ooff + 8 * g) = w; }
        }
        const float* dp = DECd + (size_t)cg * 512;
#pragma unroll
        for (int i = 0; i < 4; ++i) {
#pragma unroll
            for (int g = 0; g < 4; ++g) { const f32x4 dv = *(const GAS f32x4*)(dp + doff + 32 * i + 8 * g);
#pragma unroll
                for (int j = 0; j < 4; ++j) S[i][4 * g + j] *= dv[j]; }
            const bf16* kd = kdb + (size_t)(32 * i) * NTOK;
            S[i] = MFMA32(ld2x8(kd + kdoff), vf[0], S[i]); S[i] = MFMA32(ld2x8(kd + kdoff + 16), vf[1], S[i]);
        }
    }
    if (!lat) {
        float* so = F.out + OUT_SHG + ((size_t)(sq * 2 + d) * 4 + head) * 128 * 128 + 32 * vs;
        const unsigned sof = (unsigned)(4 * h * 128 + r);
#pragma unroll
        for (int i = 0; i < 4; ++i)
#pragma unroll
            for (int rg = 0; rg < 16; ++rg) so[sof + (unsigned)((32 * i + (rg & 3) + 8 * (rg >> 2)) * 128)] = S[i][rg];
    }
}
DI void lru_scan_item(Frame& F, int sq, int d, int cgp) {
    const bool lat = sq >= 32;
    const int T = lat ? TLAT : TCTX, base = lat ? NCTX + (sq - 32) * TLAT : sq * TCTX, c = 64 * cgp + F.lane;
    float hs = lat ? F.state_rglru[(size_t)((sq - 32) * 2 + d) * 512 + c] : 0.f;
    const unsigned* gp = F.GATES + (size_t)d * 512 + c; bf16* op = (d ? F.HB : F.HF) + c;
    constexpr int U = 32;
    unsigned g[U], gn[U];
#pragma unroll
    for (int u = 0; u < U; ++u) { const int t = d ? T - 1 - u : u; g[u] = *(const GAS unsigned*)(gp + (size_t)(base + t) * 1024); }
    for (int i0 = 0; i0 < T; i0 += U) {
        if (i0 + U < T) {
#pragma unroll
            for (int u = 0; u < U; ++u) { const int t = d ? T - 1 - (i0 + U + u) : i0 + U + u; gn[u] = *(const GAS unsigned*)(gp + (size_t)(base + t) * 1024); }
        }
#pragma unroll
        for (int u = 0; u < U; ++u) {
            const int t = d ? T - 1 - (i0 + u) : i0 + u;
            const float la = (float)__builtin_bit_cast(_Float16, (unsigned short)(g[u] & 0xffffu));
            hs = __expf(la) * hs + bfhi(g[u]);
            op[(size_t)(base + t) * 512] = (bf16)(pk2(hs, 0.f) & 0xffffu);
        }
#pragma unroll
        for (int u = 0; u < U; ++u) g[u] = gn[u];
    }
    if (!lat) F.out[OUT_SLRU + (size_t)(sq * 2 + d) * 512 + c] = hs;
}
DI void p4_scans(Frame& F) {
    const int sub = F.wave & 3;
    for (int vh = (F.wave >> 2) * F.G + F.vcu; vh < 32 + 256 + 144; vh += 2 * F.G) {
        if (vh < 32) { hg_scan_item(F, 32 + (vh >> 3), (vh >> 2) & 1, vh & 3, sub); continue; }
        const int idx = vh - 32;
        if (idx < 256) { hg_scan_item(F, idx >> 3, (idx >> 2) & 1, idx & 3, sub); continue; }
        const int li = (idx - 256) * 4 + sub;
        if (li < 64) lru_scan_item(F, 32 + (li >> 4), (li >> 3) & 1, li & 7);
        else { const int l2 = li - 64; lru_scan_item(F, l2 >> 4, (l2 >> 3) & 1, l2 & 7); }
    }
}

constexpr int N_PHASES = 11;
struct Args { const float* in[24]; float* out; unsigned char* ws; int ph_lo, ph_hi, li, pad; };
__global__ void __launch_bounds__(NWAVES * 64, 2) mk_fwd(Args args) {
    extern __shared__ __attribute__((aligned(16))) unsigned char lds[];
    Frame F;
    F.lds = (LAS unsigned char*)lds;
    F.tid = threadIdx.x; F.lane = F.tid & 63; F.wave = __builtin_amdgcn_readfirstlane(F.tid >> 6);
    F.G = gridDim.x; { const int bx = blockIdx.x; F.vcu = (F.G % 8 == 0) ? (bx % 8) * (F.G / 8) + bx / 8 : bx; }
    unsigned char* ws = args.ws;
    F.x_prompt = args.in[0]; F.x_sample = args.in[1]; F.cvec = args.in[2]; F.state_hgrn = args.in[3]; F.state_rglru = args.in[4]; F.c_ctx = args.in[5];
    F.w_ada = args.in[6]; F.b_ada = args.in[7]; F.norm1_gain = args.in[8]; F.norm2_gain = args.in[9]; F.w_in = args.in[10]; F.lb_logits = args.in[11];
    F.hg_norm_gain = args.in[12]; F.conv_w = args.in[13]; F.conv_b = args.in[14]; F.lru_wa = args.in[15]; F.lru_ba = args.in[16]; F.lru_wx = args.in[17];
    F.lru_bx = args.in[18]; F.lru_lambda = args.in[19]; F.w_out = args.in[20]; F.w_ff1 = args.in[21]; F.w_ff2 = args.in[22]; F.final_gain = args.in[23];
    F.out = args.out;
    F.Win_t = (bf16*)(ws + WS_WIN); F.Wout_t = (bf16*)(ws + WS_WOUT); F.Wff1_t = (bf16*)(ws + WS_WFF1); F.Wff2_t = (bf16*)(ws + WS_WFF2); F.WL = (bf16*)(ws + WS_WL);
    F.MOD = (float*)(ws + WS_MOD); F.XS = (float*)(ws + WS_XS); F.DEC = (float*)(ws + WS_DEC);
    F.ACT = (bf16*)(ws + WS_ACT); F.QF = (bf16*)(ws + WS_QF); F.V = (bf16*)(ws + WS_V); F.GL = (bf16*)(ws + WS_GL); F.LX = (bf16*)(ws + WS_LX);
    F.QE = (bf16*)(ws + WS_QE); F.KE = (bf16*)(ws + WS_KE); F.KDT = (bf16*)(ws + WS_KDT); F.VT = (bf16*)(ws + WS_VT);
    F.OF = (bf16*)(ws + WS_OF); F.OB = (bf16*)(ws + WS_OB); F.HF = (bf16*)(ws + WS_HF); F.HB = (bf16*)(ws + WS_HB); F.HID = (bf16*)(ws + WS_HID);
    F.GATES = (unsigned*)args.out;
    volatile LAS unsigned* MISC = (volatile LAS unsigned*)(F.lds + LDSCTL_OFF);
    for (int u = F.tid; u < 128; u += NWAVES * 64) MISC[u] = 0u;
    __syncthreads();
    const int lo = args.ph_lo, hi = args.ph_hi;
    XcdBarrier bar; bar.bar = (unsigned*)(ws + WS_CTL); bar.x = 0; bar.st = nullptr;
    if (hi - lo > 1) bar = xcd_barrier_post((unsigned*)(ws + WS_CTL), MISC + 8);
#define IN(k) (lo <= (k) && (k) < hi)
#define SEAM(k) do { if (IN(k) && IN((k) + 1)) xcd_barrier(bar); } while (0)

    if (IN(0)) { p0_prologue(F); __syncthreads(); } SEAM(0);
    if (IN(1)) { p1_rows(F); } SEAM(1);
    if (IN(2)) {
        pg8::Gemm g{F.ACT, F.Win_t, NTOK, INC, D}; pg8::StaticOrder S; S.init(NTOK, INC, F.G, (int)blockIdx.x);
        pg8::EpiRoute E{F.QF, F.V, F.GL, F.LX};
        pg8::gemm_phase<pg8::EpiRoute, pg8::StaticOrder, PG8_ALIGN, PG8_SP2>(F.lds + RING_OFF, g, S, E);
    } SEAM(2);
    if (IN(3)) { p3_prep(F); } SEAM(3);
    if (IN(4)) { p4_scans(F); } SEAM(4);
    if (IN(5)) { p5_rows(F); } SEAM(5);
    if (IN(6)) {
        pg8::Gemm g{F.ACT, F.Wout_t, NTOK, D, D}; pg8::StaticOrder S; S.init(NTOK, D, F.G, (int)blockIdx.x);
        pg8::EpiResid E{F.x_prompt, F.XS, F.out, F.MOD + 2048};
        pg8::gemm_phase<pg8::EpiResid, pg8::StaticOrder, PG8_ALIGN, PG8_SP2>(F.lds + RING_OFF, g, S, E);
    } SEAM(6);
    if (IN(7)) { p7_rows(F); } SEAM(7);
    if (IN(8)) {
        pg8::Gemm g{F.ACT, F.Wff1_t, NTOK, DFF, D}; pg8::StaticOrder S; S.init(NTOK, DFF, F.G, (int)blockIdx.x);
        pg8::EpiRelu2 E{F.HID, DFF};
        pg8::gemm_phase<pg8::EpiRelu2, pg8::StaticOrder, PG8_ALIGN, PG8_SP2>(F.lds + RING_OFF, g, S, E);
    } SEAM(8);
    if (IN(9)) {
        pg8::Gemm g{F.HID, F.Wff2_t, NTOK, D, DFF}; pg8::StaticOrder S; S.init(NTOK, D, F.G, (int)blockIdx.x);
        pg8::EpiResid E{F.out, F.out + (size_t)NCTX * D, F.out, F.MOD + 5120};
        pg8::gemm_phase<pg8::EpiResid, pg8::StaticOrder, PG8_ALIGN, PG8_SP2>(F.lds + RING_OFF, g, S, E);
    } SEAM(9);
    if (IN(10)) { p10_rows(F); }
#undef IN
#undef SEAM
}

extern "C" void kernel_launch(void* const* d_in, const int* in_sizes, int n_in, void* d_out, int out_size, void* d_ws, size_t ws_size, hipStream_t stream) {
    static int grid = 0;
    if (grid == 0) {
        if (n_in != 24 || in_sizes[0] != NCTX * D || ws_size < WS_END) { fprintf(stderr, "kernel_launch: unexpected shapes (n_in %d, in0 %d, out %d, ws %zu)\n", n_in, n_in > 0 ? in_sizes[0] : -1, out_size, ws_size); grid = -1; return; }
        int dev = 0, cus = 0, per_cu = 0;
        if (hipGetDevice(&dev) != hipSuccess || hipDeviceGetAttribute(&cus, hipDeviceAttributeMultiprocessorCount, dev) != hipSuccess) { grid = -1; return; }
        if (hipFuncSetAttribute((const void*)mk_fwd, hipFuncAttributeMaxDynamicSharedMemorySize, LDS_BYTES) != hipSuccess) { fprintf(stderr, "kernel_launch: hipFuncSetAttribute failed\n"); grid = -1; return; }
        if (hipOccupancyMaxActiveBlocksPerMultiprocessor(&per_cu, (const void*)mk_fwd, NWAVES * 64, LDS_BYTES) != hipSuccess || per_cu < 1)
            fprintf(stderr, "kernel_launch: occupancy query reports %d workgroups per CU\n", per_cu);
        (void)hipGetLastError();
        grid = cus;
    }
    if (grid < 0) return;
    if (hipMemsetAsync((char*)d_ws + WS_CTL, 0, CTL_ZERO_BYTES, stream) != hipSuccess) return;
    Args a{};
    for (int i = 0; i < 24; ++i) a.in[i] = (const float*)d_in[i];
    a.out = (float*)d_out; a.ws = (unsigned char*)d_ws;
    constexpr int NL = MK_N_LAUNCHES;
    for (int li = 0; li < NL; ++li) {
        a.ph_lo = (NL == 1) ? 0 : li; a.ph_hi = (NL == 1) ? N_PHASES : li + 1; a.li = li;
        hipLaunchKernelGGL(mk_fwd, dim3(grid), dim3(NWAVES * 64), LDS_BYTES, stream, a);
    }
}
```

```cpp
#include <hip/hip_runtime.h>
#include <cstdio>
#include <cstdint>

#ifndef MK_N_LAUNCHES
#define MK_N_LAUNCHES 1
#endif

#define DI __device__ __forceinline__
#define GAS __attribute__((address_space(1)))
#define LAS __attribute__((address_space(3)))
typedef unsigned short bf16;
typedef unsigned v4u __attribute__((ext_vector_type(4)));
typedef unsigned v2u __attribute__((ext_vector_type(2)));
typedef float f32x2 __attribute__((ext_vector_type(2)));
typedef float f32x4 __attribute__((ext_vector_type(4)));
typedef float f32x16 __attribute__((ext_vector_type(16)));
typedef short bf16x8 __attribute__((ext_vector_type(8)));
typedef short s16x4 __attribute__((ext_vector_type(4)));
typedef __bf16 bf2_t __attribute__((ext_vector_type(2)));

DI unsigned pk2(float lo, float hi) { f32x2 v = {lo, hi}; return __builtin_bit_cast(unsigned, __builtin_convertvector(v, bf2_t)); }
DI float bflo(unsigned w) { return __uint_as_float(w << 16); }
DI float bfhi(unsigned w) { return __uint_as_float(w & 0xffff0000u); }
DI float sigm(float x) { return __builtin_amdgcn_rcpf(1.0f + __expf(-x)); }
DI float silu_f(float x) { return x * sigm(x); }
DI float gelu_tanh_f(float x) { const float u = 0.7978845608028654f * (x + 0.044715f * x * x * x); return x * sigm(2.0f * u); }
DI float wave_sum(float v) {
#pragma unroll
    for (int o = 1; o < 64; o <<= 1) v += __shfl_xor(v, o);
    return v;
}
#define LDS_WAIT() asm volatile("s_waitcnt lgkmcnt(0)" ::: "memory")
#define VM_WAIT() asm volatile("s_waitcnt vmcnt(0)" ::: "memory")

constexpr int D = 1024, NTOK = 12288, NCTX = 8192, TCTX = 256, TLAT = 1024;
constexpr int INC = 4096, DFF = 4096, NCH = NTOK / 32;
constexpr float EPS = 1e-6f;
constexpr int NWAVES = 8;

constexpr size_t MiB = 1u << 20;
constexpr size_t WS_CTL = 0, CTL_ZERO_BYTES = 64 * 1024;
constexpr size_t WS_WIN = 1 * MiB, WS_WOUT = 9 * MiB, WS_WFF1 = 11 * MiB, WS_WFF2 = 19 * MiB;
constexpr size_t WS_MOD = 27 * MiB;
constexpr size_t WS_WL = 27 * MiB + 256 * 1024;
constexpr size_t WS_ACT = 28 * MiB;
constexpr size_t WS_XS = 52 * MiB;
constexpr size_t WS_QF = 68 * MiB;
constexpr size_t WS_OF = 68 * MiB, WS_OB = 80 * MiB, WS_HF = 92 * MiB, WS_HB = 104 * MiB;
constexpr size_t WS_V = 116 * MiB;
constexpr size_t WS_GL = 128 * MiB;
constexpr size_t WS_LX = 152 * MiB;
constexpr size_t WS_QE = 164 * MiB, WS_KE = 188 * MiB;
constexpr size_t WS_KDT = 212 * MiB;
constexpr size_t WS_DEC = 236 * MiB;
constexpr size_t WS_VT = 238 * MiB;
constexpr size_t WS_HID = 68 * MiB;
constexpr size_t WS_END = 250 * MiB;

constexpr int RING_OFF = 0, RING_BYTES = 131072;
constexpr int LDSCTL_OFF = RING_BYTES;
constexpr int CT_OFF = RING_BYTES + 1024;
constexpr int LDS_BYTES = 160 * 1024;
static_assert(CT_OFF + 5 * 1024 * 4 <= LDS_BYTES, "LDS map");

#define XB_TMO      128
#define XB_XCNT(j)  (256  + 64 * (j))
#define XB_XSUB(j)  (1280 + 64 * (j))
#define XB_XGEN(j)  (2304 + 64 * (j))
#define XB_TOP      3328
#define XB_TOPGEN   3392
#define XCD_BAR_WORDS 3456
#define XB_SPIN_CAP (1u << 18)
static_assert(XCD_BAR_WORDS * 4 <= CTL_ZERO_BYTES, "barrier words inside the memset region");

DI unsigned xb_ld(unsigned* p)              { return __hip_atomic_load(p, __ATOMIC_RELAXED, __HIP_MEMORY_SCOPE_AGENT); }
DI unsigned xb_add(unsigned* p, unsigned v) { return __hip_atomic_fetch_add(p, v, __ATOMIC_RELAXED, __HIP_MEMORY_SCOPE_AGENT); }
DI unsigned xb_xcc_id() { return (unsigned)__builtin_amdgcn_s_getreg((3 << 11) | 20) & 0xFu; }
#define XB_SPIN(cond, bar) do { unsigned _sp = 0; while (cond) { __builtin_amdgcn_s_sleep(1); \
    if ((++_sp & 255u) == 0u) { if (xb_ld(&(bar)[XB_TMO])) break; if (_sp > XB_SPIN_CAP) { atomicAdd(&(bar)[XB_TMO], 1u); break; } } } } while (0)

struct XcdBarrier { unsigned* bar; unsigned x; volatile LAS unsigned* st; };

DI XcdBarrier xcd_barrier_post(unsigned* bar, volatile LAS unsigned* st) {
    XcdBarrier b; b.bar = bar; b.x = xb_xcc_id(); b.st = st;
    if (threadIdx.x == 0) (void)xb_add(&bar[XB_XCNT(b.x)], 1u);
    return b;
}
DI void xcd_barrier_complete(unsigned* bar, unsigned x, unsigned& nloc, unsigned& nx) {
    const unsigned G = gridDim.x * gridDim.y * gridDim.z;
    unsigned sum, cnt, mine, sp = 0u;
    for (;;) {
        sum = 0u; cnt = 0u; mine = 0u;
#pragma unroll
        for (unsigned j = 0; j < 16; ++j) { const unsigned c = xb_ld(&bar[XB_XCNT(j)]); sum += c; cnt += (c > 0u) ? 1u : 0u; mine = (j == x) ? c : mine; }
        if (sum == G) break;
        __builtin_amdgcn_s_sleep(1);
        if ((++sp & 255u) == 0u) { if (xb_ld(&bar[XB_TMO])) break; if (sp > XB_SPIN_CAP) { atomicAdd(&bar[XB_TMO], 1u); break; } }
    }
    nloc = mine > 0u ? mine : 1u; nx = cnt > 0u ? cnt : 1u;
}
DI void xcd_barrier(const XcdBarrier& b) {
    asm volatile("s_waitcnt vmcnt(0)" ::: "memory");
    __syncthreads();
    if (threadIdx.x == 0) {
        unsigned* bar = b.bar;
        __builtin_amdgcn_s_waitcnt(0);
        unsigned nloc = b.st[0], nx = b.st[1];
        if (nloc == 0u) { xcd_barrier_complete(bar, b.x, nloc, nx); b.st[0] = nloc; b.st[1] = nx; }
        const unsigned old = xb_add(&bar[XB_XSUB(b.x)], 1u);
        const unsigned gen = old / nloc;
        if (old + 1u == (gen + 1u) * nloc) {
            __builtin_amdgcn_fence(__ATOMIC_RELEASE, "agent");
            asm volatile("s_waitcnt vmcnt(0)" ::: "memory");
            const unsigned og = xb_add(&bar[XB_TOP], 1u);
            const unsigned tg = og / nx;
            if (og + 1u == (tg + 1u) * nx) xb_add(&bar[XB_TOPGEN], 1u);
            else XB_SPIN(xb_ld(&bar[XB_TOPGEN]) == tg, bar);
            __builtin_amdgcn_fence(__ATOMIC_ACQUIRE, "agent");
            xb_add(&bar[XB_XGEN(b.x)], 1u);
            asm volatile("s_waitcnt vmcnt(0)" ::: "memory");
        } else {
            XB_SPIN(xb_ld(&bar[XB_XGEN(b.x)]) == gen, bar);
            __builtin_amdgcn_fence(__ATOMIC_ACQUIRE, "agent");
            asm volatile("s_waitcnt vmcnt(0)" ::: "memory");
        }
    }
    __syncthreads();
}

namespace pg8 {
#define PG8_LAS __attribute__((address_space(3)))
typedef unsigned short bf16_t;
typedef short bf16x8 __attribute__((ext_vector_type(8)));
typedef float f32x4 __attribute__((ext_vector_type(4)));
typedef unsigned u32x4 __attribute__((ext_vector_type(4)));
constexpr int BM = 256, BK = 64, HALF = 128, HTB = HALF * BK * 2  , STAGE_BYTES = 8 * HTB, NXCD = 8, WGM = 8;

__host__ __device__ __forceinline__ int lds_byte(int r, int c) { const int st = (r >> 4) * 2 + (c >> 5), rr = r & 15, cc = c & 31, ob = rr * 64 + cc * 2; return st * 1024 + (ob ^ (((ob >> 9) & 1) << 5)); }
__host__ __device__ __forceinline__ void stage_rc(int b, int& R, int& C) { const int st = b / 1024, sb = b % 1024, swz = sb ^ (((sb >> 9) & 1) << 5); R = (st >> 1) * 16 + swz / 64; C = (st & 1) * 32 + (swz % 64) / 2; }
__host__ __device__ __forceinline__ int perm32(int rho) { const int n = rho >> 4, i = rho & 15; return 8 * (i >> 2) + 4 * n + (i & 3); }

struct Unit { int pm, pn; };
struct Gemm { const bf16_t* A; const bf16_t* Bt; int M, N, K; };

struct StaticOrder {
    int nM, nN, nwg, G, c;
    __host__ __device__ void init(int M, int N, int G_, int c_) { nM = M / BM; nN = N / BM; nwg = nM * nN; G = G_; c = c_; }
    __host__ __device__ bool next(int i, Unit& u) const {
        const long L = (long)i * G + c; if (L >= nwg) return false;
        int wgid = (int)L; { const int q = nwg / NXCD, r = nwg % NXCD, xcd = wgid % NXCD, off = wgid / NXCD; wgid = (xcd < r ? xcd * (q + 1) : r * (q + 1) + (xcd - r) * q) + off; }
        const int nig = WGM * nN, gid = wgid / nig, fm = gid * WGM, gsz = (nM - fm) < WGM ? (nM - fm) : WGM;
        u.pm = fm + ((wgid % nig) % gsz); u.pn = (wgid % nig) / gsz; return true;
    }
    __device__ __forceinline__ void a_ready(const Unit&) const {}
    __device__ __forceinline__ void done(const Unit&) const {}
};

__device__ __forceinline__ unsigned cvt_pk_bf16(float lo, float hi) { return pk2(lo, hi); }
__device__ __forceinline__ int cond_of_pm(int pm) { return pm < 32 ? 0 : 1 + ((pm - 32) >> 2); }

struct EpiRoute {
    static constexpr bool PERM = true, AFTER_DRAIN = false;
    bf16_t *QF, *V, *GL, *LX;
    __device__ __forceinline__ void operator()(const f32x4 (&acc)[2][2][4][2], const Unit& u, int wr, int wc, int fr, int fq) const {
        const int pn = u.pn; bf16_t* base; int ldc, colt;
        if (pn < 8) { base = QF; ldc = 2048; colt = pn * 256; }
        else if (pn < 10) { base = V; ldc = 512; colt = (pn - 8) * 256; }
        else if (pn < 12) { base = GL; ldc = 1024; colt = (pn - 10) * 256; }
        else if (pn < 14) { base = LX; ldc = 512; colt = (pn - 12) * 256; }
        else { base = GL; ldc = 1024; colt = 512 + (pn - 14) * 256; }
        const int row0 = u.pm * BM + wr * 64 + fr, col0 = colt + wc * 32 + 8 * fq;
#pragma unroll
        for (int ai = 0; ai < 2; ++ai)
#pragma unroll
            for (int m = 0; m < 4; ++m) { bf16_t* rowp = base + (size_t)(row0 + ai * HALF + m * 16) * ldc + col0;
#pragma unroll
                for (int bj = 0; bj < 2; ++bj) { const f32x4 v0 = acc[ai][bj][m][0], v1 = acc[ai][bj][m][1];
                    u32x4 w; w.x = cvt_pk_bf16(v0[0], v0[1]); w.y = cvt_pk_bf16(v0[2], v0[3]); w.z = cvt_pk_bf16(v1[0], v1[1]); w.w = cvt_pk_bf16(v1[2], v1[3]);
                    *(u32x4*)(rowp + bj * HALF) = w; } }
    }
};
struct EpiRelu2 {
    static constexpr bool PERM = true, AFTER_DRAIN = false;
    bf16_t* O; int ldc;
    __device__ __forceinline__ void operator()(const f32x4 (&acc)[2][2][4][2], const Unit& u, int wr, int wc, int fr, int fq) const {
        const int row0 = u.pm * BM + wr * 64 + fr, col0 = u.pn * BM + wc * 32 + 8 * fq;
#pragma unroll
        for (int ai = 0; ai < 2; ++ai)
#pragma unroll
            for (int m = 0; m < 4; ++m) { bf16_t* rowp = O + (size_t)(row0 + ai * HALF + m * 16) * ldc + col0;
#pragma unroll
                for (int bj = 0; bj < 2; ++bj) { f32x4 v0 = acc[ai][bj][m][0], v1 = acc[ai][bj][m][1];
#pragma unroll
                    for (int j = 0; j < 4; ++j) { const float a = fmaxf(v0[j], 0.f), b = fmaxf(v1[j], 0.f); v0[j] = a * a; v1[j] = b * b; }
                    u32x4 w; w.x = cvt_pk_bf16(v0[0], v0[1]); w.y = cvt_pk_bf16(v0[2], v0[3]); w.z = cvt_pk_bf16(v1[0], v1[1]); w.w = cvt_pk_bf16(v1[2], v1[3]);
                    *(u32x4*)(rowp + bj * HALF) = w; } }
    }
};
struct EpiResid {
    static constexpr bool PERM = false, AFTER_DRAIN = false;
    const float* resA; const float* resB; float* out; const float* gate;
    __device__ __forceinline__ void operator()(const f32x4 (&acc)[2][2][4][2], const Unit& u, int wr, int wc, int fr, int fq) const {
        const int row0 = u.pm * BM + wr * 64 + fr, col0 = u.pn * BM + wc * 32 + 4 * fq;
        const float* g = gate + cond_of_pm(u.pm) * 6144 + col0;
        const float* res = (u.pm < 32) ? resA + (size_t)row0 * 1024 : resB + (size_t)(row0 - 8192) * 1024;
        f32x4 gv[2][2];
#pragma unroll
        for (int bj = 0; bj < 2; ++bj)
#pragma unroll
            for (int n = 0; n < 2; ++n) gv[bj][n] = *(const f32x4*)(g + bj * HALF + n * 16);
#pragma unroll
        for (int ai = 0; ai < 2; ++ai)
#pragma unroll
            for (int m = 0; m < 4; ++m) { const size_t ro = (size_t)(ai * HALF + m * 16) * 1024 + col0; float* rowp = out + (size_t)row0 * 1024 + ro;
#pragma unroll
                for (int bj = 0; bj < 2; ++bj)
#pragma unroll
                    for (int n = 0; n < 2; ++n) { const f32x4 rv = *(const f32x4*)(res + ro + bj * HALF + n * 16); *(f32x4*)(rowp + bj * HALF + n * 16) = rv + gv[bj][n] * acc[ai][bj][m][n]; } }
    }
};

template <class Epi, class Sched, bool ALIGN_EPI = false, bool SP2 = false>
__device__ __forceinline__ void gemm_phase(PG8_LAS unsigned char* lds, const Gemm g, const Sched& S, const Epi& E) {
    const int tid = threadIdx.x, wid = __builtin_amdgcn_readfirstlane(tid >> 6), lane = tid & 63, wr = wid >> 2, wc = wid & 3, fr = lane & 15, fq = lane >> 4;
    const int K = g.K, nt = K / BK;
    unsigned voffA[2], voffB[2];
#pragma unroll
    for (int i = 0; i < 2; ++i) { int R, C; stage_rc(tid * 16 + i * 8192, R, C); const int Rb = Epi::PERM ? ((R & ~31) + perm32(R & 31)) : R;
        voffA[i] = (unsigned)(R * K + C) * 2u; voffB[i] = (unsigned)(Rb * K + C) * 2u; }
    const size_t kstep = (size_t)(BK * 2);
    const size_t hstep = (size_t)HALF * K * 2;
    const size_t tstep = 2 * hstep;
    const unsigned ldsw = (unsigned)wid * 1024u;
    const int aoff = lds_byte(wr * 64 + fr, fq * 8), boff = lds_byte(wc * 32 + fr, fq * 8);
#define PG8_SA(b, h) (((b) * 2 + (h)) * HTB)
#define PG8_SB(b, h) ((4 + (b) * 2 + (h)) * HTB)
#define PG8_STAGE(bufoff, gbase, voff) do { _Pragma("unroll") for (int _i = 0; _i < 2; ++_i) \
        __builtin_amdgcn_global_load_lds((const unsigned*)((const char*)(gbase) + (voff)[_i]), (PG8_LAS unsigned*)(lds + (bufoff) + ldsw + _i * 8192), 16, 0, 0); } while (0)
#define PG8_LDA(dst, b, h) do { _Pragma("unroll") for (int m = 0; m < 4; ++m) _Pragma("unroll") for (int k = 0; k < 2; ++k) dst[m][k] = *(const PG8_LAS bf16x8*)(lds + PG8_SA(b, h) + aoff + m * 2048 + k * 1024); } while (0)
#define PG8_LDB(dst, b, h) do { _Pragma("unroll") for (int n = 0; n < 2; ++n) _Pragma("unroll") for (int k = 0; k < 2; ++k) dst[n][k] = *(const PG8_LAS bf16x8*)(lds + PG8_SB(b, h) + boff + n * 2048 + k * 1024); } while (0)
#define PG8_MMA(ai, bj, At, Bt) do { __builtin_amdgcn_s_setprio(1); _Pragma("unroll") for (int m = 0; m < 4; ++m) _Pragma("unroll") for (int n = 0; n < 2; ++n) _Pragma("unroll") for (int k = 0; k < 2; ++k) \
        acc[ai][bj][m][n] = __builtin_amdgcn_mfma_f32_16x16x32_bf16(Bt[n][k], At[m][k], acc[ai][bj][m][n], 0, 0, 0); __builtin_amdgcn_s_setprio(0); } while (0)
#define PG8_WAIT_V(n) asm volatile("s_waitcnt vmcnt(" #n ")" ::: "memory")
#define PG8_WAIT_L(n) asm volatile("s_waitcnt lgkmcnt(" #n ")" ::: "memory")
#define PG8_BAR __builtin_amdgcn_s_barrier()
#define PG8_SCHED __builtin_amdgcn_sched_barrier(0)
    Unit cur, nxt; int ui = 0;
    if (!S.next(0, cur)) return;
    f32x4 acc[2][2][4][2];
#pragma unroll
    for (int a = 0; a < 2; ++a)
#pragma unroll
        for (int b = 0; b < 2; ++b)
#pragma unroll
            for (int m = 0; m < 4; ++m)
#pragma unroll
                for (int n = 0; n < 2; ++n) acc[a][b][m][n] = (f32x4){0.f, 0.f, 0.f, 0.f};
    bf16x8 At[4][2], B0[2][2], B1[2][2];
    const char* cA = (const char*)g.A + (size_t)cur.pm * tstep; const char* cB = (const char*)g.Bt + (size_t)cur.pn * tstep;
    S.a_ready(cur);
    if constexpr (SP2) {
        PG8_STAGE(PG8_SB(0, 0), cB, voffB); PG8_STAGE(PG8_SB(0, 1), cB + hstep, voffB); PG8_STAGE(PG8_SA(0, 0), cA, voffA); PG8_STAGE(PG8_SA(0, 1), cA + hstep, voffA);
        if (wr == 1) PG8_BAR;
        PG8_WAIT_V(2); PG8_BAR;
        PG8_STAGE(PG8_SB(1, 0), cB + kstep, voffB); PG8_STAGE(PG8_SA(1, 0), cA + kstep, voffA); PG8_STAGE(PG8_SB(1, 1), cB + hstep + kstep, voffB);
        PG8_WAIT_V(6); PG8_BAR;
    } else {
        PG8_STAGE(PG8_SB(0, 0), cB, voffB); PG8_STAGE(PG8_SA(0, 0), cA, voffA); PG8_STAGE(PG8_SB(0, 1), cB + hstep, voffB); PG8_STAGE(PG8_SA(0, 1), cA + hstep, voffA);
        if (wr == 1) PG8_BAR;
        PG8_WAIT_V(4); PG8_BAR;
        PG8_STAGE(PG8_SB(1, 0), cB + kstep, voffB); PG8_STAGE(PG8_SA(1, 0), cA + kstep, voffA); PG8_STAGE(PG8_SB(1, 1), cB + hstep + kstep, voffB);
        PG8_WAIT_V(6); PG8_BAR;
    }
    for (;;) {
        const bool has_next = S.next(ui + 1, nxt);
        const char* nA = has_next ? (const char*)g.A + (size_t)nxt.pm * tstep : cA; const char* nB = has_next ? (const char*)g.Bt + (size_t)nxt.pn * tstep : cB;
        for (int t = 0; t < nt; t += 2) {
            const bool last = (t == nt - 2);
            const char* a1 = cA + (size_t)(t + 1) * kstep;
            const char* a2 = last ? nA : cA + (size_t)(t + 2) * kstep; const char* b2 = last ? nB : cB + (size_t)(t + 2) * kstep;
            const char* a3 = a2 + kstep; const char* b3 = b2 + kstep;
            if (last && has_next) S.a_ready(nxt);
            if constexpr (SP2) {
            PG8_LDB(B0, 0, 0); PG8_LDB(B1, 0, 1); PG8_SCHED; PG8_LDA(At, 0, 0); PG8_STAGE(PG8_SA(1, 1), a1 + hstep, voffA);
            PG8_WAIT_V(8); PG8_WAIT_L(0); PG8_BAR; PG8_MMA(0, 0, At, B0); PG8_MMA(0, 1, At, B1); PG8_BAR; PG8_SCHED;
            PG8_LDA(At, 0, 1); PG8_STAGE(PG8_SB(0, 0), b2, voffB); PG8_STAGE(PG8_SB(0, 1), b2 + hstep, voffB); PG8_STAGE(PG8_SA(0, 0), a2, voffA);
            PG8_WAIT_V(8); PG8_WAIT_L(0); PG8_BAR; PG8_MMA(1, 0, At, B0); PG8_MMA(1, 1, At, B1); PG8_BAR; PG8_SCHED;
            PG8_LDB(B0, 1, 0); PG8_LDB(B1, 1, 1); PG8_SCHED; PG8_LDA(At, 1, 0); PG8_STAGE(PG8_SA(0, 1), a2 + hstep, voffA);
            PG8_WAIT_V(8); PG8_WAIT_L(0); PG8_BAR; PG8_MMA(0, 0, At, B0); PG8_MMA(0, 1, At, B1); PG8_BAR; PG8_SCHED;
            PG8_LDA(At, 1, 1); PG8_STAGE(PG8_SB(1, 0), b3, voffB); PG8_STAGE(PG8_SB(1, 1), b3 + hstep, voffB); PG8_STAGE(PG8_SA(1, 0), a3, voffA);
            PG8_WAIT_V(8); PG8_WAIT_L(0); PG8_BAR; PG8_MMA(1, 0, At, B0); PG8_MMA(1, 1, At, B1); PG8_BAR; PG8_SCHED;
            } else {
            PG8_LDB(B0, 0, 0); PG8_SCHED; PG8_LDA(At, 0, 0); PG8_STAGE(PG8_SA(1, 1), a1 + hstep, voffA);
            PG8_WAIT_L(8); PG8_BAR; PG8_WAIT_L(0); PG8_MMA(0, 0, At, B0); PG8_BAR; PG8_SCHED;
            PG8_LDB(B1, 0, 1); PG8_STAGE(PG8_SB(0, 0), b2, voffB);
            PG8_BAR; PG8_WAIT_L(0); PG8_MMA(0, 1, At, B1); PG8_BAR;
            PG8_LDA(At, 0, 1); PG8_STAGE(PG8_SA(0, 0), a2, voffA);
            PG8_BAR; PG8_WAIT_L(0); PG8_MMA(1, 0, At, B0); PG8_BAR; PG8_SCHED;
            PG8_STAGE(PG8_SB(0, 1), b2 + hstep, voffB);
            PG8_WAIT_V(6); PG8_BAR; PG8_MMA(1, 1, At, B1); PG8_BAR;
            PG8_LDB(B0, 1, 0); PG8_SCHED; PG8_LDA(At, 1, 0); PG8_STAGE(PG8_SA(0, 1), a2 + hstep, voffA);
            PG8_WAIT_L(8); PG8_BAR; PG8_WAIT_L(0); PG8_MMA(0, 0, At, B0); PG8_BAR; PG8_SCHED;
            PG8_LDB(B1, 1, 1); PG8_STAGE(PG8_SB(1, 0), b3, voffB);
            PG8_BAR; PG8_WAIT_L(0); PG8_MMA(0, 1, At, B1); PG8_BAR;
            PG8_LDA(At, 1, 1); PG8_STAGE(PG8_SA(1, 0), a3, voffA);
            PG8_BAR; PG8_WAIT_L(0); PG8_MMA(1, 0, At, B0); PG8_BAR; PG8_SCHED;
            PG8_STAGE(PG8_SB(1, 1), b3 + hstep, voffB);
            PG8_WAIT_V(6); PG8_BAR; PG8_MMA(1, 1, At, B1); PG8_BAR;
            }
        }
        if constexpr (ALIGN_EPI) { if (wr == 0) PG8_BAR; }
        if constexpr (!Epi::AFTER_DRAIN) { E(acc, cur, wr, wc, fr, fq); S.done(cur); }
        if (!has_next) break;
#pragma unroll
        for (int a = 0; a < 2; ++a)
#pragma unroll
            for (int b = 0; b < 2; ++b)
#pragma unroll
                for (int m = 0; m < 4; ++m)
#pragma unroll
                    for (int n = 0; n < 2; ++n) acc[a][b][m][n] = (f32x4){0.f, 0.f, 0.f, 0.f};
        cur = nxt; cA = nA; cB = nB; ++ui;
        if constexpr (ALIGN_EPI) { if (wr == 1) PG8_BAR; }
    }
    PG8_WAIT_V(0);
    if constexpr (!ALIGN_EPI) { if (wr == 0) PG8_BAR; }
    PG8_BAR;
    if constexpr (Epi::AFTER_DRAIN) { E.fused(acc, cur, wr, wc, fr, fq, lds, wid, lane); S.done(cur); }
#undef PG8_SA
#undef PG8_SB
#undef PG8_STAGE
#undef PG8_LDA
#undef PG8_LDB
#undef PG8_MMA
#undef PG8_WAIT_V
#undef PG8_WAIT_L
#undef PG8_BAR
#undef PG8_SCHED
}
}

#ifndef PG8_SP2
#define PG8_SP2 true
#endif
#ifndef PG8_ALIGN
#define PG8_ALIGN true
#endif

struct Frame {
    LAS unsigned char* lds;
    int tid, lane, wave, vcu, G;
    const float *x_prompt, *x_sample, *cvec, *state_hgrn, *state_rglru, *c_ctx, *w_ada, *b_ada, *norm1_gain, *norm2_gain, *w_in, *lb_logits, *hg_norm_gain,
                *conv_w, *conv_b, *lru_wa, *lru_ba, *lru_wx, *lru_bx, *lru_lambda, *w_out, *w_ff1, *w_ff2, *final_gain;
    float* out;
    bf16 *Win_t, *Wout_t, *Wff1_t, *Wff2_t, *WL;
    float* MOD; float* XS; float* DEC;
    bf16 *ACT, *QF, *V, *GL, *LX, *QE, *KE, *KDT, *VT, *OF, *OB, *HF, *HB, *HID;
    unsigned* GATES;
};
constexpr size_t OUT_SHG = (size_t)NTOK * 1024, OUT_SLRU = OUT_SHG + (size_t)32 * 2 * 4 * 128 * 128;

DI void p0_transpose_item(const float* W, int K, int N, bf16* WT, LAS float* scr, int item, int lane) {
    const int nblk = N / 32, kb = item / nblk, nb = item % nblk, k0 = 64 * kb, n0 = 32 * nb;
#pragma unroll 8
    for (int i = 0; i < 32; ++i) { const int kk = 2 * i + (lane >> 5); scr[kk * 33 + (lane & 31)] = W[(size_t)(k0 + kk) * N + n0 + (lane & 31)]; }
    LDS_WAIT(); asm volatile("" ::: "memory");
    const int c = lane & 7;
#pragma unroll
    for (int j = 0; j < 4; ++j) { const int n = (lane >> 3) + 8 * j; const LAS float* s = scr + (8 * c) * 33 + n;
        v4u o; o.x = pk2(s[0 * 33], s[1 * 33]); o.y = pk2(s[2 * 33], s[3 * 33]); o.z = pk2(s[4 * 33], s[5 * 33]); o.w = pk2(s[6 * 33], s[7 * 33]);
        *(GAS v4u*)(WT + (size_t)(n0 + n) * K + k0 + 8 * c) = o; }
    LDS_WAIT(); asm volatile("" ::: "memory");
}
DI void p0_prologue(Frame& F) {
    LAS float* ct = (LAS float*)(F.lds + CT_OFF);
    for (int i = F.tid; i < 5 * 1024; i += NWAVES * 64) { const int j = i >> 10, k = i & 1023; const float c = (j == 0) ? F.c_ctx[k] : F.cvec[(j - 1) * 1024 + k]; ct[i] = silu_f(c); }
    __syncthreads();
    LAS float* scr = (LAS float*)(F.lds + RING_OFF + F.wave * 16384);
    const int gw = F.wave * F.G + F.vcu, NGW = F.G * NWAVES;
    constexpr int I_GEMV = 6144 / 16, I_WL = 32, I_IN = (D / 64) * (INC / 32), I_OUT = (D / 64) * (D / 32), I_F1 = (D / 64) * (DFF / 32), I_F2 = (DFF / 64) * (D / 32);
    constexpr int NITEMS = I_GEMV + I_WL + I_IN + I_OUT + I_F1 + I_F2;
    for (int it = gw; it < NITEMS; it += NGW) {
        int r = it;
        if (r < I_GEMV) {
            const int n0 = 16 * r, col = F.lane & 15, kq = F.lane >> 4;
            const float* wp = F.w_ada + n0 + col;
            float acc[5] = {0.f, 0.f, 0.f, 0.f, 0.f};
            for (int k = kq; k < 1024; k += 32) {
                float w[8];
#pragma unroll
                for (int u = 0; u < 8; ++u) w[u] = wp[(size_t)(k + 4 * u) * 6144];
#pragma unroll
                for (int u = 0; u < 8; ++u)
#pragma unroll
                    for (int j = 0; j < 5; ++j) acc[j] += ct[j * 1024 + k + 4 * u] * w[u];
            }
#pragma unroll
            for (int j = 0; j < 5; ++j) { acc[j] += __shfl_xor(acc[j], 16); acc[j] += __shfl_xor(acc[j], 32); }
            if (kq == 0) { const float b = F.b_ada[n0 + col];
#pragma unroll
                for (int j = 0; j < 5; ++j) F.MOD[j * 6144 + n0 + col] = acc[j] + b; }
            continue;
        }
        r -= I_GEMV;
        if (r < I_WL) {
            const int mat = r >> 4; const float* src = (mat ? F.lru_wx : F.lru_wa) + (size_t)(r & 15) * 4096; bf16* dst = F.WL + (size_t)r * 4096;
            for (int e = F.lane; e < 4096; e += 64) { const int o = e >> 6, i = e & 63; dst[o * 64 + i] = (bf16)(pk2(src[i * 64 + o], 0.f) & 0xffffu); }
            continue;
        }
        r -= I_WL;
        if (r < I_IN) { p0_transpose_item(F.w_in, D, INC, F.Win_t, scr, r, F.lane); continue; } r -= I_IN;
        if (r < I_OUT) { p0_transpose_item(F.w_out, D, D, F.Wout_t, scr, r, F.lane); continue; } r -= I_OUT;
        if (r < I_F1) { p0_transpose_item(F.w_ff1, D, DFF, F.Wff1_t, scr, r, F.lane); continue; } r -= I_F1;
        p0_transpose_item(F.w_ff2, DFF, D, F.Wff2_t, scr, r, F.lane);
    }
}

DI int cond_of_row(int m) { return m < NCTX ? 0 : 1 + ((m - NCTX) >> 10); }
DI void store_row_bf16(bf16* orow, int lane, const f32x4 (&v)[4]) {
    GAS v2u* o8 = (GAS v2u*)orow + lane;
#pragma unroll
    for (int j = 0; j < 4; ++j) { v2u w; w.x = pk2(v[j].x, v[j].y); w.y = pk2(v[j].z, v[j].w); o8[64 * j] = w; }
}
DI void p1_rows(Frame& F) {
    const int gw = F.vcu * NWAVES + F.wave, NGW = F.G * NWAVES;
    for (int m = gw; m < NTOK; m += NGW) {
        const float* xrow = m < NCTX ? F.x_prompt + (size_t)m * D : F.x_sample + (size_t)(m - NCTX) * D;
        const GAS f32x4* xr = (const GAS f32x4*)xrow + F.lane;
        f32x4 v[4];
#pragma unroll
        for (int j = 0; j < 4; ++j) v[j] = xr[64 * j];
        if (m >= NCTX) {
            const int t = (m - NCTX) & 1023; const float rr = (float)(t >> 6), cc = (float)(t & 63);
#pragma unroll
            for (int e = 0; e < 4; ++e) {
                const float om = exp2f(-(float)(4 * F.lane + e) * (13.287712379549449f / 256.0f));
                const float ar = rr * om * 0.15915494309189535f, ac = cc * om * 0.15915494309189535f;
                v[0][e] += __builtin_amdgcn_sinf(ar); v[1][e] += __builtin_amdgcn_cosf(ar); v[2][e] += __builtin_amdgcn_sinf(ac); v[3][e] += __builtin_amdgcn_cosf(ac);
            }
            GAS f32x4* xo = (GAS f32x4*)(F.XS + (size_t)(m - NCTX) * D) + F.lane;
#pragma unroll
            for (int j = 0; j < 4; ++j) xo[64 * j] = v[j];
        }
        float s = 0.f;
#pragma unroll
        for (int j = 0; j < 4; ++j) s += (v[j].x * v[j].x + v[j].y * v[j].y) + (v[j].z * v[j].z + v[j].w * v[j].w);
        const float rstd = 1.0f / sqrtf(wave_sum(s) * (1.f / D) + EPS);
        const float* mod = F.MOD + cond_of_row(m) * 6144;
#pragma unroll
        for (int j = 0; j < 4; ++j) {
            const int c = 256 * j + 4 * F.lane;
            const f32x4 g = *(const f32x4*)(F.norm1_gain + c), sh = *(const f32x4*)(mod + c), sc = *(const f32x4*)(mod + 1024 + c);
            v[j] = v[j] * rstd * g * (1.0f + sc) + sh;
        }
        store_row_bf16(F.ACT + (size_t)m * D, F.lane, v);
    }
}
DI void p7_rows(Frame& F) {
    const int gw = F.vcu * NWAVES + F.wave, NGW = F.G * NWAVES;
    for (int m = gw; m < NTOK; m += NGW) {
        const GAS f32x4* xr = (const GAS f32x4*)(F.out + (size_t)m * D) + F.lane;
        f32x4 v[4]; float s = 0.f;
#pragma unroll
        for (int j = 0; j < 4; ++j) { v[j] = xr[64 * j]; s += (v[j].x * v[j].x + v[j].y * v[j].y) + (v[j].z * v[j].z + v[j].w * v[j].w); }
        const float rstd = 1.0f / sqrtf(wave_sum(s) * (1.f / D) + EPS);
        const float* mod = F.MOD + cond_of_row(m) * 6144;
#pragma unroll
        for (int j = 0; j < 4; ++j) {
            const int c = 256 * j + 4 * F.lane;
            const f32x4 g = *(const f32x4*)(F.norm2_gain + c), sh = *(const f32x4*)(mod + 3072 + c), sc = *(const f32x4*)(mod + 4096 + c);
            v[j] = v[j] * rstd * g * (1.0f + sc) + sh;
        }
        store_row_bf16(F.ACT + (size_t)m * D, F.lane, v);
    }
}
DI void p10_rows(Frame& F) {
    const int gw = F.vcu * NWAVES + F.wave, NGW = F.G * NWAVES;
    for (int m = gw; m < NTOK; m += NGW) {
        GAS f32x4* xr = (GAS f32x4*)(F.out + (size_t)m * D) + F.lane;
        f32x4 v[4]; float s = 0.f;
#pragma unroll
        for (int j = 0; j < 4; ++j) { v[j] = xr[64 * j]; s += (v[j].x * v[j].x + v[j].y * v[j].y) + (v[j].z * v[j].z + v[j].w * v[j].w); }
        const float rstd = 1.0f / sqrtf(wave_sum(s) * (1.f / D) + EPS);
#pragma unroll
        for (int j = 0; j < 4; ++j) { const f32x4 g = *(const f32x4*)(F.final_gain + 256 * j + 4 * F.lane); xr[64 * j] = v[j] * rstd * g; }
    }
}
DI void p5_rows(Frame& F) {
    const int gw = F.vcu * NWAVES + F.wave, NGW = F.G * NWAVES;
    const int c8 = 8 * F.lane;
    for (int m = gw; m < NTOK; m += NGW) {
        const v4u a = *(const GAS v4u*)(F.OF + (size_t)m * 512 + c8), b = *(const GAS v4u*)(F.OB + (size_t)m * 512 + c8);
        const v4u gt = *(const GAS v4u*)(F.GL + (size_t)m * 1024 + c8), lg = *(const GAS v4u*)(F.GL + (size_t)m * 1024 + 512 + c8);
        const v4u hf = *(const GAS v4u*)(F.HF + (size_t)m * 512 + c8), hb = *(const GAS v4u*)(F.HB + (size_t)m * 512 + c8);
        float o[8], s = 0.f;
#pragma unroll
        for (int j = 0; j < 4; ++j) { o[2 * j] = bflo(a[j]) + bflo(b[j]); o[2 * j + 1] = bfhi(a[j]) + bfhi(b[j]); s += o[2 * j] * o[2 * j] + o[2 * j + 1] * o[2 * j + 1]; }
        s += __shfl_xor(s, 1); s += __shfl_xor(s, 2); s += __shfl_xor(s, 4); s += __shfl_xor(s, 8);
        const float rstd = 1.0f / sqrtf(s * (1.f / 128.f) + EPS);
        const f32x4 g0 = *(const f32x4*)(F.hg_norm_gain + c8), g1 = *(const f32x4*)(F.hg_norm_gain + c8 + 4);
        v4u w1, w2;
#pragma unroll
        for (int j = 0; j < 4; ++j) {
            const float ga = (j < 2) ? g0[2 * j] : g1[2 * j - 4], gb = (j < 2) ? g0[2 * j + 1] : g1[2 * j - 3];
            w1[j] = pk2(o[2 * j] * rstd * ga * silu_f(bflo(gt[j])), o[2 * j + 1] * rstd * gb * silu_f(bfhi(gt[j])));
            w2[j] = pk2((bflo(hf[j]) + bflo(hb[j])) * gelu_tanh_f(bflo(lg[j])), (bfhi(hf[j]) + bfhi(hb[j])) * gelu_tanh_f(bfhi(lg[j])));
        }
        *(GAS v4u*)(F.ACT + (size_t)m * D + c8) = w1;
        *(GAS v4u*)(F.ACT + (size_t)m * D + 512 + c8) = w2;
    }
}

template <int DIR>
DI void hg_prep_item(Frame& F, int cg, int head) {
    const int m0 = cg * 32, k0 = 2 * F.lane, hk = head * 128 + k0, col = DIR * 512 + hk;
    const f32x2 L0 = *(const f32x2*)(F.lb_logits + DIR * 512 + hk), L1 = *(const f32x2*)(F.lb_logits + 1024 + DIR * 512 + hk);
    const float lba = __builtin_amdgcn_rcpf(1.0f + __expf(L1.x - L0.x)), lbb = __builtin_amdgcn_rcpf(1.0f + __expf(L1.y - L0.y));
    float lf0[32], lf1[32], kk0[32], kk1[32]; unsigned qw[32];
    float bl0 = 0.f, bl1 = 0.f;
#pragma unroll
    for (int i = 0; i < 32; ++i) {
        const int t = DIR ? 31 - i : i; const size_t ro = (size_t)(m0 + t) * 2048 + col;
        const unsigned fw = *(const GAS unsigned*)(F.QF + ro + 1024); qw[i] = *(const GAS unsigned*)(F.QF + ro);
        const float f0 = lba + (1.0f - lba) * sigm(bflo(fw)), f1 = lbb + (1.0f - lbb) * sigm(bfhi(fw));
        lf0[i] = __logf(f0); lf1[i] = __logf(f1); kk0[i] = 1.0f - f0; kk1[i] = 1.0f - f1;
        bl0 += lf0[i]; bl1 += lf1[i];
    }
    const size_t cb = ((size_t)DIR * NCH + cg) * 4 + head;
    const int kk = k0 & 15, fh = (kk >> 2) & 1, fj = (kk & 3) + 4 * (kk >> 3);
    const size_t qo = cb * 4096 + (size_t)((k0 >> 4) * 64 + 32 * fh) * 8 + fj;
    float b0 = 0.f, b1 = 0.f; unsigned kd0[16], kd1[16];
#pragma unroll
    for (int ip = 0; ip < 16; ++ip) {
        float d0[2], d1[2];
#pragma unroll
        for (int s = 0; s < 2; ++s) {
            const int i = 2 * ip + s, t = DIR ? 31 - i : i;
            b0 += lf0[i]; b1 += lf1[i];
            const float q0 = silu_f(bflo(qw[i])), q1 = silu_f(bfhi(qw[i]));
            *(GAS unsigned*)(F.QE + qo + t * 8) = pk2(q0 * __expf(b0), q1 * __expf(b1));
            *(GAS unsigned*)(F.KE + qo + t * 8) = pk2(kk0[i] * __expf(-b0), kk1[i] * __expf(-b1));
            d0[s] = kk0[i] * __expf(bl0 - b0); d1[s] = kk1[i] * __expf(bl1 - b1);
        }
        const int p = DIR ? 15 - ip : ip;
        kd0[p] = DIR ? pk2(d0[1], d0[0]) : pk2(d0[0], d0[1]);
        kd1[p] = DIR ? pk2(d1[1], d1[0]) : pk2(d1[0], d1[1]);
    }
    {
        const int ti = k0 >> 5, r = k0 & 31;
        bf16* kb = F.KDT + cb * 4096 + (size_t)(ti * 2) * 512 + (size_t)r * 8;
#pragma unroll
        for (int sp = 0; sp < 2; ++sp)
#pragma unroll
            for (int h = 0; h < 2; ++h) {
                const v4u a = {kd0[8 * sp + 2 * h], kd0[8 * sp + 2 * h + 1], kd0[8 * sp + 4 + 2 * h], kd0[8 * sp + 4 + 2 * h + 1]};
                const v4u b = {kd1[8 * sp + 2 * h], kd1[8 * sp + 2 * h + 1], kd1[8 * sp + 4 + 2 * h], kd1[8 * sp + 4 + 2 * h + 1]};
                *(GAS v4u*)(kb + sp * 512 + h * 256) = a; *(GAS v4u*)(kb + sp * 512 + h * 256 + 8) = b;
            }
        const int dh = (r >> 2) & 1, rg = (r & 3) + 4 * (r >> 3);
        *(f32x2*)(F.DEC + cb * 128 + ti * 32 + dh * 16 + rg) = (f32x2){__expf(bl0), __expf(bl1)};
    }
}
DI void vt_item(Frame& F, int cg, int head) {
    const int m0 = cg * 32, v0 = 2 * F.lane, hv = head * 128 + v0;
    unsigned w[32];
#pragma unroll
    for (int t = 0; t < 32; ++t) w[t] = *(const GAS unsigned*)(F.V + (size_t)(m0 + t) * 512 + hv);
    unsigned rl[16], rh[16];
#pragma unroll
    for (int p = 0; p < 16; ++p) { const unsigned x = w[2 * p], y = w[2 * p + 1]; rl[p] = (x & 0xffffu) | (y << 16); rh[p] = (x >> 16) | (y & 0xffff0000u); }
    bf16* vb = F.VT + ((size_t)(cg * 4 + head) * 4 + (v0 >> 5)) * 1024 + (size_t)(v0 & 31) * 8;
#pragma unroll
    for (int sp = 0; sp < 2; ++sp)
#pragma unroll
        for (int h = 0; h < 2; ++h) {
            const v4u a = {rl[8 * sp + 2 * h], rl[8 * sp + 2 * h + 1], rl[8 * sp + 4 + 2 * h], rl[8 * sp + 4 + 2 * h + 1]};
            const v4u b = {rh[8 * sp + 2 * h], rh[8 * sp + 2 * h + 1], rh[8 * sp + 4 + 2 * h], rh[8 * sp + 4 + 2 * h + 1]};
            *(GAS v4u*)(vb + sp * 512 + h * 256) = a; *(GAS v4u*)(vb + sp * 512 + h * 256 + 8) = b;
        }
}
#define MFMA32(a, b, c) __builtin_amdgcn_mfma_f32_32x32x16_bf16((a), (b), (c), 0, 0, 0)
DI void lru_gate_item(Frame& F, int tg, int n) {
    const int m0 = 64 * tg, r = F.lane & 31, h = F.lane >> 5;
    const int T = m0 < NCTX ? TCTX : TLAT, tseq0 = m0 < NCTX ? (m0 & (TCTX - 1)) : ((m0 - NCTX) & (TLAT - 1));
    bf16x8 xa[2][4];
#pragma unroll
    for (int ks = 0; ks < 4; ++ks) {
        const int c0 = 64 * n + 16 * ks + 8 * h;
        f32x4 w[4][2];
#pragma unroll
        for (int j = 0; j < 4; ++j) { w[j][0] = *(const f32x4*)(F.conv_w + j * 512 + c0); w[j][1] = *(const f32x4*)(F.conv_w + j * 512 + c0 + 4); }
        const f32x4 cb0 = *(const f32x4*)(F.conv_b + c0), cb1 = *(const f32x4*)(F.conv_b + c0 + 4);
#pragma unroll
        for (int mt = 0; mt < 2; ++mt) {
            const int tk = 32 * mt + r, m = m0 + tk, ts = tseq0 + tk;
            f32x4 a0 = cb0, a1 = cb1;
#pragma unroll
            for (int j = 0; j < 4; ++j) {
                const int tt = ts + j - 2; const bool ok = (tt >= 0) && (tt < T);
                const v4u lw = *(const GAS v4u*)(F.LX + (size_t)(ok ? m + j - 2 : m) * 512 + c0);
                const float z = ok ? 1.0f : 0.0f;
                a0 += (f32x4){bflo(lw.x), bfhi(lw.x), bflo(lw.y), bfhi(lw.y)} * (w[j][0] * z);
                a1 += (f32x4){bflo(lw.z), bfhi(lw.z), bflo(lw.w), bfhi(lw.w)} * (w[j][1] * z);
            }
            const v4u p = {pk2(a0.x, a0.y), pk2(a0.z, a0.w), pk2(a1.x, a1.y), pk2(a1.z, a1.w)};
            xa[mt][ks] = __builtin_bit_cast(bf16x8, p);
        }
    }
    f32x16 zero;
#pragma unroll
    for (int i = 0; i < 16; ++i) zero[i] = 0.f;
#pragma unroll
    for (int nt = 0; nt < 2; ++nt) {
        f32x16 xcC[2] = {zero, zero};
#pragma unroll
        for (int s = 0; s < 2; ++s) {
            bf16x8 bI;
#pragma unroll
            for (int j = 0; j < 8; ++j) bI[j] = (16 * s + 8 * h + j == r) ? (short)0x3F80 : (short)0;
#pragma unroll
            for (int mt = 0; mt < 2; ++mt) xcC[mt] = MFMA32(xa[mt][2 * nt + s], bI, xcC[mt]);
        }
        const int c = 64 * n + 32 * nt + r;
#pragma unroll
        for (int d = 0; d < 2; ++d) {
            f32x16 accA[2] = {zero, zero}, accX[2] = {zero, zero};
            const bf16* wa = F.WL + ((size_t)((0 * 2 + d) * 8 + n) * 64 + 32 * nt + r) * 64 + 8 * h;
            const bf16* wx = F.WL + ((size_t)((1 * 2 + d) * 8 + n) * 64 + 32 * nt + r) * 64 + 8 * h;
#pragma unroll
            for (int ks = 0; ks < 4; ++ks) {
                const bf16x8 ba_ = *(const GAS bf16x8*)(wa + 16 * ks), bx_ = *(const GAS bf16x8*)(wx + 16 * ks);
#pragma unroll
                for (int mt = 0; mt < 2; ++mt) { accA[mt] = MFMA32(xa[mt][ks], ba_, accA[mt]); accX[mt] = MFMA32(xa[mt][ks], bx_, accX[mt]); }
            }
            const float bias_a = F.lru_ba[d * 512 + c], bias_x = F.lru_bx[d * 512 + c];
            const float e = __expf(-F.lru_lambda[d * 512 + c]);
            const float sp8 = -8.0f * e * (1.0f - e * (0.5f - e * (0.33333333f - 0.25f * e)));
#pragma unroll
            for (int mt = 0; mt < 2; ++mt)
#pragma unroll
                for (int rg = 0; rg < 16; ++rg) {
                    const int tok = m0 + 32 * mt + (rg & 3) + 8 * (rg >> 2) + 4 * h;
                    const float rr = sigm(accA[mt][rg] + bias_a), ii = sigm(accX[mt][rg] + bias_x);
                    const float la = sp8 * rr, y = 2.0f * la;
                    const float em = -y * (1.0f + y * (0.5f + y * (0.16666667f + y * (0.041666668f + y * 0.0083333333f))));
                    const float u = __builtin_sqrtf(em) * ii * xcC[mt][rg];
                    const _Float16 lh = (_Float16)la;
                    F.GATES[((size_t)tok * 2 + d) * 512 + c] = (unsigned)__builtin_bit_cast(unsigned short, lh) | (pk2(0.f, u) & 0xffff0000u);
                }
        }
    }
}
DI void p3_prep(Frame& F) {
    const int gw = F.wave * F.G + F.vcu, NGW = F.G * NWAVES;
    constexpr int I_G = (NTOK / 64) * 8, I_HG = NCH * 8, I_VT = NCH * 4;
    for (int it = gw; it < I_G + I_HG + I_VT; it += NGW) {
        int r = it;
        if (r < I_G) { lru_gate_item(F, r >> 3, r & 7); continue; } r -= I_G;
        if (r < I_HG) { const int head = r & 3, dir = (r >> 2) & 1, cg = r >> 3; if (dir) hg_prep_item<1>(F, cg, head); else hg_prep_item<0>(F, cg, head); continue; } r -= I_HG;
        vt_item(F, r >> 2, r & 3);
    }
}

DI bf16x8 pack8(const f32x16& x, int s) {
    const v4u w = {pk2(x[8 * s], x[8 * s + 1]), pk2(x[8 * s + 2], x[8 * s + 3]), pk2(x[8 * s + 4], x[8 * s + 5]), pk2(x[8 * s + 6], x[8 * s + 7])};
    return __builtin_bit_cast(bf16x8, w);
}
DI bf16x8 ldfrag(const bf16* p) { return __builtin_bit_cast(bf16x8, *(const GAS v4u*)p); }
DI void hg_scan_item(Frame& F, int sq, int d, int head, int vs) {
    const int r = F.lane & 31, h = F.lane >> 5;
    const bool lat = sq >= 32;
    const int T = lat ? TLAT : TCTX, base = lat ? NCTX + (sq - 32) * TLAT : sq * TCTX, nch = T / 32;
    f32x16 S[4];
    if (lat) {
        const float* s0 = F.state_hgrn + ((size_t)((sq - 32) * 2 + d) * 4 + head) * 128 * 128 + 32 * vs;
        const unsigned so = (unsigned)(4 * h * 128 + r);
#pragma unroll
        for (int i = 0; i < 4; ++i)
#pragma unroll
            for (int rg = 0; rg < 16; ++rg) S[i][rg] = s0[so + (unsigned)((32 * i + (rg & 3) + 8 * (rg >> 2)) * 128)];
    } else {
#pragma unroll
        for (int i = 0; i < 4; ++i)
#pragma unroll
            for (int rg = 0; rg < 16; ++rg) S[i][rg] = 0.f;
    }
    const unsigned lo8 = (unsigned)F.lane * 8u, ooff = (unsigned)(r * 512 + 32 * vs + 4 * h);
    LAS float* dl = (LAS float*)(F.lds + RING_OFF + F.wave * 16384);
    bf16* OUTd = (d ? F.OB : F.OF) + head * 128;
    const int c0 = d ? nch - 1 : 0, cstep = d ? -1 : 1;
    size_t cb = ((size_t)d * NCH + (base >> 5) + c0) * 4 + head;
    size_t vb = ((size_t)((base >> 5) + c0) * 4 + head) * 4 + vs;
    bf16x8 qf[8], kf[8], vf[2];
#pragma unroll
    for (int ks = 0; ks < 8; ++ks) { qf[ks] = ldfrag(F.QE + cb * 4096 + ks * 512 + lo8); kf[ks] = ldfrag(F.KE + cb * 4096 + ks * 512 + lo8); }
    vf[0] = ldfrag(F.VT + vb * 1024 + lo8); vf[1] = ldfrag(F.VT + vb * 1024 + 512 + lo8);
    *(LAS f32x2*)(dl + 2 * F.lane) = *(const GAS f32x2*)(F.DEC + cb * 128 + 2 * F.lane);
    for (int ci = 0; ci < nch; ++ci) {
        const int m0 = base + 32 * (c0 + cstep * ci);
        const bool last = (ci == nch - 1);
        const size_t cbn = last ? cb : (size_t)((long)cb + 4 * cstep), vbn = last ? vb : (size_t)((long)vb + 16 * cstep);
        bf16x8 kd[8], qfn[8], kfn[8], vfn[2];
#pragma unroll
        for (int j = 0; j < 8; ++j) kd[j] = ldfrag(F.KDT + cb * 4096 + j * 512 + lo8);
        f32x16 X;
#pragma unroll
        for (int i = 0; i < 16; ++i) X[i] = 0.f;
#pragma unroll
        for (int ks = 0; ks < 8; ++ks) X = MFMA32(kf[ks], qf[ks], X);
#pragma unroll
        for (int ks = 0; ks < 8; ++ks) kfn[ks] = ldfrag(F.KE + cbn * 4096 + ks * 512 + lo8);
#pragma unroll
        for (int rg = 0; rg < 16; ++rg) { const int s = (rg & 3) + 8 * (rg >> 2) + 4 * h; const bool keep = d ? (s >= r) : (s <= r); X[rg] = keep ? X[rg] : 0.f; }
        f32x16 O;
#pragma unroll
        for (int i = 0; i < 16; ++i) O[i] = 0.f;
        O = MFMA32(vf[0], pack8(X, 0), O); O = MFMA32(vf[1], pack8(X, 1), O);
#pragma unroll
        for (int i = 0; i < 4; ++i) { O = MFMA32(pack8(S[i], 0), qf[2 * i], O); O = MFMA32(pack8(S[i], 1), qf[2 * i + 1], O); }
#pragma unroll
        for (int ks = 0; ks < 8; ++ks) qfn[ks] = ldfrag(F.QE + cbn * 4096 + ks * 512 + lo8);
        const f32x2 dn = *(const GAS f32x2*)(F.DEC + cbn * 128 + 2 * F.lane);
        {
            bf16* op = OUTd + (size_t)m0 * 512;
#pragma unroll
            for (int g = 0; g < 4; ++g) { const v2u w = {pk2(O[4 * g], O[4 * g + 1]), pk2(O[4 * g + 2], O[4 * g + 3])}; *(GAS v2u*)(op + ooff + 8 * g) = w; }
        }
        const LAS float* dc = dl + (ci & 1) * 128 + h * 16;
#pragma unroll
        for (int i = 0; i < 4; ++i) {
#pragma unroll
            for (int g = 0; g < 4; ++g) { const f32x4 dv = *(const LAS f32x4*)(dc + i * 32 + 4 * g);
#pragma unroll
                for (int j = 0; j < 4; ++j) S[i][4 * g + j] *= dv[j]; }
            S[i] = MFMA32(kd[2 * i], vf[0], S[i]); S[i] = MFMA32(kd[2 * i + 1], vf[1], S[i]);
        }
        vfn[0] = ldfrag(F.VT + vbn * 1024 + lo8); vfn[1] = ldfrag(F.VT + vbn * 1024 + 512 + lo8);
        *(LAS f32x2*)(dl + ((ci + 1) & 1) * 128 + 2 * F.lane) = dn;
#pragma unroll
        for (int ks = 0; ks < 8; ++ks) { qf[ks] = qfn[ks]; kf[ks] = kfn[ks]; }
        vf[0] = vfn[0]; vf[1] = vfn[1];
        cb = cbn; vb = vbn;
    }
    if (!lat) {
        float* so = F.out + OUT_SHG + ((size_t)(sq * 2 + d) * 4 + head) * 128 * 128 + 32 * vs;
        const unsigned sof = (unsigned)(4 * h * 128 + r);
#pragma unroll
        for (int i = 0; i < 4; ++i)
#pragma unroll
            for (int rg = 0; rg < 16; ++rg) so[sof + (unsigned)((32 * i + (rg & 3) + 8 * (rg >> 2)) * 128)] = S[i][rg];
    }
}
DI void lru_scan_item(Frame& F, int sq, int d, int cgp) {
    const bool lat = sq >= 32;
    const int T = lat ? TLAT : TCTX, base = lat ? NCTX + (sq - 32) * TLAT : sq * TCTX, c = 64 * cgp + F.lane;
    float hs = lat ? F.state_rglru[(size_t)((sq - 32) * 2 + d) * 512 + c] : 0.f;
    const int t0 = d ? base + T - 1 : base, ts = d ? -1 : 1;
    const unsigned* gp = F.GATES + (size_t)d * 512 + c; bf16* op = (d ? F.HB : F.HF) + c;
    constexpr int U = 16, NB = 8;
    unsigned g[NB][U];
#pragma unroll
    for (int b = 0; b < NB; ++b)
#pragma unroll
        for (int u = 0; u < U; ++u) g[b][u] = *(const GAS unsigned*)(gp + (size_t)(t0 + ts * (b * U + u)) * 1024);
    for (int i0 = 0; i0 < T; i0 += U * NB) {
#pragma unroll
        for (int b = 0; b < NB; ++b) {
#pragma unroll
            for (int u = 0; u < U; ++u) {
                const int t = t0 + ts * (i0 + b * U + u);
                const float la = (float)__builtin_bit_cast(_Float16, (unsigned short)(g[b][u] & 0xffffu));
                hs = __expf(la) * hs + bfhi(g[b][u]);
                op[(size_t)t * 512] = (bf16)(pk2(hs, 0.f) & 0xffffu);
            }
            if (i0 + U * NB < T) {
#pragma unroll
                for (int u = 0; u < U; ++u) g[b][u] = *(const GAS unsigned*)(gp + (size_t)(t0 + ts * (i0 + U * NB + b * U + u)) * 1024);
            }
        }
    }
    if (!lat) F.out[OUT_SLRU + (size_t)(sq * 2 + d) * 512 + c] = hs;
}
DI void p4_scans(Frame& F) {
    const int sub = F.wave & 3;
    for (int vh = (F.wave >> 2) * F.G + F.vcu; vh < 32 + 256 + 144; vh += 2 * F.G) {
        if (vh < 32) { hg_scan_item(F, 32 + (vh >> 3), (vh >> 2) & 1, vh & 3, sub); continue; }
        const int idx = vh - 32;
        if (idx < 256) { hg_scan_item(F, idx >> 3, (idx >> 2) & 1, idx & 3, sub); continue; }
        const int li = (idx - 256) * 4 + sub;
        if (li < 64) lru_scan_item(F, 32 + (li >> 4), (li >> 3) & 1, li & 7);
        else { const int l2 = li - 64; lru_scan_item(F, l2 >> 4, (l2 >> 3) & 1, l2 & 7); }
    }
}

constexpr int N_PHASES = 11;
struct Args { const float* in[24]; float* out; unsigned char* ws; int ph_lo, ph_hi, li, pad; };
__global__ void __launch_bounds__(NWAVES * 64, 2) mk_fwd(Args args) {
    extern __shared__ __attribute__((aligned(16))) unsigned char lds[];
    Frame F;
    F.lds = (LAS unsigned char*)lds;
    F.tid = threadIdx.x; F.lane = F.tid & 63; F.wave = __builtin_amdgcn_readfirstlane(F.tid >> 6);
    F.G = gridDim.x; { const int bx = blockIdx.x; F.vcu = (F.G % 8 == 0) ? (bx % 8) * (F.G / 8) + bx / 8 : bx; }
    unsigned char* ws = args.ws;
    F.x_prompt = args.in[0]; F.x_sample = args.in[1]; F.cvec = args.in[2]; F.state_hgrn = args.in[3]; F.state_rglru = args.in[4]; F.c_ctx = args.in[5];
    F.w_ada = args.in[6]; F.b_ada = args.in[7]; F.norm1_gain = args.in[8]; F.norm2_gain = args.in[9]; F.w_in = args.in[10]; F.lb_logits = args.in[11];
    F.hg_norm_gain = args.in[12]; F.conv_w = args.in[13]; F.conv_b = args.in[14]; F.lru_wa = args.in[15]; F.lru_ba = args.in[16]; F.lru_wx = args.in[17];
    F.lru_bx = args.in[18]; F.lru_lambda = args.in[19]; F.w_out = args.in[20]; F.w_ff1 = args.in[21]; F.w_ff2 = args.in[22]; F.final_gain = args.in[23];
    F.out = args.out;
    F.Win_t = (bf16*)(ws + WS_WIN); F.Wout_t = (bf16*)(ws + WS_WOUT); F.Wff1_t = (bf16*)(ws + WS_WFF1); F.Wff2_t = (bf16*)(ws + WS_WFF2); F.WL = (bf16*)(ws + WS_WL);
    F.MOD = (float*)(ws + WS_MOD); F.XS = (float*)(ws + WS_XS); F.DEC = (float*)(ws + WS_DEC);
    F.ACT = (bf16*)(ws + WS_ACT); F.QF = (bf16*)(ws + WS_QF); F.V = (bf16*)(ws + WS_V); F.GL = (bf16*)(ws + WS_GL); F.LX = (bf16*)(ws + WS_LX);
    F.QE = (bf16*)(ws + WS_QE); F.KE = (bf16*)(ws + WS_KE); F.KDT = (bf16*)(ws + WS_KDT); F.VT = (bf16*)(ws + WS_VT);
    F.OF = (bf16*)(ws + WS_OF); F.OB = (bf16*)(ws + WS_OB); F.HF = (bf16*)(ws + WS_HF); F.HB = (bf16*)(ws + WS_HB); F.HID = (bf16*)(ws + WS_HID);
    F.GATES = (unsigned*)args.out;
    volatile LAS unsigned* MISC = (volatile LAS unsigned*)(F.lds + LDSCTL_OFF);
    for (int u = F.tid; u < 128; u += NWAVES * 64) MISC[u] = 0u;
    __syncthreads();
    const int lo = args.ph_lo, hi = args.ph_hi;
    XcdBarrier bar; bar.bar = (unsigned*)(ws + WS_CTL); bar.x = 0; bar.st = nullptr;
    if (hi - lo > 1) bar = xcd_barrier_post((unsigned*)(ws + WS_CTL), MISC + 8);
#define IN(k) (lo <= (k) && (k) < hi)
#define SEAM(k) do { if (IN(k) && IN((k) + 1)) xcd_barrier(bar); } while (0)
#ifndef RPT
#define RPT -1
#endif
#define NREP(k) ((RPT == (k)) ? 2 : 1)

    if (IN(0)) { for (int rp = 0; rp < NREP(0); ++rp) { p0_prologue(F); __syncthreads(); } } SEAM(0);
    if (IN(1)) { for (int rp = 0; rp < NREP(1); ++rp) p1_rows(F); } SEAM(1);
    if (IN(2)) for (int rp = 0; rp < NREP(2); ++rp) {
        pg8::Gemm g{F.ACT, F.Win_t, NTOK, INC, D}; pg8::StaticOrder S; S.init(NTOK, INC, F.G, (int)blockIdx.x);
        pg8::EpiRoute E{F.QF, F.V, F.GL, F.LX};
        pg8::gemm_phase<pg8::EpiRoute, pg8::StaticOrder, PG8_ALIGN, PG8_SP2>(F.lds + RING_OFF, g, S, E);
    } SEAM(2);
    if (IN(3)) { for (int rp = 0; rp < NREP(3); ++rp) p3_prep(F); } SEAM(3);
    if (IN(4)) { for (int rp = 0; rp < NREP(4); ++rp) p4_scans(F); } SEAM(4);
    if (IN(5)) { for (int rp = 0; rp < NREP(5); ++rp) p5_rows(F); } SEAM(5);
    if (IN(6)) for (int rp = 0; rp < NREP(6); ++rp) {
        pg8::Gemm g{F.ACT, F.Wout_t, NTOK, D, D}; pg8::StaticOrder S; S.init(NTOK, D, F.G, (int)blockIdx.x);
        pg8::EpiResid E{F.x_prompt, F.XS, F.out, F.MOD + 2048};
        pg8::gemm_phase<pg8::EpiResid, pg8::StaticOrder, PG8_ALIGN, PG8_SP2>(F.lds + RING_OFF, g, S, E);
    } SEAM(6);
    if (IN(7)) { for (int rp = 0; rp < NREP(7); ++rp) p7_rows(F); } SEAM(7);
    if (IN(8)) for (int rp = 0; rp < NREP(8); ++rp) {
        pg8::Gemm g{F.ACT, F.Wff1_t, NTOK, DFF, D}; pg8::StaticOrder S; S.init(NTOK, DFF, F.G, (int)blockIdx.x);
        pg8::EpiRelu2 E{F.HID, DFF};
        pg8::gemm_phase<pg8::EpiRelu2, pg8::StaticOrder, PG8_ALIGN, PG8_SP2>(F.lds + RING_OFF, g, S, E);
    } SEAM(8);
    if (IN(9)) {
        pg8::Gemm g{F.HID, F.Wff2_t, NTOK, D, DFF}; pg8::StaticOrder S; S.init(NTOK, D, F.G, (int)blockIdx.x);
        pg8::EpiResid E{F.out, F.out + (size_t)NCTX * D, F.out, F.MOD + 5120};
        pg8::gemm_phase<pg8::EpiResid, pg8::StaticOrder, PG8_ALIGN, PG8_SP2>(F.lds + RING_OFF, g, S, E);
    } SEAM(9);
    if (IN(10)) { p10_rows(F); }
#undef IN
#undef SEAM
}

extern "C" void kernel_launch(void* const* d_in, const int* in_sizes, int n_in, void* d_out, int out_size, void* d_ws, size_t ws_size, hipStream_t stream) {
    static int grid = 0;
    if (grid == 0) {
        if (n_in != 24 || in_sizes[0] != NCTX * D || ws_size < WS_END) { fprintf(stderr, "kernel_launch: unexpected shapes (n_in %d, in0 %d, out %d, ws %zu)\n", n_in, n_in > 0 ? in_sizes[0] : -1, out_size, ws_size); grid = -1; return; }
        int dev = 0, cus = 0, per_cu = 0;
        if (hipGetDevice(&dev) != hipSuccess || hipDeviceGetAttribute(&cus, hipDeviceAttributeMultiprocessorCount, dev) != hipSuccess) { grid = -1; return; }
        if (hipFuncSetAttribute((const void*)mk_fwd, hipFuncAttributeMaxDynamicSharedMemorySize, LDS_BYTES) != hipSuccess) { fprintf(stderr, "kernel_launch: hipFuncSetAttribute failed\n"); grid = -1; return; }
        if (hipOccupancyMaxActiveBlocksPerMultiprocessor(&per_cu, (const void*)mk_fwd, NWAVES * 64, LDS_BYTES) != hipSuccess || per_cu < 1)
            fprintf(stderr, "kernel_launch: occupancy query reports %d workgroups per CU\n", per_cu);
        (void)hipGetLastError();
        grid = cus;
    }
    if (grid < 0) return;
    if (hipMemsetAsync((char*)d_ws + WS_CTL, 0, CTL_ZERO_BYTES, stream) != hipSuccess) return;
    Args a{};
    for (int i = 0; i < 24; ++i) a.in[i] = (const float*)d_in[i];
    a.out = (float*)d_out; a.ws = (unsigned char*)d_ws;
    constexpr int NL = MK_N_LAUNCHES;
    for (int li = 0; li < NL; ++li) {
        a.ph_lo = (NL == 1) ? 0 : li; a.ph_hi = (NL == 1) ? N_PHASES : li + 1; a.li = li;
        hipLaunchKernelGGL(mk_fwd, dim3(grid), dim3(NWAVES * 64), LDS_BYTES, stream, a);
    }
}
```

```cpp
#include <hip/hip_runtime.h>
#include <cstdio>
#include <cstdint>

#ifndef MK_N_LAUNCHES
#define MK_N_LAUNCHES 1
#endif

#define DI __device__ __forceinline__
#define GAS __attribute__((address_space(1)))
#define LAS __attribute__((address_space(3)))
typedef unsigned short bf16;
typedef unsigned v4u __attribute__((ext_vector_type(4)));
typedef unsigned v2u __attribute__((ext_vector_type(2)));
typedef float f32x2 __attribute__((ext_vector_type(2)));
typedef float f32x4 __attribute__((ext_vector_type(4)));
typedef float f32x16 __attribute__((ext_vector_type(16)));
typedef short bf16x8 __attribute__((ext_vector_type(8)));
typedef short s16x4 __attribute__((ext_vector_type(4)));
typedef __bf16 bf2_t __attribute__((ext_vector_type(2)));

DI unsigned pk2(float lo, float hi) { f32x2 v = {lo, hi}; return __builtin_bit_cast(unsigned, __builtin_convertvector(v, bf2_t)); }
DI float bflo(unsigned w) { return __uint_as_float(w << 16); }
DI float bfhi(unsigned w) { return __uint_as_float(w & 0xffff0000u); }
DI float sigm(float x) { return __builtin_amdgcn_rcpf(1.0f + __expf(-x)); }
DI float silu_f(float x) { return x * sigm(x); }
DI float gelu_tanh_f(float x) { const float u = 0.7978845608028654f * (x + 0.044715f * x * x * x); return x * sigm(2.0f * u); }
DI float wave_sum(float v) {
#pragma unroll
    for (int o = 1; o < 64; o <<= 1) v += __shfl_xor(v, o);
    return v;
}
#define LDS_WAIT() asm volatile("s_waitcnt lgkmcnt(0)" ::: "memory")
#define VM_WAIT() asm volatile("s_waitcnt vmcnt(0)" ::: "memory")

constexpr int D = 1024, NTOK = 12288, NCTX = 8192, TCTX = 256, TLAT = 1024;
constexpr int INC = 4096, DFF = 4096, NCH = NTOK / 32;
constexpr float EPS = 1e-6f;
constexpr int NWAVES = 8;

constexpr size_t MiB = 1u << 20;
constexpr size_t WS_CTL = 0, CTL_ZERO_BYTES = 64 * 1024;
constexpr size_t WS_WIN = 1 * MiB, WS_WOUT = 9 * MiB, WS_WFF1 = 11 * MiB, WS_WFF2 = 19 * MiB;
constexpr size_t WS_MOD = 27 * MiB;
constexpr size_t WS_WL = 27 * MiB + 256 * 1024;
constexpr size_t WS_LC = 27 * MiB + 640 * 1024;
constexpr size_t WS_ACT = 28 * MiB;
constexpr size_t WS_XS = 52 * MiB;
constexpr size_t WS_QF = 68 * MiB;
constexpr size_t WS_OF = 68 * MiB, WS_OB = 80 * MiB, WS_HF = 92 * MiB, WS_HB = 104 * MiB;
constexpr size_t WS_V = 116 * MiB;
constexpr size_t WS_PC = 116 * MiB;
constexpr size_t WS_XF = 250 * MiB;
constexpr size_t WS_GL = 128 * MiB;
constexpr size_t WS_LX = 152 * MiB;
constexpr size_t WS_QE = 164 * MiB, WS_KE = 188 * MiB;
constexpr size_t WS_KDT = 212 * MiB;
constexpr size_t WS_DEC = 236 * MiB;
constexpr size_t WS_VT = 238 * MiB;
constexpr size_t WS_HID = 68 * MiB;
constexpr size_t WS_END = 256 * MiB;

constexpr int RING_OFF = 0, RING_BYTES = 131072;
constexpr int LDSCTL_OFF = RING_BYTES;
constexpr int CT_OFF = RING_BYTES + 1024;
constexpr int LDS_BYTES = 160 * 1024;
static_assert(CT_OFF + 5 * 1024 * 4 <= LDS_BYTES, "LDS map");

#define XB_TMO      128
#define XB_XCNT(j)  (256  + 64 * (j))
#define XB_XSUB(j)  (1280 + 64 * (j))
#define XB_XGEN(j)  (2304 + 64 * (j))
#define XB_TOP      3328
#define XB_TOPGEN   3392
#define XCD_BAR_WORDS 3456
#define XB_SPIN_CAP (1u << 18)
static_assert(XCD_BAR_WORDS * 4 <= CTL_ZERO_BYTES, "barrier words inside the memset region");

DI unsigned xb_ld(unsigned* p)              { return __hip_atomic_load(p, __ATOMIC_RELAXED, __HIP_MEMORY_SCOPE_AGENT); }
DI unsigned xb_add(unsigned* p, unsigned v) { return __hip_atomic_fetch_add(p, v, __ATOMIC_RELAXED, __HIP_MEMORY_SCOPE_AGENT); }
DI unsigned xb_xcc_id() { return (unsigned)__builtin_amdgcn_s_getreg((3 << 11) | 20) & 0xFu; }
#define XB_SPIN(cond, bar) do { unsigned _sp = 0; while (cond) { __builtin_amdgcn_s_sleep(1); \
    if ((++_sp & 255u) == 0u) { if (xb_ld(&(bar)[XB_TMO])) break; if (_sp > XB_SPIN_CAP) { atomicAdd(&(bar)[XB_TMO], 1u); break; } } } } while (0)

struct XcdBarrier { unsigned* bar; unsigned x; volatile LAS unsigned* st; };

DI XcdBarrier xcd_barrier_post(unsigned* bar, volatile LAS unsigned* st) {
    XcdBarrier b; b.bar = bar; b.x = xb_xcc_id(); b.st = st;
    if (threadIdx.x == 0) (void)xb_add(&bar[XB_XCNT(b.x)], 1u);
    return b;
}
DI void xcd_barrier_complete(unsigned* bar, unsigned x, unsigned& nloc, unsigned& nx) {
    const unsigned G = gridDim.x * gridDim.y * gridDim.z;
    unsigned sum, cnt, mine, sp = 0u;
    for (;;) {
        sum = 0u; cnt = 0u; mine = 0u;
#pragma unroll
        for (unsigned j = 0; j < 16; ++j) { const unsigned c = xb_ld(&bar[XB_XCNT(j)]); sum += c; cnt += (c > 0u) ? 1u : 0u; mine = (j == x) ? c : mine; }
        if (sum == G) break;
        __builtin_amdgcn_s_sleep(1);
        if ((++sp & 255u) == 0u) { if (xb_ld(&bar[XB_TMO])) break; if (sp > XB_SPIN_CAP) { atomicAdd(&bar[XB_TMO], 1u); break; } }
    }
    nloc = mine > 0u ? mine : 1u; nx = cnt > 0u ? cnt : 1u;
}
DI void xcd_barrier(const XcdBarrier& b) {
    asm volatile("s_waitcnt vmcnt(0)" ::: "memory");
    __syncthreads();
    if (threadIdx.x == 0) {
        unsigned* bar = b.bar;
        __builtin_amdgcn_s_waitcnt(0);
        unsigned nloc = b.st[0], nx = b.st[1];
        if (nloc == 0u) { xcd_barrier_complete(bar, b.x, nloc, nx); b.st[0] = nloc; b.st[1] = nx; }
        const unsigned old = xb_add(&bar[XB_XSUB(b.x)], 1u);
        const unsigned gen = old / nloc;
        if (old + 1u == (gen + 1u) * nloc) {
            __builtin_amdgcn_fence(__ATOMIC_RELEASE, "agent");
            asm volatile("s_waitcnt vmcnt(0)" ::: "memory");
            const unsigned og = xb_add(&bar[XB_TOP], 1u);
            const unsigned tg = og / nx;
            if (og + 1u == (tg + 1u) * nx) xb_add(&bar[XB_TOPGEN], 1u);
            else XB_SPIN(xb_ld(&bar[XB_TOPGEN]) == tg, bar);
            __builtin_amdgcn_fence(__ATOMIC_ACQUIRE, "agent");
            xb_add(&bar[XB_XGEN(b.x)], 1u);
            asm volatile("s_waitcnt vmcnt(0)" ::: "memory");
        } else {
            XB_SPIN(xb_ld(&bar[XB_XGEN(b.x)]) == gen, bar);
            __builtin_amdgcn_fence(__ATOMIC_ACQUIRE, "agent");
            asm volatile("s_waitcnt vmcnt(0)" ::: "memory");
        }
    }
    __syncthreads();
}

namespace pg8 {
#define PG8_LAS __attribute__((address_space(3)))
typedef unsigned short bf16_t;
typedef short bf16x8 __attribute__((ext_vector_type(8)));
typedef float f32x4 __attribute__((ext_vector_type(4)));
typedef unsigned u32x4 __attribute__((ext_vector_type(4)));
constexpr int BM = 256, BK = 64, HALF = 128, HTB = HALF * BK * 2  , STAGE_BYTES = 8 * HTB, NXCD = 8, WGM = 8;

__host__ __device__ __forceinline__ int lds_byte(int r, int c) { const int st = (r >> 4) * 2 + (c >> 5), rr = r & 15, cc = c & 31, ob = rr * 64 + cc * 2; return st * 1024 + (ob ^ (((ob >> 9) & 1) << 5)); }
__host__ __device__ __forceinline__ void stage_rc(int b, int& R, int& C) { const int st = b / 1024, sb = b % 1024, swz = sb ^ (((sb >> 9) & 1) << 5); R = (st >> 1) * 16 + swz / 64; C = (st & 1) * 32 + (swz % 64) / 2; }
__host__ __device__ __forceinline__ int perm32(int rho) { const int n = rho >> 4, i = rho & 15; return 8 * (i >> 2) + 4 * n + (i & 3); }

struct Unit { int pm, pn; };
struct Gemm { const bf16_t* A; const bf16_t* Bt; int M, N, K; };

struct StaticOrder {
    int nM, nN, nwg, G, c;
    __host__ __device__ void init(int M, int N, int G_, int c_) { nM = M / BM; nN = N / BM; nwg = nM * nN; G = G_; c = c_; }
    __host__ __device__ bool next(int i, Unit& u) const {
        const long L = (long)i * G + c; if (L >= nwg) return false;
        int wgid = (int)L; { const int q = nwg / NXCD, r = nwg % NXCD, xcd = wgid % NXCD, off = wgid / NXCD; wgid = (xcd < r ? xcd * (q + 1) : r * (q + 1) + (xcd - r) * q) + off; }
        const int nig = WGM * nN, gid = wgid / nig, fm = gid * WGM, gsz = (nM - fm) < WGM ? (nM - fm) : WGM;
        u.pm = fm + ((wgid % nig) % gsz); u.pn = (wgid % nig) / gsz; return true;
    }
    __device__ __forceinline__ void a_ready(const Unit&) const {}
    __device__ __forceinline__ void done(const Unit&) const {}
};

__device__ __forceinline__ unsigned cvt_pk_bf16(float lo, float hi) { return pk2(lo, hi); }
__device__ __forceinline__ int cond_of_pm(int pm) { return pm < 32 ? 0 : 1 + ((pm - 32) >> 2); }

struct EpiRoute {
    static constexpr bool PERM = true, AFTER_DRAIN = false;
    bf16_t *QF, *V, *GL, *LX;
    __device__ __forceinline__ void operator()(const f32x4 (&acc)[2][2][4][2], const Unit& u, int wr, int wc, int fr, int fq) const {
        const int pn = u.pn; bf16_t* base; int ldc, colt;
        if (pn < 8) { base = QF; ldc = 2048; colt = pn * 256; }
        else if (pn < 10) { base = V; ldc = 512; colt = (pn - 8) * 256; }
        else if (pn < 12) { base = GL; ldc = 1024; colt = (pn - 10) * 256; }
        else if (pn < 14) { base = LX; ldc = 512; colt = (pn - 12) * 256; }
        else { base = GL; ldc = 1024; colt = 512 + (pn - 14) * 256; }
        const int row0 = u.pm * BM + wr * 64 + fr, col0 = colt + wc * 32 + 8 * fq;
#pragma unroll
        for (int ai = 0; ai < 2; ++ai)
#pragma unroll
            for (int m = 0; m < 4; ++m) { bf16_t* rowp = base + (size_t)(row0 + ai * HALF + m * 16) * ldc + col0;
#pragma unroll
                for (int bj = 0; bj < 2; ++bj) { const f32x4 v0 = acc[ai][bj][m][0], v1 = acc[ai][bj][m][1];
                    u32x4 w; w.x = cvt_pk_bf16(v0[0], v0[1]); w.y = cvt_pk_bf16(v0[2], v0[3]); w.z = cvt_pk_bf16(v1[0], v1[1]); w.w = cvt_pk_bf16(v1[2], v1[3]);
                    *(u32x4*)(rowp + bj * HALF) = w; } }
    }
};
struct EpiRelu2 {
    static constexpr bool PERM = true, AFTER_DRAIN = false;
    bf16_t* O; int ldc;
    __device__ __forceinline__ void operator()(const f32x4 (&acc)[2][2][4][2], const Unit& u, int wr, int wc, int fr, int fq) const {
        const int row0 = u.pm * BM + wr * 64 + fr, col0 = u.pn * BM + wc * 32 + 8 * fq;
#pragma unroll
        for (int ai = 0; ai < 2; ++ai)
#pragma unroll
            for (int m = 0; m < 4; ++m) { bf16_t* rowp = O + (size_t)(row0 + ai * HALF + m * 16) * ldc + col0;
#pragma unroll
                for (int bj = 0; bj < 2; ++bj) { f32x4 v0 = acc[ai][bj][m][0], v1 = acc[ai][bj][m][1];
#pragma unroll
                    for (int j = 0; j < 4; ++j) { const float a = fmaxf(v0[j], 0.f), b = fmaxf(v1[j], 0.f); v0[j] = a * a; v1[j] = b * b; }
                    u32x4 w; w.x = cvt_pk_bf16(v0[0], v0[1]); w.y = cvt_pk_bf16(v0[2], v0[3]); w.z = cvt_pk_bf16(v1[0], v1[1]); w.w = cvt_pk_bf16(v1[2], v1[3]);
                    *(u32x4*)(rowp + bj * HALF) = w; } }
    }
};
struct EpiResid {
    static constexpr bool PERM = false, AFTER_DRAIN = false;
    const float* resA; const float* resB; float* out; const float* gate;
    __device__ __forceinline__ void operator()(const f32x4 (&acc)[2][2][4][2], const Unit& u, int wr, int wc, int fr, int fq) const {
        const int row0 = u.pm * BM + wr * 64 + fr, col0 = u.pn * BM + wc * 32 + 4 * fq;
        const float* g = gate + cond_of_pm(u.pm) * 6144 + col0;
        const float* res = (u.pm < 32) ? resA + (size_t)row0 * 1024 : resB + (size_t)(row0 - 8192) * 1024;
        f32x4 gv[2][2];
#pragma unroll
        for (int bj = 0; bj < 2; ++bj)
#pragma unroll
            for (int n = 0; n < 2; ++n) gv[bj][n] = *(const f32x4*)(g + bj * HALF + n * 16);
#pragma unroll
        for (int ai = 0; ai < 2; ++ai)
#pragma unroll
            for (int m = 0; m < 4; ++m) { const size_t ro = (size_t)(ai * HALF + m * 16) * 1024 + col0; float* rowp = out + (size_t)row0 * 1024 + ro;
#pragma unroll
                for (int bj = 0; bj < 2; ++bj)
#pragma unroll
                    for (int n = 0; n < 2; ++n) { const f32x4 rv = *(const f32x4*)(res + ro + bj * HALF + n * 16); *(f32x4*)(rowp + bj * HALF + n * 16) = rv + gv[bj][n] * acc[ai][bj][m][n]; } }
    }
};

template <class Epi, class Sched, bool ALIGN_EPI = false, bool SP2 = false>
__device__ __forceinline__ void gemm_phase(PG8_LAS unsigned char* lds, const Gemm g, const Sched& S, const Epi& E) {
    const int tid = threadIdx.x, wid = __builtin_amdgcn_readfirstlane(tid >> 6), lane = tid & 63, wr = wid >> 2, wc = wid & 3, fr = lane & 15, fq = lane >> 4;
    const int K = g.K, nt = K / BK;
    unsigned voffA[2], voffB[2];
#pragma unroll
    for (int i = 0; i < 2; ++i) { int R, C; stage_rc(tid * 16 + i * 8192, R, C); const int Rb = Epi::PERM ? ((R & ~31) + perm32(R & 31)) : R;
        voffA[i] = (unsigned)(R * K + C) * 2u; voffB[i] = (unsigned)(Rb * K + C) * 2u; }
    const size_t kstep = (size_t)(BK * 2);
    const size_t hstep = (size_t)HALF * K * 2;
    const size_t tstep = 2 * hstep;
    const unsigned ldsw = (unsigned)wid * 1024u;
    const int aoff = lds_byte(wr * 64 + fr, fq * 8), boff = lds_byte(wc * 32 + fr, fq * 8);
#define PG8_SA(b, h) (((b) * 2 + (h)) * HTB)
#define PG8_SB(b, h) ((4 + (b) * 2 + (h)) * HTB)
#define PG8_STAGE(bufoff, gbase, voff) do { _Pragma("unroll") for (int _i = 0; _i < 2; ++_i) \
        __builtin_amdgcn_global_load_lds((const unsigned*)((const char*)(gbase) + (voff)[_i]), (PG8_LAS unsigned*)(lds + (bufoff) + ldsw + _i * 8192), 16, 0, 0); } while (0)
#define PG8_LDA(dst, b, h) do { _Pragma("unroll") for (int m = 0; m < 4; ++m) _Pragma("unroll") for (int k = 0; k < 2; ++k) dst[m][k] = *(const PG8_LAS bf16x8*)(lds + PG8_SA(b, h) + aoff + m * 2048 + k * 1024); } while (0)
#define PG8_LDB(dst, b, h) do { _Pragma("unroll") for (int n = 0; n < 2; ++n) _Pragma("unroll") for (int k = 0; k < 2; ++k) dst[n][k] = *(const PG8_LAS bf16x8*)(lds + PG8_SB(b, h) + boff + n * 2048 + k * 1024); } while (0)
#define PG8_MMA(ai, bj, At, Bt) do { __builtin_amdgcn_s_setprio(1); _Pragma("unroll") for (int m = 0; m < 4; ++m) _Pragma("unroll") for (int n = 0; n < 2; ++n) _Pragma("unroll") for (int k = 0; k < 2; ++k) \
        acc[ai][bj][m][n] = __builtin_amdgcn_mfma_f32_16x16x32_bf16(Bt[n][k], At[m][k], acc[ai][bj][m][n], 0, 0, 0); __builtin_amdgcn_s_setprio(0); } while (0)
#define PG8_WAIT_V(n) asm volatile("s_waitcnt vmcnt(" #n ")" ::: "memory")
#define PG8_WAIT_L(n) asm volatile("s_waitcnt lgkmcnt(" #n ")" ::: "memory")
#define PG8_BAR __builtin_amdgcn_s_barrier()
#define PG8_SCHED __builtin_amdgcn_sched_barrier(0)
    Unit cur, nxt; int ui = 0;
    if (!S.next(0, cur)) return;
    f32x4 acc[2][2][4][2];
#pragma unroll
    for (int a = 0; a < 2; ++a)
#pragma unroll
        for (int b = 0; b < 2; ++b)
#pragma unroll
            for (int m = 0; m < 4; ++m)
#pragma unroll
                for (int n = 0; n < 2; ++n) acc[a][b][m][n] = (f32x4){0.f, 0.f, 0.f, 0.f};
    bf16x8 At[4][2], B0[2][2], B1[2][2];
    const char* cA = (const char*)g.A + (size_t)cur.pm * tstep; const char* cB = (const char*)g.Bt + (size_t)cur.pn * tstep;
    S.a_ready(cur);
    if constexpr (SP2) {
        PG8_STAGE(PG8_SB(0, 0), cB, voffB); PG8_STAGE(PG8_SB(0, 1), cB + hstep, voffB); PG8_STAGE(PG8_SA(0, 0), cA, voffA); PG8_STAGE(PG8_SA(0, 1), cA + hstep, voffA);
        if (wr == 1) PG8_BAR;
        PG8_WAIT_V(2); PG8_BAR;
        PG8_STAGE(PG8_SB(1, 0), cB + kstep, voffB); PG8_STAGE(PG8_SA(1, 0), cA + kstep, voffA); PG8_STAGE(PG8_SB(1, 1), cB + hstep + kstep, voffB);
        PG8_WAIT_V(6); PG8_BAR;
    } else {
        PG8_STAGE(PG8_SB(0, 0), cB, voffB); PG8_STAGE(PG8_SA(0, 0), cA, voffA); PG8_STAGE(PG8_SB(0, 1), cB + hstep, voffB); PG8_STAGE(PG8_SA(0, 1), cA + hstep, voffA);
        if (wr == 1) PG8_BAR;
        PG8_WAIT_V(4); PG8_BAR;
        PG8_STAGE(PG8_SB(1, 0), cB + kstep, voffB); PG8_STAGE(PG8_SA(1, 0), cA + kstep, voffA); PG8_STAGE(PG8_SB(1, 1), cB + hstep + kstep, voffB);
        PG8_WAIT_V(6); PG8_BAR;
    }
    for (;;) {
        const bool has_next = S.next(ui + 1, nxt);
        const char* nA = has_next ? (const char*)g.A + (size_t)nxt.pm * tstep : cA; const char* nB = has_next ? (const char*)g.Bt + (size_t)nxt.pn * tstep : cB;
        for (int t = 0; t < nt; t += 2) {
            const bool last = (t == nt - 2);
            const char* a1 = cA + (size_t)(t + 1) * kstep;
            const char* a2 = last ? nA : cA + (size_t)(t + 2) * kstep; const char* b2 = last ? nB : cB + (size_t)(t + 2) * kstep;
            const char* a3 = a2 + kstep; const char* b3 = b2 + kstep;
            if (last && has_next) S.a_ready(nxt);
            if constexpr (SP2) {
            PG8_LDB(B0, 0, 0); PG8_LDB(B1, 0, 1); PG8_SCHED; PG8_LDA(At, 0, 0); PG8_STAGE(PG8_SA(1, 1), a1 + hstep, voffA);
            PG8_WAIT_V(8); PG8_WAIT_L(0); PG8_BAR; PG8_MMA(0, 0, At, B0); PG8_MMA(0, 1, At, B1); PG8_BAR; PG8_SCHED;
            PG8_LDA(At, 0, 1); PG8_STAGE(PG8_SB(0, 0), b2, voffB); PG8_STAGE(PG8_SB(0, 1), b2 + hstep, voffB); PG8_STAGE(PG8_SA(0, 0), a2, voffA);
            PG8_WAIT_V(8); PG8_WAIT_L(0); PG8_BAR; PG8_MMA(1, 0, At, B0); PG8_MMA(1, 1, At, B1); PG8_BAR; PG8_SCHED;
            PG8_LDB(B0, 1, 0); PG8_LDB(B1, 1, 1); PG8_SCHED; PG8_LDA(At, 1, 0); PG8_STAGE(PG8_SA(0, 1), a2 + hstep, voffA);
            PG8_WAIT_V(8); PG8_WAIT_L(0); PG8_BAR; PG8_MMA(0, 0, At, B0); PG8_MMA(0, 1, At, B1); PG8_BAR; PG8_SCHED;
            PG8_LDA(At, 1, 1); PG8_STAGE(PG8_SB(1, 0), b3, voffB); PG8_STAGE(PG8_SB(1, 1), b3 + hstep, voffB); PG8_STAGE(PG8_SA(1, 0), a3, voffA);
            PG8_WAIT_V(8); PG8_WAIT_L(0); PG8_BAR; PG8_MMA(1, 0, At, B0); PG8_MMA(1, 1, At, B1); PG8_BAR; PG8_SCHED;
            } else {
            PG8_LDB(B0, 0, 0); PG8_SCHED; PG8_LDA(At, 0, 0); PG8_STAGE(PG8_SA(1, 1), a1 + hstep, voffA);
            PG8_WAIT_L(8); PG8_BAR; PG8_WAIT_L(0); PG8_MMA(0, 0, At, B0); PG8_BAR; PG8_SCHED;
            PG8_LDB(B1, 0, 1); PG8_STAGE(PG8_SB(0, 0), b2, voffB);
            PG8_BAR; PG8_WAIT_L(0); PG8_MMA(0, 1, At, B1); PG8_BAR;
            PG8_LDA(At, 0, 1); PG8_STAGE(PG8_SA(0, 0), a2, voffA);
            PG8_BAR; PG8_WAIT_L(0); PG8_MMA(1, 0, At, B0); PG8_BAR; PG8_SCHED;
            PG8_STAGE(PG8_SB(0, 1), b2 + hstep, voffB);
            PG8_WAIT_V(6); PG8_BAR; PG8_MMA(1, 1, At, B1); PG8_BAR;
            PG8_LDB(B0, 1, 0); PG8_SCHED; PG8_LDA(At, 1, 0); PG8_STAGE(PG8_SA(0, 1), a2 + hstep, voffA);
            PG8_WAIT_L(8); PG8_BAR; PG8_WAIT_L(0); PG8_MMA(0, 0, At, B0); PG8_BAR; PG8_SCHED;
            PG8_LDB(B1, 1, 1); PG8_STAGE(PG8_SB(1, 0), b3, voffB);
            PG8_BAR; PG8_WAIT_L(0); PG8_MMA(0, 1, At, B1); PG8_BAR;
            PG8_LDA(At, 1, 1); PG8_STAGE(PG8_SA(1, 0), a3, voffA);
            PG8_BAR; PG8_WAIT_L(0); PG8_MMA(1, 0, At, B0); PG8_BAR; PG8_SCHED;
            PG8_STAGE(PG8_SB(1, 1), b3 + hstep, voffB);
            PG8_WAIT_V(6); PG8_BAR; PG8_MMA(1, 1, At, B1); PG8_BAR;
            }
        }
        if constexpr (ALIGN_EPI) { if (wr == 0) PG8_BAR; }
        if constexpr (!Epi::AFTER_DRAIN) { E(acc, cur, wr, wc, fr, fq); S.done(cur); }
        if (!has_next) break;
#pragma unroll
        for (int a = 0; a < 2; ++a)
#pragma unroll
            for (int b = 0; b < 2; ++b)
#pragma unroll
                for (int m = 0; m < 4; ++m)
#pragma unroll
                    for (int n = 0; n < 2; ++n) acc[a][b][m][n] = (f32x4){0.f, 0.f, 0.f, 0.f};
        cur = nxt; cA = nA; cB = nB; ++ui;
        if constexpr (ALIGN_EPI) { if (wr == 1) PG8_BAR; }
    }
    PG8_WAIT_V(0);
    if constexpr (!ALIGN_EPI) { if (wr == 0) PG8_BAR; }
    PG8_BAR;
    if constexpr (Epi::AFTER_DRAIN) { E.fused(acc, cur, wr, wc, fr, fq, lds, wid, lane); S.done(cur); }
#undef PG8_SA
#undef PG8_SB
#undef PG8_STAGE
#undef PG8_LDA
#undef PG8_LDB
#undef PG8_MMA
#undef PG8_WAIT_V
#undef PG8_WAIT_L
#undef PG8_BAR
#undef PG8_SCHED
}
}

#ifndef PG8_SP2
#define PG8_SP2 true
#endif
#ifndef PG8_ALIGN
#define PG8_ALIGN true
#endif

struct Frame {
    LAS unsigned char* lds;
    int tid, lane, wave, vcu, G;
    const float *x_prompt, *x_sample, *cvec, *state_hgrn, *state_rglru, *c_ctx, *w_ada, *b_ada, *norm1_gain, *norm2_gain, *w_in, *lb_logits, *hg_norm_gain,
                *conv_w, *conv_b, *lru_wa, *lru_ba, *lru_wx, *lru_bx, *lru_lambda, *w_out, *w_ff1, *w_ff2, *final_gain;
    float* out;
    bf16 *Win_t, *Wout_t, *Wff1_t, *Wff2_t, *WL;
    float* MOD; float* XS; float* DEC; float* LC;
    bf16 *ACT, *QF, *V, *GL, *LX, *QE, *KE, *KDT, *VT, *OF, *OB, *HF, *HB, *HID, *PC, *XF;
    unsigned* GATES;
};
constexpr size_t OUT_SHG = (size_t)NTOK * 1024, OUT_SLRU = OUT_SHG + (size_t)32 * 2 * 4 * 128 * 128;

DI void p0_transpose_item(const float* W, int K, int N, bf16* WT, LAS float* scr, int item, int lane) {
    const int nblk = N / 32, kb = item / nblk, nb = item % nblk, k0 = 64 * kb, n0 = 32 * nb;
#pragma unroll 8
    for (int i = 0; i < 32; ++i) { const int kk = 2 * i + (lane >> 5); scr[kk * 33 + (lane & 31)] = W[(size_t)(k0 + kk) * N + n0 + (lane & 31)]; }
    LDS_WAIT(); asm volatile("" ::: "memory");
    const int c = lane & 7;
#pragma unroll
    for (int j = 0; j < 4; ++j) { const int n = (lane >> 3) + 8 * j; const LAS float* s = scr + (8 * c) * 33 + n;
        v4u o; o.x = pk2(s[0 * 33], s[1 * 33]); o.y = pk2(s[2 * 33], s[3 * 33]); o.z = pk2(s[4 * 33], s[5 * 33]); o.w = pk2(s[6 * 33], s[7 * 33]);
        *(GAS v4u*)(WT + (size_t)(n0 + n) * K + k0 + 8 * c) = o; }
    LDS_WAIT(); asm volatile("" ::: "memory");
}
DI void p0_prologue(Frame& F) {
    LAS float* ct = (LAS float*)(F.lds + CT_OFF);
    for (int i = F.tid; i < 5 * 1024; i += NWAVES * 64) { const int j = i >> 10, k = i & 1023; const float c = (j == 0) ? F.c_ctx[k] : F.cvec[(j - 1) * 1024 + k]; ct[i] = silu_f(c); }
    __syncthreads();
    LAS float* scr = (LAS float*)(F.lds + RING_OFF + F.wave * 16384);
    const int gw = F.wave * F.G + F.vcu, NGW = F.G * NWAVES;
    constexpr int I_GEMV = 6144 / 16, I_WL = 32, I_IN = (D / 64) * (INC / 32), I_OUT = (D / 64) * (D / 32), I_F1 = (D / 64) * (DFF / 32), I_F2 = (DFF / 64) * (D / 32);
    constexpr int NITEMS = I_GEMV + I_WL + I_IN + I_OUT + I_F1 + I_F2;
    for (int it = gw; it < NITEMS; it += NGW) {
        int r = it;
        if (r < I_GEMV) {
            const int n0 = 16 * r, col = F.lane & 15, kq = F.lane >> 4;
            const float* wp = F.w_ada + n0 + col;
            float acc[5] = {0.f, 0.f, 0.f, 0.f, 0.f};
            for (int k = kq; k < 1024; k += 32) {
                float w[8];
#pragma unroll
                for (int u = 0; u < 8; ++u) w[u] = wp[(size_t)(k + 4 * u) * 6144];
#pragma unroll
                for (int u = 0; u < 8; ++u)
#pragma unroll
                    for (int j = 0; j < 5; ++j) acc[j] += ct[j * 1024 + k + 4 * u] * w[u];
            }
#pragma unroll
            for (int j = 0; j < 5; ++j) { acc[j] += __shfl_xor(acc[j], 16); acc[j] += __shfl_xor(acc[j], 32); }
            if (kq == 0) { const float b = F.b_ada[n0 + col];
#pragma unroll
                for (int j = 0; j < 5; ++j) F.MOD[j * 6144 + n0 + col] = acc[j] + b; }
            continue;
        }
        r -= I_GEMV;
        if (r < I_WL) {
            const int mat = r >> 4; const float* src = (mat ? F.lru_wx : F.lru_wa) + (size_t)(r & 15) * 4096; bf16* dst = F.WL + (size_t)r * 4096;
            for (int e = F.lane; e < 4096; e += 64) { const int o = e >> 6, i = e & 63; dst[o * 64 + i] = (bf16)(pk2(src[i * 64 + o], 0.f) & 0xffffu); }
            continue;
        }
        r -= I_WL;
        if (r < I_IN) { p0_transpose_item(F.w_in, D, INC, F.Win_t, scr, r, F.lane); continue; } r -= I_IN;
        if (r < I_OUT) { p0_transpose_item(F.w_out, D, D, F.Wout_t, scr, r, F.lane); continue; } r -= I_OUT;
        if (r < I_F1) { p0_transpose_item(F.w_ff1, D, DFF, F.Wff1_t, scr, r, F.lane); continue; } r -= I_F1;
        p0_transpose_item(F.w_ff2, DFF, D, F.Wff2_t, scr, r, F.lane);
    }
}

DI int cond_of_row(int m) { return m < NCTX ? 0 : 1 + ((m - NCTX) >> 10); }
DI void store_row_bf16(bf16* orow, int lane, const f32x4 (&v)[4]) {
    GAS v2u* o8 = (GAS v2u*)orow + lane;
#pragma unroll
    for (int j = 0; j < 4; ++j) { v2u w; w.x = pk2(v[j].x, v[j].y); w.y = pk2(v[j].z, v[j].w); o8[64 * j] = w; }
}
DI void p1_rows(Frame& F) {
    const int gw = F.vcu * NWAVES + F.wave, NGW = F.G * NWAVES;
    for (int m = gw; m < NTOK; m += NGW) {
        const float* xrow = m < NCTX ? F.x_prompt + (size_t)m * D : F.x_sample + (size_t)(m - NCTX) * D;
        const GAS f32x4* xr = (const GAS f32x4*)xrow + F.lane;
        f32x4 v[4];
#pragma unroll
        for (int j = 0; j < 4; ++j) v[j] = xr[64 * j];
        if (m >= NCTX) {
            const int t = (m - NCTX) & 1023; const float rr = (float)(t >> 6), cc = (float)(t & 63);
#pragma unroll
            for (int e = 0; e < 4; ++e) {
                const float om = exp2f(-(float)(4 * F.lane + e) * (13.287712379549449f / 256.0f));
                const float ar = rr * om * 0.15915494309189535f, ac = cc * om * 0.15915494309189535f;
                v[0][e] += __builtin_amdgcn_sinf(ar); v[1][e] += __builtin_amdgcn_cosf(ar); v[2][e] += __builtin_amdgcn_sinf(ac); v[3][e] += __builtin_amdgcn_cosf(ac);
            }
            GAS f32x4* xo = (GAS f32x4*)(F.XS + (size_t)(m - NCTX) * D) + F.lane;
#pragma unroll
            for (int j = 0; j < 4; ++j) xo[64 * j] = v[j];
        }
        float s = 0.f;
#pragma unroll
        for (int j = 0; j < 4; ++j) s += (v[j].x * v[j].x + v[j].y * v[j].y) + (v[j].z * v[j].z + v[j].w * v[j].w);
        const float rstd = 1.0f / sqrtf(wave_sum(s) * (1.f / D) + EPS);
        const float* mod = F.MOD + cond_of_row(m) * 6144;
#pragma unroll
        for (int j = 0; j < 4; ++j) {
            const int c = 256 * j + 4 * F.lane;
            const f32x4 g = *(const f32x4*)(F.norm1_gain + c), sh = *(const f32x4*)(mod + c), sc = *(const f32x4*)(mod + 1024 + c);
            v[j] = v[j] * rstd * g * (1.0f + sc) + sh;
        }
        store_row_bf16(F.ACT + (size_t)m * D, F.lane, v);
    }
}
DI void p7_rows(Frame& F) {
    const int gw = F.vcu * NWAVES + F.wave, NGW = F.G * NWAVES;
    for (int m = gw; m < NTOK; m += NGW) {
        const GAS f32x4* xr = (const GAS f32x4*)(F.out + (size_t)m * D) + F.lane;
        f32x4 v[4]; float s = 0.f;
#pragma unroll
        for (int j = 0; j < 4; ++j) { v[j] = xr[64 * j]; s += (v[j].x * v[j].x + v[j].y * v[j].y) + (v[j].z * v[j].z + v[j].w * v[j].w); }
        const float rstd = 1.0f / sqrtf(wave_sum(s) * (1.f / D) + EPS);
        const float* mod = F.MOD + cond_of_row(m) * 6144;
#pragma unroll
        for (int j = 0; j < 4; ++j) {
            const int c = 256 * j + 4 * F.lane;
            const f32x4 g = *(const f32x4*)(F.norm2_gain + c), sh = *(const f32x4*)(mod + 3072 + c), sc = *(const f32x4*)(mod + 4096 + c);
            v[j] = v[j] * rstd * g * (1.0f + sc) + sh;
        }
        store_row_bf16(F.ACT + (size_t)m * D, F.lane, v);
    }
}
DI void p10_rows(Frame& F) {
    const int gw = F.vcu * NWAVES + F.wave, NGW = F.G * NWAVES;
    for (int m = gw; m < NTOK; m += NGW) {
        GAS f32x4* xr = (GAS f32x4*)(F.out + (size_t)m * D) + F.lane;
        f32x4 v[4]; float s = 0.f;
#pragma unroll
        for (int j = 0; j < 4; ++j) { v[j] = xr[64 * j]; s += (v[j].x * v[j].x + v[j].y * v[j].y) + (v[j].z * v[j].z + v[j].w * v[j].w); }
        const float rstd = 1.0f / sqrtf(wave_sum(s) * (1.f / D) + EPS);
#pragma unroll
        for (int j = 0; j < 4; ++j) { const f32x4 g = *(const f32x4*)(F.final_gain + 256 * j + 4 * F.lane); xr[64 * j] = v[j] * rstd * g; }
    }
}
DI void p5_rows(Frame& F) {
    const int gw = F.vcu * NWAVES + F.wave, NGW = F.G * NWAVES;
    const int c8 = 8 * F.lane;
    for (int m = gw; m < NTOK; m += NGW) {
        const v4u a = *(const GAS v4u*)(F.OF + (size_t)m * 512 + c8), b = *(const GAS v4u*)(F.OB + (size_t)m * 512 + c8);
        const v4u gt = *(const GAS v4u*)(F.GL + (size_t)m * 1024 + c8), lg = *(const GAS v4u*)(F.GL + (size_t)m * 1024 + 512 + c8);
        const v4u hf = *(const GAS v4u*)(F.HF + (size_t)m * 512 + c8), hb = *(const GAS v4u*)(F.HB + (size_t)m * 512 + c8);
        float o[8], s = 0.f;
#pragma unroll
        for (int j = 0; j < 4; ++j) { o[2 * j] = bflo(a[j]) + bflo(b[j]); o[2 * j + 1] = bfhi(a[j]) + bfhi(b[j]); s += o[2 * j] * o[2 * j] + o[2 * j + 1] * o[2 * j + 1]; }
        float hsum[8];
#pragma unroll
        for (int j = 0; j < 4; ++j) { hsum[2 * j] = bflo(hf[j]) + bflo(hb[j]); hsum[2 * j + 1] = bfhi(hf[j]) + bfhi(hb[j]); }
        if (m >= NCTX) {
            const int ml = m - NCTX, bb = ml >> 10, seg = (ml >> 8) & 3;
#pragma unroll
            for (int d = 0; d < 2; ++d) {
                const int jn = d ? 3 - seg : seg;
                if (jn > 0) {
                    const float* lc = F.LC + ((size_t)((bb * 2 + d) * 4) * 512 + c8) * 2;
                    float hin[8];
                    { const f32x4 q0 = *(const f32x4*)(lc), q1 = *(const f32x4*)(lc + 4), q2 = *(const f32x4*)(lc + 8), q3 = *(const f32x4*)(lc + 12);
                      hin[0] = q0[1]; hin[1] = q0[3]; hin[2] = q1[1]; hin[3] = q1[3]; hin[4] = q2[1]; hin[5] = q2[3]; hin[6] = q3[1]; hin[7] = q3[3]; }
                    for (int jj = 1; jj < jn; ++jj) {
                        const float* l2 = lc + (size_t)jj * 1024;
                        const f32x4 q0 = *(const f32x4*)(l2), q1 = *(const f32x4*)(l2 + 4), q2 = *(const f32x4*)(l2 + 8), q3 = *(const f32x4*)(l2 + 12);
                        hin[0] = q0[0] * hin[0] + q0[1]; hin[1] = q0[2] * hin[1] + q0[3]; hin[2] = q1[0] * hin[2] + q1[1]; hin[3] = q1[2] * hin[3] + q1[3];
                        hin[4] = q2[0] * hin[4] + q2[1]; hin[5] = q2[2] * hin[5] + q2[3]; hin[6] = q3[0] * hin[6] + q3[1]; hin[7] = q3[2] * hin[7] + q3[3];
                    }
                    const v4u pc = *(const GAS v4u*)(F.PC + ((size_t)ml * 2 + d) * 512 + c8);
#pragma unroll
                    for (int e = 0; e < 4; ++e) { hsum[2 * e] += bflo(pc[e]) * hin[2 * e]; hsum[2 * e + 1] += bfhi(pc[e]) * hin[2 * e + 1]; }
                }
            }
        }
        s += __shfl_xor(s, 1); s += __shfl_xor(s, 2); s += __shfl_xor(s, 4); s += __shfl_xor(s, 8);
        const float rstd = 1.0f / sqrtf(s * (1.f / 128.f) + EPS);
        const f32x4 g0 = *(const f32x4*)(F.hg_norm_gain + c8), g1 = *(const f32x4*)(F.hg_norm_gain + c8 + 4);
        v4u w1, w2;
#pragma unroll
        for (int j = 0; j < 4; ++j) {
            const float ga = (j < 2) ? g0[2 * j] : g1[2 * j - 4], gb = (j < 2) ? g0[2 * j + 1] : g1[2 * j - 3];
            w1[j] = pk2(o[2 * j] * rstd * ga * silu_f(bflo(gt[j])), o[2 * j + 1] * rstd * gb * silu_f(bfhi(gt[j])));
            w2[j] = pk2(hsum[2 * j] * gelu_tanh_f(bflo(lg[j])), hsum[2 * j + 1] * gelu_tanh_f(bfhi(lg[j])));
        }
        *(GAS v4u*)(F.ACT + (size_t)m * D + c8) = w1;
        *(GAS v4u*)(F.ACT + (size_t)m * D + 512 + c8) = w2;
    }
}

#define MFMA32(a, b, c) __builtin_amdgcn_mfma_f32_32x32x16_bf16((a), (b), (c), 0, 0, 0)
DI bf16x8 pack8(const f32x16& x, int s) {
    const v4u w = {pk2(x[8 * s], x[8 * s + 1]), pk2(x[8 * s + 2], x[8 * s + 3]), pk2(x[8 * s + 4], x[8 * s + 5]), pk2(x[8 * s + 6], x[8 * s + 7])};
    return __builtin_bit_cast(bf16x8, w);
}
DI bf16x8 ldfrag(const bf16* p) { return __builtin_bit_cast(bf16x8, *(const GAS v4u*)p); }
template <int DIR>
DI void hg_prep_item(Frame& F, int cg, int head) {
    const int m0 = cg * 32, k0 = 2 * F.lane, hk = head * 128 + k0, col = DIR * 512 + hk;
    const f32x2 L0 = *(const f32x2*)(F.lb_logits + DIR * 512 + hk), L1 = *(const f32x2*)(F.lb_logits + 1024 + DIR * 512 + hk);
    const float lba = __builtin_amdgcn_rcpf(1.0f + __expf(L1.x - L0.x)), lbb = __builtin_amdgcn_rcpf(1.0f + __expf(L1.y - L0.y));
    float lf0[32], lf1[32], kk0[32], kk1[32]; unsigned qw[32];
    float bl0 = 0.f, bl1 = 0.f;
#pragma unroll
    for (int i = 0; i < 32; ++i) {
        const int t = DIR ? 31 - i : i; const size_t ro = (size_t)(m0 + t) * 2048 + col;
        const unsigned fw = *(const GAS unsigned*)(F.QF + ro + 1024); qw[i] = *(const GAS unsigned*)(F.QF + ro);
        const float f0 = lba + (1.0f - lba) * sigm(bflo(fw)), f1 = lbb + (1.0f - lbb) * sigm(bfhi(fw));
        lf0[i] = __logf(f0); lf1[i] = __logf(f1); kk0[i] = 1.0f - f0; kk1[i] = 1.0f - f1;
        bl0 += lf0[i]; bl1 += lf1[i];
    }
    const size_t cb = ((size_t)DIR * NCH + cg) * 4 + head;
    const int kk = k0 & 15, fh = (kk >> 2) & 1, fj = (kk & 3) + 4 * (kk >> 3);
    const size_t qo = cb * 4096 + (size_t)((k0 >> 4) * 64 + 32 * fh) * 8 + fj;
    float b0 = 0.f, b1 = 0.f; unsigned kd0[16], kd1[16];
#pragma unroll
    for (int ip = 0; ip < 16; ++ip) {
        float d0[2], d1[2];
#pragma unroll
        for (int s = 0; s < 2; ++s) {
            const int i = 2 * ip + s, t = DIR ? 31 - i : i;
            b0 += lf0[i]; b1 += lf1[i];
            const float q0 = silu_f(bflo(qw[i])), q1 = silu_f(bfhi(qw[i]));
            *(GAS unsigned*)(F.QE + qo + t * 8) = pk2(q0 * __expf(b0), q1 * __expf(b1));
            *(GAS unsigned*)(F.KE + qo + t * 8) = pk2(kk0[i] * __expf(-b0), kk1[i] * __expf(-b1));
            d0[s] = kk0[i] * __expf(bl0 - b0); d1[s] = kk1[i] * __expf(bl1 - b1);
        }
        const int p = DIR ? 15 - ip : ip;
        kd0[p] = DIR ? pk2(d0[1], d0[0]) : pk2(d0[0], d0[1]);
        kd1[p] = DIR ? pk2(d1[1], d1[0]) : pk2(d1[0], d1[1]);
    }
    {
        const int ti = k0 >> 5, r = k0 & 31;
        bf16* kb = F.KDT + cb * 4096 + (size_t)(ti * 2) * 512 + (size_t)r * 8;
#pragma unroll
        for (int sp = 0; sp < 2; ++sp)
#pragma unroll
            for (int h = 0; h < 2; ++h) {
                const v4u a = {kd0[8 * sp + 2 * h], kd0[8 * sp + 2 * h + 1], kd0[8 * sp + 4 + 2 * h], kd0[8 * sp + 4 + 2 * h + 1]};
                const v4u b = {kd1[8 * sp + 2 * h], kd1[8 * sp + 2 * h + 1], kd1[8 * sp + 4 + 2 * h], kd1[8 * sp + 4 + 2 * h + 1]};
                *(GAS v4u*)(kb + sp * 512 + h * 256) = a; *(GAS v4u*)(kb + sp * 512 + h * 256 + 8) = b;
            }
        const int dh = (r >> 2) & 1, rg = (r & 3) + 4 * (r >> 3);
        *(f32x2*)(F.DEC + cb * 128 + ti * 32 + dh * 16 + rg) = (f32x2){__expf(bl0), __expf(bl1)};
    }
    asm volatile("s_waitcnt vmcnt(0)" ::: "memory");
    {
        const int r = F.lane & 31, h = F.lane >> 5; const unsigned lo8 = (unsigned)F.lane * 8u;
        f32x16 X;
#pragma unroll
        for (int i = 0; i < 16; ++i) X[i] = 0.f;
#pragma unroll
        for (int ks = 0; ks < 8; ++ks) X = MFMA32(ldfrag(F.KE + cb * 4096 + ks * 512 + lo8), ldfrag(F.QE + cb * 4096 + ks * 512 + lo8), X);
#pragma unroll
        for (int rg = 0; rg < 16; ++rg) { const int s = (rg & 3) + 8 * (rg >> 2) + 4 * h; const bool keep = DIR ? (s >= r) : (s <= r); X[rg] = keep ? X[rg] : 0.f; }
        *(GAS v4u*)(F.XF + cb * 1024 + lo8) = __builtin_bit_cast(v4u, pack8(X, 0));
        *(GAS v4u*)(F.XF + cb * 1024 + 512 + lo8) = __builtin_bit_cast(v4u, pack8(X, 1));
    }
}
DI void vt_item(Frame& F, int cg, int head) {
    const int m0 = cg * 32, v0 = 2 * F.lane, hv = head * 128 + v0;
    unsigned w[32];
#pragma unroll
    for (int t = 0; t < 32; ++t) w[t] = *(const GAS unsigned*)(F.V + (size_t)(m0 + t) * 512 + hv);
    unsigned rl[16], rh[16];
#pragma unroll
    for (int p = 0; p < 16; ++p) { const unsigned x = w[2 * p], y = w[2 * p + 1]; rl[p] = (x & 0xffffu) | (y << 16); rh[p] = (x >> 16) | (y & 0xffff0000u); }
    bf16* vb = F.VT + ((size_t)(cg * 4 + head) * 4 + (v0 >> 5)) * 1024 + (size_t)(v0 & 31) * 8;
#pragma unroll
    for (int sp = 0; sp < 2; ++sp)
#pragma unroll
        for (int h = 0; h < 2; ++h) {
            const v4u a = {rl[8 * sp + 2 * h], rl[8 * sp + 2 * h + 1], rl[8 * sp + 4 + 2 * h], rl[8 * sp + 4 + 2 * h + 1]};
            const v4u b = {rh[8 * sp + 2 * h], rh[8 * sp + 2 * h + 1], rh[8 * sp + 4 + 2 * h], rh[8 * sp + 4 + 2 * h + 1]};
            *(GAS v4u*)(vb + sp * 512 + h * 256) = a; *(GAS v4u*)(vb + sp * 512 + h * 256 + 8) = b;
        }
}
DI void lru_gate_item(Frame& F, int tg, int n) {
    const int m0 = 64 * tg, r = F.lane & 31, h = F.lane >> 5;
    const int T = m0 < NCTX ? TCTX : TLAT, tseq0 = m0 < NCTX ? (m0 & (TCTX - 1)) : ((m0 - NCTX) & (TLAT - 1));
    bf16x8 xa[2][4];
#pragma unroll
    for (int ks = 0; ks < 4; ++ks) {
        const int c0 = 64 * n + 16 * ks + 8 * h;
        f32x4 w[4][2];
#pragma unroll
        for (int j = 0; j < 4; ++j) { w[j][0] = *(const f32x4*)(F.conv_w + j * 512 + c0); w[j][1] = *(const f32x4*)(F.conv_w + j * 512 + c0 + 4); }
        const f32x4 cb0 = *(const f32x4*)(F.conv_b + c0), cb1 = *(const f32x4*)(F.conv_b + c0 + 4);
#pragma unroll
        for (int mt = 0; mt < 2; ++mt) {
            const int tk = 32 * mt + r, m = m0 + tk, ts = tseq0 + tk;
            f32x4 a0 = cb0, a1 = cb1;
#pragma unroll
            for (int j = 0; j < 4; ++j) {
                const int tt = ts + j - 2; const bool ok = (tt >= 0) && (tt < T);
                const v4u lw = *(const GAS v4u*)(F.LX + (size_t)(ok ? m + j - 2 : m) * 512 + c0);
                const float z = ok ? 1.0f : 0.0f;
                a0 += (f32x4){bflo(lw.x), bfhi(lw.x), bflo(lw.y), bfhi(lw.y)} * (w[j][0] * z);
                a1 += (f32x4){bflo(lw.z), bfhi(lw.z), bflo(lw.w), bfhi(lw.w)} * (w[j][1] * z);
            }
            const v4u p = {pk2(a0.x, a0.y), pk2(a0.z, a0.w), pk2(a1.x, a1.y), pk2(a1.z, a1.w)};
            xa[mt][ks] = __builtin_bit_cast(bf16x8, p);
        }
    }
    f32x16 zero;
#pragma unroll
    for (int i = 0; i < 16; ++i) zero[i] = 0.f;
#pragma unroll
    for (int nt = 0; nt < 2; ++nt) {
        f32x16 xcC[2] = {zero, zero};
#pragma unroll
        for (int s = 0; s < 2; ++s) {
            bf16x8 bI;
#pragma unroll
            for (int j = 0; j < 8; ++j) bI[j] = (16 * s + 8 * h + j == r) ? (short)0x3F80 : (short)0;
#pragma unroll
            for (int mt = 0; mt < 2; ++mt) xcC[mt] = MFMA32(xa[mt][2 * nt + s], bI, xcC[mt]);
        }
        const int c = 64 * n + 32 * nt + r;
#pragma unroll
        for (int d = 0; d < 2; ++d) {
            f32x16 accA[2] = {zero, zero}, accX[2] = {zero, zero};
            const bf16* wa = F.WL + ((size_t)((0 * 2 + d) * 8 + n) * 64 + 32 * nt + r) * 64 + 8 * h;
            const bf16* wx = F.WL + ((size_t)((1 * 2 + d) * 8 + n) * 64 + 32 * nt + r) * 64 + 8 * h;
#pragma unroll
            for (int ks = 0; ks < 4; ++ks) {
                const bf16x8 ba_ = *(const GAS bf16x8*)(wa + 16 * ks), bx_ = *(const GAS bf16x8*)(wx + 16 * ks);
#pragma unroll
                for (int mt = 0; mt < 2; ++mt) { accA[mt] = MFMA32(xa[mt][ks], ba_, accA[mt]); accX[mt] = MFMA32(xa[mt][ks], bx_, accX[mt]); }
            }
            const float bias_a = F.lru_ba[d * 512 + c], bias_x = F.lru_bx[d * 512 + c];
            const float e = __expf(-F.lru_lambda[d * 512 + c]);
            const float sp8 = -8.0f * e * (1.0f - e * (0.5f - e * (0.33333333f - 0.25f * e)));
#pragma unroll
            for (int mt = 0; mt < 2; ++mt)
#pragma unroll
                for (int rg = 0; rg < 16; ++rg) {
                    const int tok = m0 + 32 * mt + (rg & 3) + 8 * (rg >> 2) + 4 * h;
                    const float rr = sigm(accA[mt][rg] + bias_a), ii = sigm(accX[mt][rg] + bias_x);
                    const float la = sp8 * rr, y = 2.0f * la;
                    const float em = -y * (1.0f + y * (0.5f + y * (0.16666667f + y * (0.041666668f + y * 0.0083333333f))));
                    const float u = __builtin_sqrtf(em) * ii * xcC[mt][rg];
                    const _Float16 lh = (_Float16)la;
                    F.GATES[((size_t)tok * 2 + d) * 512 + c] = (unsigned)__builtin_bit_cast(unsigned short, lh) | (pk2(0.f, u) & 0xffff0000u);
                }
        }
    }
}
DI void p3_prep(Frame& F) {
    const int gw = F.wave * F.G + F.vcu, NGW = F.G * NWAVES;
    constexpr int I_G = (NTOK / 64) * 8, I_HG = NCH * 8, I_VT = NCH * 4;
    for (int it = gw; it < I_G + I_HG + I_VT; it += NGW) {
        int r = it;
        if (r < I_G) { lru_gate_item(F, r >> 3, r & 7); continue; } r -= I_G;
        if (r < I_HG) { const int head = r & 3, dir = (r >> 2) & 1, cg = r >> 3; if (dir) hg_prep_item<1>(F, cg, head); else hg_prep_item<0>(F, cg, head); continue; } r -= I_HG;
        vt_item(F, r >> 2, r & 3);
    }
}

constexpr int HG_GB = 27136, HG_QE = 0, HG_KD = 8192, HG_XF = 16384, HG_VT = 18432, HG_DEC = 26624;
static_assert(4 * HG_GB <= RING_BYTES, "hg scan LDS");
DI void hg_scan_wg(Frame& F, int sqA, int dA, int headA, int sqB, int dB, int headB, int mode = 0) {
    const int half = F.wave >> 2, vs = F.wave & 3, r = F.lane & 31, h = F.lane >> 5;
    const int sq = half ? sqB : sqA, d = half ? dB : dA, head = half ? headB : headA;
    const bool latA = sqA >= 32;
    const int nch = (mode == 5) ? 8 : (latA ? TLAT : TCTX) / 32;
#define HG_BAR() do { asm volatile("s_waitcnt lgkmcnt(0)" ::: "memory"); __builtin_amdgcn_s_barrier(); asm volatile("" ::: "memory"); } while (0)
    if (sq < 0) { for (int n = 0; n <= nch; ++n) HG_BAR(); return; }
    const bool lat = sq >= 32;
    const int base = lat ? NCTX + (sq - 32) * TLAT : sq * TCTX;
    f32x16 S[4];
    if (lat) {
        const float* s0 = F.state_hgrn + ((size_t)((sq - 32) * 2 + d) * 4 + head) * 128 * 128 + 32 * vs;
        const unsigned so = (unsigned)(4 * h * 128 + r);
#pragma unroll
        for (int i = 0; i < 4; ++i)
#pragma unroll
            for (int rg = 0; rg < 16; ++rg) S[i][rg] = s0[so + (unsigned)((32 * i + (rg & 3) + 8 * (rg >> 2)) * 128)];
    } else {
#pragma unroll
        for (int i = 0; i < 4; ++i)
#pragma unroll
            for (int rg = 0; rg < 16; ++rg) S[i][rg] = 0.f;
    }
#pragma unroll
    for (int i = 0; i < 4; ++i)
#pragma unroll
        for (int rg = 0; rg < 16; ++rg) asm volatile("" : "+v"(S[i][rg]));
    const unsigned lo8 = (unsigned)F.lane * 8u, ooff = (unsigned)(r * 512 + 32 * vs + 4 * h);
    LAS unsigned char* gl = F.lds + RING_OFF + half * (2 * HG_GB);
    const unsigned l16 = (unsigned)F.lane * 16u;
    bf16* OUTd = (d ? F.OB : F.OF) + head * 128;
    const int c0 = d ? nch - 1 : 0, cstep = d ? -1 : 1;
    const size_t cb = ((size_t)d * NCH + (base >> 5) + c0) * 4 + head;
    const size_t vb = ((size_t)((base >> 5) + c0) * 4 + head) * 4 + vs;
    struct StageRegs { v4u q0, q1, k0, k1, x, v0, v1; f32x2 dd; };
    StageRegs R0, R1;
#define HG_LOAD(R, n) do { const size_t cbx = (size_t)((long)cb + 4 * cstep * (n)), vbx = (size_t)((long)vb + 16 * cstep * (n)); \
        R.q0 = *(const GAS v4u*)(F.QE + cbx * 4096 + (2 * vs) * 512 + lo8); R.q1 = *(const GAS v4u*)(F.QE + cbx * 4096 + (2 * vs + 1) * 512 + lo8); \
        R.k0 = *(const GAS v4u*)(F.KDT + cbx * 4096 + (2 * vs) * 512 + lo8); R.k1 = *(const GAS v4u*)(F.KDT + cbx * 4096 + (2 * vs + 1) * 512 + lo8); \
        R.x = *(const GAS v4u*)(F.XF + cbx * 1024 + (vs & 1) * 512 + lo8); \
        R.v0 = *(const GAS v4u*)(F.VT + vbx * 1024 + lo8); R.v1 = *(const GAS v4u*)(F.VT + vbx * 1024 + 512 + lo8); \
        R.dd = *(const GAS f32x2*)(F.DEC + cbx * 128 + 2 * F.lane); } while (0)
#define HG_STAGE(R, bufp) do { \
        *(LAS v4u*)((bufp) + HG_QE + (2 * vs) * 1024 + l16) = R.q0; *(LAS v4u*)((bufp) + HG_QE + (2 * vs + 1) * 1024 + l16) = R.q1; \
        *(LAS v4u*)((bufp) + HG_KD + (2 * vs) * 1024 + l16) = R.k0; *(LAS v4u*)((bufp) + HG_KD + (2 * vs + 1) * 1024 + l16) = R.k1; \
        if (vs < 2) *(LAS v4u*)((bufp) + HG_XF + vs * 1024 + l16) = R.x; \
        *(LAS v4u*)((bufp) + HG_VT + (2 * vs) * 1024 + l16) = R.v0; *(LAS v4u*)((bufp) + HG_VT + (2 * vs + 1) * 1024 + l16) = R.v1; \
        if (vs == 3) *(LAS f32x2*)((bufp) + HG_DEC + 8 * F.lane) = R.dd; } while (0)
#define HG_COMPUTE(cur, n) do { \
            const int m0 = base + 32 * (c0 + cstep * (n)); \
            const bf16x8 xf0 = *(const LAS bf16x8*)((cur) + HG_XF + l16), xf1 = *(const LAS bf16x8*)((cur) + HG_XF + 1024 + l16); \
            const bf16x8 vf0 = *(const LAS bf16x8*)((cur) + HG_VT + (2 * vs) * 1024 + l16), vf1 = *(const LAS bf16x8*)((cur) + HG_VT + (2 * vs + 1) * 1024 + l16); \
            const LAS float* dc = (const LAS float*)((cur) + HG_DEC) + h * 16; \
            bf16x8 sp[8]; \
            _Pragma("unroll") for (int i = 0; i < 4; ++i) { sp[2 * i] = pack8(S[i], 0); sp[2 * i + 1] = pack8(S[i], 1); } \
            _Pragma("unroll") for (int i = 0; i < 4; ++i) { f32x4 dv[4]; \
                _Pragma("unroll") for (int g = 0; g < 4; ++g) dv[g] = *(const LAS f32x4*)(dc + i * 32 + 4 * g); \
                _Pragma("unroll") for (int g = 0; g < 4; ++g) _Pragma("unroll") for (int j = 0; j < 4; ++j) S[i][4 * g + j] *= dv[g][j]; } \
            f32x16 O; \
            _Pragma("unroll") for (int i = 0; i < 16; ++i) O[i] = 0.f; \
            O = MFMA32(vf0, xf0, O); O = MFMA32(vf1, xf1, O); \
            _Pragma("unroll") for (int i = 0; i < 8; ++i) O = MFMA32(sp[i], *(const LAS bf16x8*)((cur) + HG_QE + i * 1024 + l16), O); \
            _Pragma("unroll") for (int i = 0; i < 4; ++i) { \
                S[i] = MFMA32(*(const LAS bf16x8*)((cur) + HG_KD + (2 * i) * 1024 + l16), vf0, S[i]); \
                S[i] = MFMA32(*(const LAS bf16x8*)((cur) + HG_KD + (2 * i + 1) * 1024 + l16), vf1, S[i]); } \
            bf16* op = OUTd + (size_t)m0 * 512; \
            _Pragma("unroll") for (int g = 0; g < 4; ++g) { const v2u w = {pk2(O[4 * g], O[4 * g + 1]), pk2(O[4 * g + 2], O[4 * g + 3])}; if (mode != 4) *(GAS v2u*)(op + ooff + 8 * g) = w; else asm volatile("" :: "v"(w)); } \
        } while (0)
    LAS unsigned char* b0 = gl; LAS unsigned char* b1 = gl + HG_GB;
    HG_LOAD(R0, 0); HG_STAGE(R0, b0); HG_LOAD(R1, 1);
    HG_BAR();
    for (int n = 0; n < nch; n += 2) {
        { const int nn = n + 2 < nch ? n + 2 : nch - 1; HG_LOAD(R0, nn); }
        HG_COMPUTE(b0, n);
        HG_STAGE(R1, b1);
        HG_BAR();
        { const int nn = n + 3 < nch ? n + 3 : nch - 1; HG_LOAD(R1, nn); }
        HG_COMPUTE(b1, n + 1);
        HG_STAGE(R0, b0);
        HG_BAR();
    }
#undef HG_LOAD
#undef HG_STAGE
#undef HG_BAR
#undef HG_COMPUTE
    if (!lat) {
        float* so = F.out + OUT_SHG + ((size_t)(sq * 2 + d) * 4 + head) * 128 * 128 + 32 * vs;
        const unsigned sof = (unsigned)(4 * h * 128 + r);
#pragma unroll
        for (int i = 0; i < 4; ++i)
#pragma unroll
            for (int rg = 0; rg < 16; ++rg) so[sof + (unsigned)((32 * i + (rg & 3) + 8 * (rg >> 2)) * 128)] = S[i][rg];
    }
}
DI void lru_scan_item(Frame& F, int ss, int d, int cgp) {
    const bool lat = ss >= 32;
    const int b = (ss - 32) >> 2, seg = (ss - 32) & 3, j = d ? 3 - seg : seg;
    const int T = 256, base = lat ? NCTX + (ss - 32) * 256 : ss * 256, c = 64 * cgp + F.lane;
    float hs = (lat && j == 0) ? F.state_rglru[(size_t)(b * 2 + d) * 512 + c] : 0.f, pp = 1.0f;
    const int t0 = d ? base + T - 1 : base, ts = d ? -1 : 1;
    const unsigned* gp = F.GATES + (size_t)d * 512; bf16* op = d ? F.HB : F.HF;
    bf16* pcp = F.PC + (size_t)d * 512 - (size_t)NCTX * 1024;
    constexpr int U = 16, NB = 4;
    unsigned g[NB][U];
#pragma unroll
    for (int bb = 0; bb < NB; ++bb)
#pragma unroll
        for (int u = 0; u < U; ++u) g[bb][u] = ((const GAS unsigned*)(gp + (size_t)(t0 + ts * (bb * U + u)) * 1024))[c];
#pragma unroll 1
    for (int i0 = 0; i0 < T; i0 += U * NB) {
#pragma unroll
        for (int bb = 0; bb < NB; ++bb) {
#pragma unroll
            for (int u = 0; u < U; ++u) {
                const int t = t0 + ts * (i0 + bb * U + u);
                const float a = __expf((float)__builtin_bit_cast(_Float16, (unsigned short)(g[bb][u] & 0xffffu)));
                hs = a * hs + bfhi(g[bb][u]);
                ((GAS bf16*)(op + (size_t)t * 512))[c] = (bf16)(pk2(hs, 0.f) & 0xffffu);
                if (lat) { pp *= a; ((GAS bf16*)(pcp + (size_t)t * 1024))[c] = (bf16)(pk2(pp, 0.f) & 0xffffu); }
            }
            if (i0 + U * NB < T) {
#pragma unroll
                for (int u = 0; u < U; ++u) g[bb][u] = ((const GAS unsigned*)(gp + (size_t)(t0 + ts * (i0 + U * NB + bb * U + u)) * 1024))[c];
            }
        }
    }
    if (!lat) F.out[OUT_SLRU + (size_t)(ss * 2 + d) * 512 + c] = hs;
    else *(f32x2*)(F.LC + ((size_t)((b * 2 + d) * 4 + j) * 512 + c) * 2) = (f32x2){pp, hs};
}
DI void p4_scans(Frame& F, int mode = 0) {
    for (int wi = F.vcu; wi < 256; wi += F.G) {
        if (wi < 160) {
            if (mode == 2) continue;
            if (wi < 32) hg_scan_wg(F, 32 + (wi >> 3), (wi >> 2) & 1, wi & 3, -1, 0, 0, mode);
            else { const int gA = 2 * (wi - 32), gB = gA + 1; hg_scan_wg(F, gA >> 3, (gA >> 2) & 1, gA & 3, gB >> 3, (gB >> 2) & 1, gB & 3, mode); }
        } else {
            if (mode == 1 || mode == 4 || mode == 5) continue;
            const int li = (wi - 160) * 8 + F.wave;
            const int ssx = li >> 4; const int ss = ssx < 16 ? 32 + ssx : ssx - 16;
            lru_scan_item(F, ss, (li >> 3) & 1, li & 7);
        }
    }
}

constexpr int N_PHASES = 11;
struct Args { const float* in[24]; float* out; unsigned char* ws; int ph_lo, ph_hi, li, pad; };
__global__ void __launch_bounds__(NWAVES * 64, 2) mk_fwd(Args args) {
    extern __shared__ __attribute__((aligned(16))) unsigned char lds[];
    Frame F;
    F.lds = (LAS unsigned char*)lds;
    F.tid = threadIdx.x; F.lane = F.tid & 63; F.wave = __builtin_amdgcn_readfirstlane(F.tid >> 6);
    F.G = gridDim.x; { const int bx = blockIdx.x; F.vcu = (F.G % 8 == 0) ? (bx % 8) * (F.G / 8) + bx / 8 : bx; }
    unsigned char* ws = args.ws;
    F.x_prompt = args.in[0]; F.x_sample = args.in[1]; F.cvec = args.in[2]; F.state_hgrn = args.in[3]; F.state_rglru = args.in[4]; F.c_ctx = args.in[5];
    F.w_ada = args.in[6]; F.b_ada = args.in[7]; F.norm1_gain = args.in[8]; F.norm2_gain = args.in[9]; F.w_in = args.in[10]; F.lb_logits = args.in[11];
    F.hg_norm_gain = args.in[12]; F.conv_w = args.in[13]; F.conv_b = args.in[14]; F.lru_wa = args.in[15]; F.lru_ba = args.in[16]; F.lru_wx = args.in[17];
    F.lru_bx = args.in[18]; F.lru_lambda = args.in[19]; F.w_out = args.in[20]; F.w_ff1 = args.in[21]; F.w_ff2 = args.in[22]; F.final_gain = args.in[23];
    F.out = args.out;
    F.Win_t = (bf16*)(ws + WS_WIN); F.Wout_t = (bf16*)(ws + WS_WOUT); F.Wff1_t = (bf16*)(ws + WS_WFF1); F.Wff2_t = (bf16*)(ws + WS_WFF2); F.WL = (bf16*)(ws + WS_WL);
    F.MOD = (float*)(ws + WS_MOD); F.XS = (float*)(ws + WS_XS); F.DEC = (float*)(ws + WS_DEC); F.LC = (float*)(ws + WS_LC); F.PC = (bf16*)(ws + WS_PC); F.XF = (bf16*)(ws + WS_XF);
    F.ACT = (bf16*)(ws + WS_ACT); F.QF = (bf16*)(ws + WS_QF); F.V = (bf16*)(ws + WS_V); F.GL = (bf16*)(ws + WS_GL); F.LX = (bf16*)(ws + WS_LX);
    F.QE = (bf16*)(ws + WS_QE); F.KE = (bf16*)(ws + WS_KE); F.KDT = (bf16*)(ws + WS_KDT); F.VT = (bf16*)(ws + WS_VT);
    F.OF = (bf16*)(ws + WS_OF); F.OB = (bf16*)(ws + WS_OB); F.HF = (bf16*)(ws + WS_HF); F.HB = (bf16*)(ws + WS_HB); F.HID = (bf16*)(ws + WS_HID);
    F.GATES = (unsigned*)args.out;
    volatile LAS unsigned* MISC = (volatile LAS unsigned*)(F.lds + LDSCTL_OFF);
    for (int u = F.tid; u < 128; u += NWAVES * 64) MISC[u] = 0u;
    __syncthreads();
    const int lo = args.ph_lo, hi = args.ph_hi;
    XcdBarrier bar; bar.bar = (unsigned*)(ws + WS_CTL); bar.x = 0; bar.st = nullptr;
    if (hi - lo > 1) bar = xcd_barrier_post((unsigned*)(ws + WS_CTL), MISC + 8);
#define IN(k) (lo <= (k) && (k) < hi)
#define SEAM(k) do { if (IN(k) && IN((k) + 1)) xcd_barrier(bar); } while (0)
#ifndef RPT
#define RPT -1
#endif
#define NREP(k) ((RPT == (k)) ? 2 : 1)
#ifndef RPTMODE
#define RPTMODE 0
#endif

    if (IN(0)) { for (int rp = 0; rp < NREP(0); ++rp) { p0_prologue(F); __syncthreads(); } } SEAM(0);
    if (IN(1)) { for (int rp = 0; rp < NREP(1); ++rp) p1_rows(F); } SEAM(1);
    if (IN(2)) for (int rp = 0; rp < NREP(2); ++rp) {
        pg8::Gemm g{F.ACT, F.Win_t, NTOK, INC, D}; pg8::StaticOrder S; S.init(NTOK, INC, F.G, (int)blockIdx.x);
        pg8::EpiRoute E{F.QF, F.V, F.GL, F.LX};
        pg8::gemm_phase<pg8::EpiRoute, pg8::StaticOrder, PG8_ALIGN, PG8_SP2>(F.lds + RING_OFF, g, S, E);
    } SEAM(2);
    if (IN(3)) { for (int rp = 0; rp < NREP(3); ++rp) p3_prep(F); } SEAM(3);
    if (IN(4)) { for (int rp = 0; rp < NREP(4); ++rp) p4_scans(F, rp ? RPTMODE : 0); } SEAM(4);
    if (IN(5)) { for (int rp = 0; rp < NREP(5); ++rp) p5_rows(F); } SEAM(5);
    if (IN(6)) for (int rp = 0; rp < NREP(6); ++rp) {
        pg8::Gemm g{F.ACT, F.Wout_t, NTOK, D, D}; pg8::StaticOrder S; S.init(NTOK, D, F.G, (int)blockIdx.x);
        pg8::EpiResid E{F.x_prompt, F.XS, F.out, F.MOD + 2048};
        pg8::gemm_phase<pg8::EpiResid, pg8::StaticOrder, PG8_ALIGN, PG8_SP2>(F.lds + RING_OFF, g, S, E);
    } SEAM(6);
    if (IN(7)) { for (int rp = 0; rp < NREP(7); ++rp) p7_rows(F); } SEAM(7);
    if (IN(8)) for (int rp = 0; rp < NREP(8); ++rp) {
        pg8::Gemm g{F.ACT, F.Wff1_t, NTOK, DFF, D}; pg8::StaticOrder S; S.init(NTOK, DFF, F.G, (int)blockIdx.x);
        pg8::EpiRelu2 E{F.HID, DFF};
        pg8::gemm_phase<pg8::EpiRelu2, pg8::StaticOrder, PG8_ALIGN, PG8_SP2>(F.lds + RING_OFF, g, S, E);
    } SEAM(8);
    if (IN(9)) {
        pg8::Gemm g{F.HID, F.Wff2_t, NTOK, D, DFF}; pg8::StaticOrder S; S.init(NTOK, D, F.G, (int)blockIdx.x);
        pg8::EpiResid E{F.out, F.out + (size_t)NCTX * D, F.out, F.MOD + 5120};
        pg8::gemm_phase<pg8::EpiResid, pg8::StaticOrder, PG8_ALIGN, PG8_SP2>(F.lds + RING_OFF, g, S, E);
    } SEAM(9);
    if (IN(10)) { p10_rows(F); }
#undef IN
#undef SEAM
}

extern "C" void kernel_launch(void* const* d_in, const int* in_sizes, int n_in, void* d_out, int out_size, void* d_ws, size_t ws_size, hipStream_t stream) {
    static int grid = 0;
    if (grid == 0) {
        if (n_in != 24 || in_sizes[0] != NCTX * D || ws_size < WS_END) { fprintf(stderr, "kernel_launch: unexpected shapes (n_in %d, in0 %d, out %d, ws %zu)\n", n_in, n_in > 0 ? in_sizes[0] : -1, out_size, ws_size); grid = -1; return; }
        int dev = 0, cus = 0, per_cu = 0;
        if (hipGetDevice(&dev) != hipSuccess || hipDeviceGetAttribute(&cus, hipDeviceAttributeMultiprocessorCount, dev) != hipSuccess) { grid = -1; return; }
        if (hipFuncSetAttribute((const void*)mk_fwd, hipFuncAttributeMaxDynamicSharedMemorySize, LDS_BYTES) != hipSuccess) { fprintf(stderr, "kernel_launch: hipFuncSetAttribute failed\n"); grid = -1; return; }
        if (hipOccupancyMaxActiveBlocksPerMultiprocessor(&per_cu, (const void*)mk_fwd, NWAVES * 64, LDS_BYTES) != hipSuccess || per_cu < 1)
            fprintf(stderr, "kernel_launch: occupancy query reports %d workgroups per CU\n", per_cu);
        (void)hipGetLastError();
        grid = cus;
    }
    if (grid < 0) return;
    if (hipMemsetAsync((char*)d_ws + WS_CTL, 0, CTL_ZERO_BYTES, stream) != hipSuccess) return;
    Args a{};
    for (int i = 0; i < 24; ++i) a.in[i] = (const float*)d_in[i];
    a.out = (float*)d_out; a.ws = (unsigned char*)d_ws;
    constexpr int NL = MK_N_LAUNCHES;
    for (int li = 0; li < NL; ++li) {
        a.ph_lo = (NL == 1) ? 0 : li; a.ph_hi = (NL == 1) ? N_PHASES : li + 1; a.li = li;
        hipLaunchKernelGGL(mk_fwd, dim3(grid), dim3(NWAVES * 64), LDS_BYTES, stream, a);
    }
}
```

```cpp
#include <hip/hip_runtime.h>
#include <cstdio>
#include <cstdint>

#ifndef MK_N_LAUNCHES
#define MK_N_LAUNCHES 1
#endif

#define DI __device__ __forceinline__
#define GAS __attribute__((address_space(1)))
#define LAS __attribute__((address_space(3)))
typedef unsigned short bf16;
typedef unsigned v4u __attribute__((ext_vector_type(4)));
typedef unsigned v2u __attribute__((ext_vector_type(2)));
typedef float f32x2 __attribute__((ext_vector_type(2)));
typedef float f32x4 __attribute__((ext_vector_type(4)));
typedef float f32x16 __attribute__((ext_vector_type(16)));
typedef short bf16x8 __attribute__((ext_vector_type(8)));
typedef short s16x4 __attribute__((ext_vector_type(4)));
typedef __bf16 bf2_t __attribute__((ext_vector_type(2)));

DI unsigned pk2(float lo, float hi) { f32x2 v = {lo, hi}; return __builtin_bit_cast(unsigned, __builtin_convertvector(v, bf2_t)); }
DI float bflo(unsigned w) { return __uint_as_float(w << 16); }
DI float bfhi(unsigned w) { return __uint_as_float(w & 0xffff0000u); }
DI float sigm(float x) { return __builtin_amdgcn_rcpf(1.0f + __expf(-x)); }
DI float silu_f(float x) { return x * sigm(x); }
DI float gelu_tanh_f(float x) { const float u = 0.7978845608028654f * (x + 0.044715f * x * x * x); return x * sigm(2.0f * u); }
DI float wave_sum(float v) {
#pragma unroll
    for (int o = 1; o < 64; o <<= 1) v += __shfl_xor(v, o);
    return v;
}
#define LDS_WAIT() asm volatile("s_waitcnt lgkmcnt(0)" ::: "memory")
#define VM_WAIT() asm volatile("s_waitcnt vmcnt(0)" ::: "memory")

constexpr int D = 1024, NTOK = 12288, NCTX = 8192, TCTX = 256, TLAT = 1024;
constexpr int INC = 4096, DFF = 4096, NCH = NTOK / 32;
constexpr float EPS = 1e-6f;
constexpr int NWAVES = 8;

constexpr size_t MiB = 1u << 20;
constexpr size_t WS_CTL = 0, CTL_ZERO_BYTES = 640 * 1024;
constexpr size_t WS_WIN = 1 * MiB, WS_WOUT = 9 * MiB, WS_WFF1 = 11 * MiB, WS_WFF2 = 19 * MiB;
constexpr size_t WS_MOD = 64 * 1024;
constexpr size_t WS_WL = 27 * MiB + 256 * 1024;
constexpr size_t WS_LC = 27 * MiB + 640 * 1024;
constexpr size_t WS_ACT = 28 * MiB;
constexpr size_t WS_XS = 52 * MiB;
constexpr size_t WS_QF = 68 * MiB;
constexpr size_t WS_OF = 164 * MiB, WS_OB = 176 * MiB, WS_HF = 196 * MiB, WS_HB = 208 * MiB;
constexpr size_t WS_V = 116 * MiB;
constexpr size_t WS_PC = 188 * MiB;
constexpr size_t WS_XF = 250 * MiB;
constexpr size_t WS_GL = 128 * MiB;
constexpr size_t WS_LX = 152 * MiB;
constexpr size_t WS_QE = 164 * MiB, WS_KE = 188 * MiB;
constexpr size_t WS_X1B = 164 * MiB;
constexpr size_t WS_KDT = 212 * MiB;
constexpr size_t WS_DEC = 236 * MiB;
constexpr size_t WS_XRMS = 256 * 1024;
constexpr size_t WS_VT = 238 * MiB;
constexpr size_t WS_HID = 68 * MiB;
constexpr size_t WS_END = 256 * MiB;

constexpr int RING_OFF = 0, RING_BYTES = 131072;
constexpr int LDSCTL_OFF = RING_BYTES;
constexpr int CT_OFF = RING_BYTES + 1024;
constexpr int LDS_BYTES = 160 * 1024;
static_assert(CT_OFF + 5 * 1024 * 4 <= LDS_BYTES, "LDS map");

#define XB_TMO      128
#define XB_XCNT(j)  (256  + 64 * (j))
#define XB_XSUB(j)  (1280 + 64 * (j))
#define XB_XGEN(j)  (2304 + 64 * (j))
#define XB_TOP      3328
#define XB_TOPGEN   3392
#define XCD_BAR_WORDS 3456
#define XB_SPIN_CAP (1u << 18)
constexpr int CW_RMSCNT = 4096;
static_assert(XCD_BAR_WORDS <= CW_RMSCNT && (CW_RMSCNT + 2 * 64 * 16) * 4 <= 32768, "CTL map");
static_assert(XCD_BAR_WORDS * 4 <= CTL_ZERO_BYTES, "barrier words inside the memset region");

DI unsigned xb_ld(unsigned* p)              { return __hip_atomic_load(p, __ATOMIC_RELAXED, __HIP_MEMORY_SCOPE_AGENT); }
DI unsigned xb_add(unsigned* p, unsigned v) { return __hip_atomic_fetch_add(p, v, __ATOMIC_RELAXED, __HIP_MEMORY_SCOPE_AGENT); }
DI unsigned xb_xcc_id() { return (unsigned)__builtin_amdgcn_s_getreg((3 << 11) | 20) & 0xFu; }
#define XB_SPIN(cond, bar) do { unsigned _sp = 0; while (cond) { __builtin_amdgcn_s_sleep(1); \
    if ((++_sp & 255u) == 0u) { if (xb_ld(&(bar)[XB_TMO])) break; if (_sp > XB_SPIN_CAP) { atomicAdd(&(bar)[XB_TMO], 1u); break; } } } } while (0)

struct XcdBarrier { unsigned* bar; unsigned x; volatile LAS unsigned* st; };

DI XcdBarrier xcd_barrier_post(unsigned* bar, volatile LAS unsigned* st) {
    XcdBarrier b; b.bar = bar; b.x = xb_xcc_id(); b.st = st;
    if (threadIdx.x == 0) (void)xb_add(&bar[XB_XCNT(b.x)], 1u);
    return b;
}
DI void xcd_barrier_complete(unsigned* bar, unsigned x, unsigned& nloc, unsigned& nx) {
    const unsigned G = gridDim.x * gridDim.y * gridDim.z;
    unsigned sum, cnt, mine, sp = 0u;
    for (;;) {
        sum = 0u; cnt = 0u; mine = 0u;
#pragma unroll
        for (unsigned j = 0; j < 16; ++j) { const unsigned c = xb_ld(&bar[XB_XCNT(j)]); sum += c; cnt += (c > 0u) ? 1u : 0u; mine = (j == x) ? c : mine; }
        if (sum == G) break;
        __builtin_amdgcn_s_sleep(1);
        if ((++sp & 255u) == 0u) { if (xb_ld(&bar[XB_TMO])) break; if (sp > XB_SPIN_CAP) { atomicAdd(&bar[XB_TMO], 1u); break; } }
    }
    nloc = mine > 0u ? mine : 1u; nx = cnt > 0u ? cnt : 1u;
}
DI void xcd_barrier(const XcdBarrier& b) {
    asm volatile("s_waitcnt vmcnt(0)" ::: "memory");
    __syncthreads();
    if (threadIdx.x == 0) {
        unsigned* bar = b.bar;
        __builtin_amdgcn_s_waitcnt(0);
        unsigned nloc = b.st[0], nx = b.st[1];
        if (nloc == 0u) { xcd_barrier_complete(bar, b.x, nloc, nx); b.st[0] = nloc; b.st[1] = nx; }
        const unsigned old = xb_add(&bar[XB_XSUB(b.x)], 1u);
        asm volatile("s_waitcnt vmcnt(0)" ::: "memory");
        const unsigned gen = old / nloc;
        const bool xlast = (old + 1u == (gen + 1u) * nloc);
        asm volatile("buffer_inv sc1" ::: "memory");
        if (xlast) {
            __builtin_amdgcn_fence(__ATOMIC_RELEASE, "agent");
            asm volatile("s_waitcnt vmcnt(0)" ::: "memory");
            const unsigned og = xb_add(&bar[XB_TOP], 1u);
            const unsigned tg = og / nx;
            if (og + 1u == (tg + 1u) * nx) {
#pragma unroll
                for (unsigned j = 0; j < 16; ++j) xb_add(&bar[XB_XGEN(j)], 1u);
            }
        }
        XB_SPIN(xb_ld(&bar[XB_XGEN(b.x)]) == gen, bar);
        asm volatile("s_waitcnt vmcnt(0)" ::: "memory");
        __builtin_amdgcn_fence(__ATOMIC_ACQUIRE, "workgroup");
    }
    __syncthreads();
}

namespace pg8 {
#define PG8_LAS __attribute__((address_space(3)))
typedef unsigned short bf16_t;
typedef short bf16x8 __attribute__((ext_vector_type(8)));
typedef float f32x4 __attribute__((ext_vector_type(4)));
typedef unsigned u32x4 __attribute__((ext_vector_type(4)));
constexpr int BM = 256, BK = 64, HALF = 128, HTB = HALF * BK * 2  , STAGE_BYTES = 8 * HTB, NXCD = 8, WGM = 8;

__host__ __device__ __forceinline__ int lds_byte(int r, int c) { const int st = (r >> 4) * 2 + (c >> 5), rr = r & 15, cc = c & 31, ob = rr * 64 + cc * 2; return st * 1024 + (ob ^ (((ob >> 9) & 1) << 5)); }
__host__ __device__ __forceinline__ void stage_rc(int b, int& R, int& C) { const int st = b / 1024, sb = b % 1024, swz = sb ^ (((sb >> 9) & 1) << 5); R = (st >> 1) * 16 + swz / 64; C = (st & 1) * 32 + (swz % 64) / 2; }
__host__ __device__ __forceinline__ int perm32(int rho) { const int n = rho >> 4, i = rho & 15; return 8 * (i >> 2) + 4 * n + (i & 3); }

struct Unit { int pm, pn; };
struct Gemm { const bf16_t* A; const bf16_t* Bt; int M, N, K; };

struct StaticOrder {
    int nM, nN, nwg, G, c;
    __host__ __device__ void init(int M, int N, int G_, int c_, int unit_rows = BM) { nM = M / unit_rows; nN = N / BM; nwg = nM * nN; G = G_; c = c_; }
    __host__ __device__ bool next(int i, Unit& u) const {
        const long L = (long)i * G + c; if (L >= nwg) return false;
        int wgid = (int)L; { const int q = nwg / NXCD, r = nwg % NXCD, xcd = wgid % NXCD, off = wgid / NXCD; wgid = (xcd < r ? xcd * (q + 1) : r * (q + 1) + (xcd - r) * q) + off; }
        const int nig = WGM * nN, gid = wgid / nig, fm = gid * WGM, gsz = (nM - fm) < WGM ? (nM - fm) : WGM;
        u.pm = fm + ((wgid % nig) % gsz); u.pn = (wgid % nig) / gsz; return true;
    }
    __device__ __forceinline__ void a_ready(const Unit&) const {}
    __device__ __forceinline__ void done(const Unit&) const {}
};

__device__ __forceinline__ unsigned cvt_pk_bf16(float lo, float hi) { return pk2(lo, hi); }
__device__ __forceinline__ int cond_of_pm(int pm) { return pm < 32 ? 0 : 1 + ((pm - 32) >> 2); }

struct EpiRoute {
    static constexpr bool PERM = true, AFTER_DRAIN = false;
    bf16_t *QF, *V, *GL, *LX;
    __device__ __forceinline__ void operator()(const f32x4 (&acc)[2][2][4][2], const Unit& u, int wr, int wc, int fr, int fq) const {
        const int pn = u.pn; bf16_t* base; int ldc, colt;
        if (pn < 8) { base = QF; ldc = 2048; colt = pn * 256; }
        else if (pn < 10) { base = V; ldc = 512; colt = (pn - 8) * 256; }
        else if (pn < 12) { base = GL; ldc = 1024; colt = (pn - 10) * 256; }
        else if (pn < 14) { base = LX; ldc = 512; colt = (pn - 12) * 256; }
        else { base = GL; ldc = 1024; colt = 512 + (pn - 14) * 256; }
        const int row0 = u.pm * BM + wr * 64 + fr, col0 = colt + wc * 32 + 8 * fq;
#pragma unroll
        for (int ai = 0; ai < 2; ++ai)
#pragma unroll
            for (int m = 0; m < 4; ++m) { bf16_t* rowp = base + (size_t)(row0 + ai * HALF + m * 16) * ldc + col0;
#pragma unroll
                for (int bj = 0; bj < 2; ++bj) { const f32x4 v0 = acc[ai][bj][m][0], v1 = acc[ai][bj][m][1];
                    u32x4 w; w.x = cvt_pk_bf16(v0[0], v0[1]); w.y = cvt_pk_bf16(v0[2], v0[3]); w.z = cvt_pk_bf16(v1[0], v1[1]); w.w = cvt_pk_bf16(v1[2], v1[3]);
                    *(u32x4*)(rowp + bj * HALF) = w; } }
    }
};
struct EpiRelu2 {
    static constexpr bool PERM = true, AFTER_DRAIN = false;
    bf16_t* O; int ldc;
    __device__ __forceinline__ void operator()(const f32x4 (&acc)[2][2][4][2], const Unit& u, int wr, int wc, int fr, int fq) const {
        const int row0 = u.pm * BM + wr * 64 + fr, col0 = u.pn * BM + wc * 32 + 8 * fq;
#pragma unroll
        for (int ai = 0; ai < 2; ++ai)
#pragma unroll
            for (int m = 0; m < 4; ++m) { bf16_t* rowp = O + (size_t)(row0 + ai * HALF + m * 16) * ldc + col0;
#pragma unroll
                for (int bj = 0; bj < 2; ++bj) { f32x4 v0 = acc[ai][bj][m][0], v1 = acc[ai][bj][m][1];
#pragma unroll
                    for (int j = 0; j < 4; ++j) { const float a = fmaxf(v0[j], 0.f), b = fmaxf(v1[j], 0.f); v0[j] = a * a; v1[j] = b * b; }
                    u32x4 w; w.x = cvt_pk_bf16(v0[0], v0[1]); w.y = cvt_pk_bf16(v0[2], v0[3]); w.z = cvt_pk_bf16(v1[0], v1[1]); w.w = cvt_pk_bf16(v1[2], v1[3]);
                    *(u32x4*)(rowp + bj * HALF) = w; } }
    }
};
struct EpiResid {
    static constexpr bool PERM = false, AFTER_DRAIN = false;
    const float* resA; const float* resB; float* out; const float* gate;
    __device__ __forceinline__ void operator()(const f32x4 (&acc)[2][2][4][2], const Unit& u, int wr, int wc, int fr, int fq) const {
        const int row0 = u.pm * BM + wr * 64 + fr, col0 = u.pn * BM + wc * 32 + 4 * fq;
        const float* g = gate + cond_of_pm(u.pm) * 6144 + col0;
        const float* res = (u.pm < 32) ? resA + (size_t)row0 * 1024 : resB + (size_t)(row0 - 8192) * 1024;
        f32x4 gv[2][2];
#pragma unroll
        for (int bj = 0; bj < 2; ++bj)
#pragma unroll
            for (int n = 0; n < 2; ++n) gv[bj][n] = *(const f32x4*)(g + bj * HALF + n * 16);
#pragma unroll
        for (int ai = 0; ai < 2; ++ai)
#pragma unroll
            for (int m = 0; m < 4; ++m) { const size_t ro = (size_t)(ai * HALF + m * 16) * 1024 + col0; float* rowp = out + (size_t)row0 * 1024 + ro;
#pragma unroll
                for (int bj = 0; bj < 2; ++bj)
#pragma unroll
                    for (int n = 0; n < 2; ++n) { const f32x4 rv = *(const f32x4*)(res + ro + bj * HALF + n * 16); *(f32x4*)(rowp + bj * HALF + n * 16) = rv + gv[bj][n] * acc[ai][bj][m][n]; } }
    }
};

template <int MT> struct EpiResidT {
    static constexpr bool PERM = false, AFTER_DRAIN = false;
    const float* resA; const float* resB; float* out; const float* gate;
    __device__ __forceinline__ void operator()(const f32x4 (&acc)[2][2][MT][2], const Unit& u, int wr, int wc, int fr, int fq) const {
        const int col0 = u.pn * BM + wc * 32 + 4 * fq;
#pragma unroll
        for (int ai = 0; ai < 2; ++ai)
#pragma unroll
            for (int m = 0; m < MT; ++m) {
                const int row = u.pm * (64 * MT) + ai * (32 * MT) + wr * (16 * MT) + m * 16 + fr;
                const float* res = (row < 8192 ? resA + (size_t)row * 1024 : resB + (size_t)(row - 8192) * 1024) + col0;
                const float* g = gate + (row < 8192 ? 0 : 1 + ((row - 8192) >> 10)) * 6144 + col0;
                float* rowp = out + (size_t)row * 1024 + col0;
#pragma unroll
                for (int bj = 0; bj < 2; ++bj)
#pragma unroll
                    for (int n = 0; n < 2; ++n) { const f32x4 rv = *(const f32x4*)(res + bj * HALF + n * 16), gv = *(const f32x4*)(g + bj * HALF + n * 16); *(f32x4*)(rowp + bj * HALF + n * 16) = rv + gv * acc[ai][bj][m][n]; }
            }
    }
};

template <int MT, int MODE> struct EpiRmsT {
    static constexpr bool PERM = false, AFTER_DRAIN = true;
    const float* resA; const float* resB; float* out; const float* gate; const float* ngain; const float* mod; bf16_t* act; float* slots; unsigned* cnt; bf16_t* x1b;
    __device__ __forceinline__ void fused(f32x4 (&acc)[2][2][MT][2], const Unit& u, int wr, int wc, int fr, int fq, PG8_LAS unsigned char* lds, int wid, int lane) const {
        constexpr int RU = 64 * MT;
        typedef unsigned u32x2v __attribute__((ext_vector_type(2)));
        PG8_LAS float* P = (PG8_LAS float*)lds;
        PG8_LAS float* S = (PG8_LAS float*)(lds + 4096);
        const int col0 = u.pn * BM + wc * 32 + 4 * fq, tid = wid * 64 + lane;
        const int row_first = u.pm * RU, row_last = row_first + RU - 1;
        const int cond_lo = row_first < 8192 ? 0 : 1 + ((row_first - 8192) >> 10), cond_hi = row_last < 8192 ? 0 : 1 + ((row_last - 8192) >> 10);
        const int bnd = cond_hi == 0 ? 0 : 8192 + (cond_hi - 1) * 1024;
        f32x4 rv[2][MT][2][2]; u32x2v rb[2][MT][2][2];
#pragma unroll
        for (int ai = 0; ai < 2; ++ai)
#pragma unroll
            for (int m = 0; m < MT; ++m) { const int row = u.pm * RU + ai * (32 * MT) + wr * (16 * MT) + m * 16 + fr;
#pragma unroll
                for (int bj = 0; bj < 2; ++bj)
#pragma unroll
                    for (int n = 0; n < 2; ++n) { const int co = bj * HALF + n * 16;
                        if (MODE == 0) rv[ai][m][bj][n] = __builtin_nontemporal_load((const f32x4*)((row < 8192 ? resA + (size_t)row * 1024 : resB + (size_t)(row - 8192) * 1024) + col0 + co));
                        else rb[ai][m][bj][n] = __builtin_nontemporal_load((const u32x2v*)(x1b + (size_t)row * 1024 + col0 + co)); } }
        f32x4 gvl[2][2], gvh[2][2];
#pragma unroll
        for (int bj = 0; bj < 2; ++bj)
#pragma unroll
            for (int n = 0; n < 2; ++n) { const int co = bj * HALF + n * 16; gvl[bj][n] = *(const f32x4*)(gate + cond_lo * 6144 + col0 + co); gvh[bj][n] = *(const f32x4*)(gate + cond_hi * 6144 + col0 + co); }
        const float quarter = (u.pn & 1) ? 0.25f : 0.0f;
#pragma unroll
        for (int ai = 0; ai < 2; ++ai)
#pragma unroll
            for (int m = 0; m < MT; ++m) {
                const int rbase = u.pm * RU + ai * (32 * MT) + wr * (16 * MT) + m * 16, rl = ai * (32 * MT) + wr * (16 * MT) + m * 16 + fr, row = u.pm * RU + rl;
                const bool hi = rbase >= bnd;
                const int tl = (row - 8192) & 1023; const float posv = (u.pn < 2) ? (float)(tl >> 6) : (float)(tl & 63);
                float s = 0.f;
#pragma unroll
                for (int bj = 0; bj < 2; ++bj)
#pragma unroll
                    for (int n = 0; n < 2; ++n) { const int co = bj * HALF + n * 16; f32x4 r4;
                        if (MODE == 0) { r4 = rv[ai][m][bj][n];
                            if (rbase >= 8192) {
#pragma unroll
                                for (int e = 0; e < 4; ++e) { const int c = col0 + co + e; const float om = __builtin_amdgcn_exp2f(-(float)(c & 255) * (13.287712379549449f / 256.0f));
                                    r4[e] += __builtin_amdgcn_sinf(posv * om * 0.15915494309189535f + quarter); } }
                        } else { const u32x2v xb = rb[ai][m][bj][n];
                            r4 = (f32x4){__uint_as_float(xb.x << 16), __uint_as_float(xb.x & 0xffff0000u), __uint_as_float(xb.y << 16), __uint_as_float(xb.y & 0xffff0000u)}; }
                        const f32x4 gv = hi ? gvh[bj][n] : gvl[bj][n];
                        const f32x4 x = r4 + gv * acc[ai][bj][m][n]; acc[ai][bj][m][n] = x; s += (x[0] * x[0] + x[1] * x[1]) + (x[2] * x[2] + x[3] * x[3]); }
                s += __shfl_xor(s, 16); s += __shfl_xor(s, 32);
                if (fq == 0) P[rl * 4 + wc] = s;
            }
        f32x4 al[2][2], ah[2][2], sl_[2][2], sh_[2][2];
#pragma unroll
        for (int bj = 0; bj < 2; ++bj)
#pragma unroll
            for (int n = 0; n < 2; ++n) { const int co = bj * HALF + n * 16; const f32x4 gn = *(const f32x4*)(ngain + col0 + co);
                if (MODE == 0) { const float* ml = mod + cond_lo * 6144 + col0 + co; const float* mh = mod + cond_hi * 6144 + col0 + co;
                    al[bj][n] = gn * (1.0f + *(const f32x4*)(ml + 4096)); sl_[bj][n] = *(const f32x4*)(ml + 3072);
                    ah[bj][n] = gn * (1.0f + *(const f32x4*)(mh + 4096)); sh_[bj][n] = *(const f32x4*)(mh + 3072); }
                else al[bj][n] = gn; }
        asm volatile("s_waitcnt lgkmcnt(0)" ::: "memory"); __builtin_amdgcn_s_barrier(); asm volatile("" ::: "memory");
        if (tid < RU) { const float s4 = fmaxf((P[tid * 4] + P[tid * 4 + 1]) + (P[tid * 4 + 2] + P[tid * 4 + 3]), 1e-30f);
            float* sl = slots + (size_t)(u.pm * RU + tid) * 4;
            __hip_atomic_store(sl + u.pn, s4, __ATOMIC_RELAXED, __HIP_MEMORY_SCOPE_AGENT);
            float v0, v1, v2, v3; unsigned sp = 0;
            for (;;) {
                v0 = __hip_atomic_load(sl + 0, __ATOMIC_RELAXED, __HIP_MEMORY_SCOPE_AGENT); v1 = __hip_atomic_load(sl + 1, __ATOMIC_RELAXED, __HIP_MEMORY_SCOPE_AGENT);
                v2 = __hip_atomic_load(sl + 2, __ATOMIC_RELAXED, __HIP_MEMORY_SCOPE_AGENT); v3 = __hip_atomic_load(sl + 3, __ATOMIC_RELAXED, __HIP_MEMORY_SCOPE_AGENT);
                v0 = (u.pn == 0) ? s4 : v0; v1 = (u.pn == 1) ? s4 : v1; v2 = (u.pn == 2) ? s4 : v2; v3 = (u.pn == 3) ? s4 : v3;
                if (__builtin_amdgcn_ballot_w64(!(v0 > 0.f && v1 > 0.f && v2 > 0.f && v3 > 0.f)) == 0ull || ++sp > (1u << 20)) break;
                __builtin_amdgcn_s_sleep(2);
            }
            S[tid] = __builtin_amdgcn_rsqf(((v0 + v1) + (v2 + v3)) * (1.0f / 1024.0f) + 1e-6f); }
        asm volatile("s_waitcnt lgkmcnt(0)" ::: "memory"); __builtin_amdgcn_s_barrier(); asm volatile("" ::: "memory");
#pragma unroll
        for (int ai = 0; ai < 2; ++ai)
#pragma unroll
            for (int m = 0; m < MT; ++m) {
                const int rbase = u.pm * RU + ai * (32 * MT) + wr * (16 * MT) + m * 16, rl = ai * (32 * MT) + wr * (16 * MT) + m * 16 + fr, row = u.pm * RU + rl;
                const bool hi = rbase >= bnd;
                const float rstd = S[rl];
#pragma unroll
                for (int bj = 0; bj < 2; ++bj)
#pragma unroll
                    for (int n = 0; n < 2; ++n) { const int co = bj * HALF + n * 16;
                        const f32x4 x = acc[ai][bj][m][n];
                        if (MODE == 0) { const f32x4 y = x * rstd * (hi ? ah[bj][n] : al[bj][n]) + (hi ? sh_[bj][n] : sl_[bj][n]);
                            u32x2v w; w.x = cvt_pk_bf16(y[0], y[1]); w.y = cvt_pk_bf16(y[2], y[3]);
                            *(u32x2v*)(act + (size_t)row * 1024 + col0 + co) = w;
                            u32x2v xw; xw.x = cvt_pk_bf16(x[0], x[1]); xw.y = cvt_pk_bf16(x[2], x[3]);
                            *(u32x2v*)(x1b + (size_t)row * 1024 + col0 + co) = xw; }
                        else __builtin_nontemporal_store(x * rstd * al[bj][n], (f32x4*)(out + (size_t)row * 1024 + col0 + co)); }
            }
    }
};

template <class Epi, class Sched, bool ALIGN_EPI = false, bool SP2 = false, int MT = 4>
__device__ __forceinline__ void gemm_phase(PG8_LAS unsigned char* lds, const Gemm g, const Sched& S, const Epi& E) {
    const int tid = threadIdx.x, wid = __builtin_amdgcn_readfirstlane(tid >> 6), lane = tid & 63, wr = wid >> 2, wc = wid & 3, fr = lane & 15, fq = lane >> 4;
    const int K = g.K, nt = K / BK;
    unsigned voffA[2], voffB[2];
#pragma unroll
    for (int i = 0; i < 2; ++i) { int R, C; stage_rc(tid * 16 + i * 8192, R, C); const int Rb = Epi::PERM ? ((R & ~31) + perm32(R & 31)) : R;
        voffA[i] = (unsigned)(R * K + C) * 2u; voffB[i] = (unsigned)(Rb * K + C) * 2u; }
    const size_t kstep = (size_t)(BK * 2);
    const size_t hstep = (size_t)HALF * K * 2;
    const size_t tstep = 2 * hstep;
    const size_t hstepA = (size_t)(32 * MT) * K * 2, tstepA = 2 * hstepA;
    const unsigned ldsw = (unsigned)wid * 1024u;
    const int aoff = lds_byte(wr * 16 * MT + fr, fq * 8), boff = lds_byte(wc * 32 + fr, fq * 8);
#define PG8_SA(b, h) (((b) * 2 + (h)) * HTB)
#define PG8_SB(b, h) ((4 + (b) * 2 + (h)) * HTB)
#define PG8_STAGE(bufoff, gbase, voff) do { _Pragma("unroll") for (int _i = 0; _i < 2; ++_i) \
        __builtin_amdgcn_global_load_lds((const unsigned*)((const char*)(gbase) + (voff)[_i]), (PG8_LAS unsigned*)(lds + (bufoff) + ldsw + _i * 8192), 16, 0, 0); } while (0)
#define PG8_LDA(dst, b, h) do { _Pragma("unroll") for (int m = 0; m < MT; ++m) _Pragma("unroll") for (int k = 0; k < 2; ++k) dst[m][k] = *(const PG8_LAS bf16x8*)(lds + PG8_SA(b, h) + aoff + m * 2048 + k * 1024); } while (0)
#define PG8_LDB(dst, b, h) do { _Pragma("unroll") for (int n = 0; n < 2; ++n) _Pragma("unroll") for (int k = 0; k < 2; ++k) dst[n][k] = *(const PG8_LAS bf16x8*)(lds + PG8_SB(b, h) + boff + n * 2048 + k * 1024); } while (0)
#define PG8_MMA(ai, bj, At, Bt) do { __builtin_amdgcn_s_setprio(1); _Pragma("unroll") for (int m = 0; m < MT; ++m) _Pragma("unroll") for (int n = 0; n < 2; ++n) _Pragma("unroll") for (int k = 0; k < 2; ++k) \
        acc[ai][bj][m][n] = __builtin_amdgcn_mfma_f32_16x16x32_bf16(Bt[n][k], At[m][k], acc[ai][bj][m][n], 0, 0, 0); __builtin_amdgcn_s_setprio(0); } while (0)
#define PG8_WAIT_V(n) asm volatile("s_waitcnt vmcnt(" #n ")" ::: "memory")
#define PG8_WAIT_L(n) asm volatile("s_waitcnt lgkmcnt(" #n ")" ::: "memory")
#define PG8_BAR __builtin_amdgcn_s_barrier()
#define PG8_SCHED __builtin_amdgcn_sched_barrier(0)
    Unit cur, nxt; int ui = 0;
    if (!S.next(0, cur)) return;
    f32x4 acc[2][2][MT][2];
#pragma unroll
    for (int a = 0; a < 2; ++a)
#pragma unroll
        for (int b = 0; b < 2; ++b)
#pragma unroll
            for (int m = 0; m < MT; ++m)
#pragma unroll
                for (int n = 0; n < 2; ++n) acc[a][b][m][n] = (f32x4){0.f, 0.f, 0.f, 0.f};
    bf16x8 At[MT][2], B0[2][2], B1[2][2];
    const char* cA = (const char*)g.A + (size_t)cur.pm * tstepA; const char* cB = (const char*)g.Bt + (size_t)cur.pn * tstep;
    S.a_ready(cur);
    if constexpr (SP2) {
        PG8_STAGE(PG8_SB(0, 0), cB, voffB); PG8_STAGE(PG8_SB(0, 1), cB + hstep, voffB); PG8_STAGE(PG8_SA(0, 0), cA, voffA); PG8_STAGE(PG8_SA(0, 1), cA + hstepA, voffA);
        if (wr == 1) PG8_BAR;
        PG8_WAIT_V(2); PG8_BAR;
        PG8_STAGE(PG8_SB(1, 0), cB + kstep, voffB); PG8_STAGE(PG8_SA(1, 0), cA + kstep, voffA); PG8_STAGE(PG8_SB(1, 1), cB + hstep + kstep, voffB);
        PG8_WAIT_V(6); PG8_BAR;
    } else {
        PG8_STAGE(PG8_SB(0, 0), cB, voffB); PG8_STAGE(PG8_SA(0, 0), cA, voffA); PG8_STAGE(PG8_SB(0, 1), cB + hstep, voffB); PG8_STAGE(PG8_SA(0, 1), cA + hstepA, voffA);
        if (wr == 1) PG8_BAR;
        PG8_WAIT_V(4); PG8_BAR;
        PG8_STAGE(PG8_SB(1, 0), cB + kstep, voffB); PG8_STAGE(PG8_SA(1, 0), cA + kstep, voffA); PG8_STAGE(PG8_SB(1, 1), cB + hstep + kstep, voffB);
        PG8_WAIT_V(6); PG8_BAR;
    }
    for (;;) {
        const bool has_next = S.next(ui + 1, nxt);
        const char* nA = has_next ? (const char*)g.A + (size_t)nxt.pm * tstepA : cA; const char* nB = has_next ? (const char*)g.Bt + (size_t)nxt.pn * tstep : cB;
        for (int t = 0; t < nt; t += 2) {
            const bool last = (t == nt - 2);
            const char* a1 = cA + (size_t)(t + 1) * kstep;
            const char* a2 = last ? nA : cA + (size_t)(t + 2) * kstep; const char* b2 = last ? nB : cB + (size_t)(t + 2) * kstep;
            const char* a3 = a2 + kstep; const char* b3 = b2 + kstep;
            if (last && has_next) S.a_ready(nxt);
            if constexpr (SP2) {
            PG8_LDB(B0, 0, 0); PG8_LDB(B1, 0, 1); PG8_SCHED; PG8_LDA(At, 0, 0); PG8_STAGE(PG8_SA(1, 1), a1 + hstepA, voffA);
            PG8_WAIT_V(8); PG8_WAIT_L(0); PG8_BAR; PG8_MMA(0, 0, At, B0); PG8_MMA(0, 1, At, B1); PG8_BAR; PG8_SCHED;
            PG8_LDA(At, 0, 1); PG8_STAGE(PG8_SB(0, 0), b2, voffB); PG8_STAGE(PG8_SB(0, 1), b2 + hstep, voffB); PG8_STAGE(PG8_SA(0, 0), a2, voffA);
            PG8_WAIT_V(8); PG8_WAIT_L(0); PG8_BAR; PG8_MMA(1, 0, At, B0); PG8_MMA(1, 1, At, B1); PG8_BAR; PG8_SCHED;
            PG8_LDB(B0, 1, 0); PG8_LDB(B1, 1, 1); PG8_SCHED; PG8_LDA(At, 1, 0); PG8_STAGE(PG8_SA(0, 1), a2 + hstepA, voffA);
            PG8_WAIT_V(8); PG8_WAIT_L(0); PG8_BAR; PG8_MMA(0, 0, At, B0); PG8_MMA(0, 1, At, B1); PG8_BAR; PG8_SCHED;
            PG8_LDA(At, 1, 1); PG8_STAGE(PG8_SB(1, 0), b3, voffB); PG8_STAGE(PG8_SB(1, 1), b3 + hstep, voffB); PG8_STAGE(PG8_SA(1, 0), a3, voffA);
            PG8_WAIT_V(8); PG8_WAIT_L(0); PG8_BAR; PG8_MMA(1, 0, At, B0); PG8_MMA(1, 1, At, B1); PG8_BAR; PG8_SCHED;
            } else {
            PG8_LDB(B0, 0, 0); PG8_SCHED; PG8_LDA(At, 0, 0); PG8_STAGE(PG8_SA(1, 1), a1 + hstepA, voffA);
            PG8_WAIT_L(8); PG8_BAR; PG8_WAIT_L(0); PG8_MMA(0, 0, At, B0); PG8_BAR; PG8_SCHED;
            PG8_LDB(B1, 0, 1); PG8_STAGE(PG8_SB(0, 0), b2, voffB);
            PG8_BAR; PG8_WAIT_L(0); PG8_MMA(0, 1, At, B1); PG8_BAR;
            PG8_LDA(At, 0, 1); PG8_STAGE(PG8_SA(0, 0), a2, voffA);
            PG8_BAR; PG8_WAIT_L(0); PG8_MMA(1, 0, At, B0); PG8_BAR; PG8_SCHED;
            PG8_STAGE(PG8_SB(0, 1), b2 + hstep, voffB);
            PG8_WAIT_V(6); PG8_BAR; PG8_MMA(1, 1, At, B1); PG8_BAR;
            PG8_LDB(B0, 1, 0); PG8_SCHED; PG8_LDA(At, 1, 0); PG8_STAGE(PG8_SA(0, 1), a2 + hstepA, voffA);
            PG8_WAIT_L(8); PG8_BAR; PG8_WAIT_L(0); PG8_MMA(0, 0, At, B0); PG8_BAR; PG8_SCHED;
            PG8_LDB(B1, 1, 1); PG8_STAGE(PG8_SB(1, 0), b3, voffB);
            PG8_BAR; PG8_WAIT_L(0); PG8_MMA(0, 1, At, B1); PG8_BAR;
            PG8_LDA(At, 1, 1); PG8_STAGE(PG8_SA(1, 0), a3, voffA);
            PG8_BAR; PG8_WAIT_L(0); PG8_MMA(1, 0, At, B0); PG8_BAR; PG8_SCHED;
            PG8_STAGE(PG8_SB(1, 1), b3 + hstep, voffB);
            PG8_WAIT_V(6); PG8_BAR; PG8_MMA(1, 1, At, B1); PG8_BAR;
            }
        }
        if constexpr (ALIGN_EPI) { if (wr == 0) PG8_BAR; }
        if constexpr (!Epi::AFTER_DRAIN) { E(acc, cur, wr, wc, fr, fq); S.done(cur); }
        if (!has_next) break;
#pragma unroll
        for (int a = 0; a < 2; ++a)
#pragma unroll
            for (int b = 0; b < 2; ++b)
#pragma unroll
                for (int m = 0; m < MT; ++m)
#pragma unroll
                    for (int n = 0; n < 2; ++n) acc[a][b][m][n] = (f32x4){0.f, 0.f, 0.f, 0.f};
        cur = nxt; cA = nA; cB = nB; ++ui;
        if constexpr (ALIGN_EPI) { if (wr == 1) PG8_BAR; }
    }
    PG8_WAIT_V(0);
    if constexpr (!ALIGN_EPI) { if (wr == 0) PG8_BAR; }
    PG8_BAR;
    if constexpr (Epi::AFTER_DRAIN) { E.fused(acc, cur, wr, wc, fr, fq, lds, wid, lane); S.done(cur); }
#undef PG8_SA
#undef PG8_SB
#undef PG8_STAGE
#undef PG8_LDA
#undef PG8_LDB
#undef PG8_MMA
#undef PG8_WAIT_V
#undef PG8_WAIT_L
#undef PG8_BAR
#undef PG8_SCHED
}
}

#ifndef PG8_SP2
#define PG8_SP2 true
#endif
#ifndef PG8_ALIGN
#define PG8_ALIGN true
#endif

struct Frame {
    LAS unsigned char* lds;
    int tid, lane, wave, vcu, G;
    const float *x_prompt, *x_sample, *cvec, *state_hgrn, *state_rglru, *c_ctx, *w_ada, *b_ada, *norm1_gain, *norm2_gain, *w_in, *lb_logits, *hg_norm_gain,
                *conv_w, *conv_b, *lru_wa, *lru_ba, *lru_wx, *lru_bx, *lru_lambda, *w_out, *w_ff1, *w_ff2, *final_gain;
    float* out;
    bf16 *Win_t, *Wout_t, *Wff1_t, *Wff2_t, *WL;
    float* MOD; float* XS; float* DEC; float* LC;
    bf16 *ACT, *QF, *V, *GL, *LX, *QE, *KE, *KDT, *VT, *OF, *OB, *HF, *HB, *HID, *PC, *XF;
};
constexpr size_t OUT_SHG = (size_t)NTOK * 1024, OUT_SLRU = OUT_SHG + (size_t)32 * 2 * 4 * 128 * 128;

DI void p0_transpose_item(const float* W, int K, int N, bf16* WT, LAS float* scr, int item, int lane) {
    const int nblk = N / 32, kb = item / nblk, nb = item % nblk, k0 = 64 * kb, n0 = 32 * nb;
    float wv[32];
#pragma unroll
    for (int i = 0; i < 32; ++i) wv[i] = __builtin_nontemporal_load(W + (size_t)(k0 + 2 * i + (lane >> 5)) * N + n0 + (lane & 31));
#pragma unroll
    for (int i = 0; i < 32; ++i) scr[(2 * i + (lane >> 5)) * 33 + (lane & 31)] = wv[i];
    LDS_WAIT(); asm volatile("" ::: "memory");
    const int c = lane & 7;
#pragma unroll
    for (int j = 0; j < 4; ++j) { const int n = (lane >> 3) + 8 * j; const LAS float* s = scr + (8 * c) * 33 + n;
        v4u o; o.x = pk2(s[0 * 33], s[1 * 33]); o.y = pk2(s[2 * 33], s[3 * 33]); o.z = pk2(s[4 * 33], s[5 * 33]); o.w = pk2(s[6 * 33], s[7 * 33]);
        *(GAS v4u*)(WT + (size_t)(n0 + n) * K + k0 + 8 * c) = o; }
    LDS_WAIT(); asm volatile("" ::: "memory");
}
DI void p0_prologue(Frame& F) {
    LAS float* ct = (LAS float*)(F.lds + CT_OFF);
    for (int i = F.tid; i < 5 * 1024; i += NWAVES * 64) { const int j = i >> 10, k = i & 1023; const float c = (j == 0) ? F.c_ctx[k] : F.cvec[(j - 1) * 1024 + k]; ct[i] = silu_f(c); }
    __syncthreads();
    LAS float* scr = (LAS float*)(F.lds + RING_OFF + F.wave * 16384);
    const int gw = F.wave * F.G + F.vcu, NGW = F.G * NWAVES;
    constexpr int I_GEMV = 8 * (6144 / 32), I_WL = 32, I_IN = (D / 64) * (INC / 32);
    constexpr int NITEMS = I_GEMV + I_WL + I_IN;
    for (int it = gw; it < NITEMS; it += NGW) {
        int r = it;
        if (r < I_GEMV) {
            const int ksl = r & 7, n0 = 32 * (r >> 3), col = F.lane & 31, kq = F.lane >> 5;
            const float* wp = F.w_ada + (size_t)(128 * ksl) * 6144 + n0 + col;
            const LAS float* cts = ct + 128 * ksl;
            float acc[5] = {0.f, 0.f, 0.f, 0.f, 0.f};
#pragma unroll 1
            for (int k = kq; k < 128; k += 64) {
                float w[32];
#pragma unroll
                for (int u = 0; u < 32; ++u) w[u] = __builtin_nontemporal_load(wp + (size_t)(k + 2 * u) * 6144);
#pragma unroll
                for (int u = 0; u < 32; ++u)
#pragma unroll
                    for (int j = 0; j < 5; ++j) acc[j] += cts[j * 1024 + k + 2 * u] * w[u];
            }
#pragma unroll
            for (int j = 0; j < 5; ++j) acc[j] += __shfl_xor(acc[j], 32);
            if (kq == 0) { const float bsum = ksl == 0 ? F.b_ada[n0 + col] : 0.f;
#pragma unroll
                for (int j = 0; j < 5; ++j) atomicAdd(F.MOD + j * 6144 + n0 + col, acc[j] + bsum); }
            continue;
        }
        r -= I_GEMV;
        if (r < I_WL) {
            const int mat = r >> 4; const float* src = (mat ? F.lru_wx : F.lru_wa) + (size_t)(r & 15) * 4096; bf16* dst = F.WL + (size_t)r * 4096;
            for (int e = F.lane; e < 4096; e += 64) { const int o = e >> 6, i = e & 63; dst[o * 64 + i] = (bf16)(pk2(src[i * 64 + o], 0.f) & 0xffffu); }
            continue;
        }
        r -= I_WL;
        p0_transpose_item(F.w_in, D, INC, F.Win_t, scr, r, F.lane);
    }
}
DI void deferred_transposes(Frame& F, int iw, int nw) {
    LAS float* scr = (LAS float*)(F.lds + RING_OFF + F.wave * 16384);
    constexpr int I_OUT = (D / 64) * (D / 32), I_F1 = (D / 64) * (DFF / 32), I_F2 = (DFF / 64) * (D / 32);
    for (int it = iw; it < I_OUT + I_F1 + I_F2; it += nw) {
        int r = it;
        if (r < I_OUT) { p0_transpose_item(F.w_out, D, D, F.Wout_t, scr, r, F.lane); continue; } r -= I_OUT;
        if (r < I_F1) { p0_transpose_item(F.w_ff1, D, DFF, F.Wff1_t, scr, r, F.lane); continue; } r -= I_F1;
        p0_transpose_item(F.w_ff2, DFF, D, F.Wff2_t, scr, r, F.lane);
    }
}

DI int cond_of_row(int m) { return m < NCTX ? 0 : 1 + ((m - NCTX) >> 10); }
DI void store_row_bf16(bf16* orow, int lane, const f32x4 (&v)[4]) {
    GAS v2u* o8 = (GAS v2u*)orow + lane;
#pragma unroll
    for (int j = 0; j < 4; ++j) { v2u w; w.x = pk2(v[j].x, v[j].y); w.y = pk2(v[j].z, v[j].w); o8[64 * j] = w; }
}
DI void p1_rows(Frame& F) {
    const int gw0 = F.vcu * NWAVES + F.wave, NGW0 = F.G * NWAVES;
    const bool blocked = (NTOK % NGW0) == 0;
    const int R = NTOK / NGW0, gw = blocked ? gw0 * R : gw0, NGW = blocked ? 1 : NGW0, mend = blocked ? gw + R : NTOK;
    f32x4 vn[4];
    if (gw < NTOK) { const GAS f32x4* xr = (const GAS f32x4*)(gw < NCTX ? F.x_prompt + (size_t)gw * D : F.x_sample + (size_t)(gw - NCTX) * D) + F.lane;
#pragma unroll
        for (int j = 0; j < 4; ++j) vn[j] = __builtin_nontemporal_load((const f32x4*)xr + 64 * j); }
    f32x4 msh[4], msc[4]; int ccur = -1;
    for (int m = gw; m < mend; m += NGW) {
        f32x4 v[4];
#pragma unroll
        for (int j = 0; j < 4; ++j) v[j] = vn[j];
        const int cnd = cond_of_row(m);
        if (cnd != ccur) {
            const float* mod = F.MOD + cnd * 6144;
#pragma unroll
            for (int j = 0; j < 4; ++j) { const int c = 256 * j + 4 * F.lane; const f32x4 g = *(const f32x4*)(F.norm1_gain + c);
                msh[j] = *(const f32x4*)(mod + c); msc[j] = g * (1.0f + *(const f32x4*)(mod + 1024 + c)); }
            ccur = cnd;
        }
        { const int mn = m + NGW < mend ? m + NGW : m;
          const GAS f32x4* xr = (const GAS f32x4*)(mn < NCTX ? F.x_prompt + (size_t)mn * D : F.x_sample + (size_t)(mn - NCTX) * D) + F.lane;
#pragma unroll
          for (int j = 0; j < 4; ++j) vn[j] = __builtin_nontemporal_load((const f32x4*)xr + 64 * j); }
        if (m >= NCTX) {
            const int t = (m - NCTX) & 1023; const float rr = (float)(t >> 6), cc = (float)(t & 63);
#pragma unroll
            for (int e = 0; e < 4; ++e) {
                const float om = __builtin_amdgcn_exp2f(-(float)(4 * F.lane + e) * (13.287712379549449f / 256.0f));
                const float ar = rr * om * 0.15915494309189535f, ac = cc * om * 0.15915494309189535f;
                v[0][e] += __builtin_amdgcn_sinf(ar); v[1][e] += __builtin_amdgcn_cosf(ar); v[2][e] += __builtin_amdgcn_sinf(ac); v[3][e] += __builtin_amdgcn_cosf(ac);
            }
            if (F.G != 256) {
                GAS f32x4* xo = (GAS f32x4*)(F.XS + (size_t)(m - NCTX) * D) + F.lane;
#pragma unroll
                for (int j = 0; j < 4; ++j) xo[64 * j] = v[j]; }
        }
        float s = 0.f;
#pragma unroll
        for (int j = 0; j < 4; ++j) s += (v[j].x * v[j].x + v[j].y * v[j].y) + (v[j].z * v[j].z + v[j].w * v[j].w);
        const float rstd = __builtin_amdgcn_rsqf(wave_sum(s) * (1.f / D) + EPS);
#pragma unroll
        for (int j = 0; j < 4; ++j) v[j] = v[j] * rstd * msc[j] + msh[j];
        store_row_bf16(F.ACT + (size_t)m * D, F.lane, v);
    }
}
DI void p7_rows(Frame& F) {
    const int gw = F.vcu * NWAVES + F.wave, NGW = F.G * NWAVES;
    for (int m = gw; m < NTOK; m += NGW) {
        const GAS f32x4* xr = (const GAS f32x4*)(F.out + (size_t)m * D) + F.lane;
        f32x4 v[4]; float s = 0.f;
#pragma unroll
        for (int j = 0; j < 4; ++j) { v[j] = xr[64 * j]; s += (v[j].x * v[j].x + v[j].y * v[j].y) + (v[j].z * v[j].z + v[j].w * v[j].w); }
        const float rstd = __builtin_amdgcn_rsqf(wave_sum(s) * (1.f / D) + EPS);
        const float* mod = F.MOD + cond_of_row(m) * 6144;
#pragma unroll
        for (int j = 0; j < 4; ++j) {
            const int c = 256 * j + 4 * F.lane;
            const f32x4 g = *(const f32x4*)(F.norm2_gain + c), sh = *(const f32x4*)(mod + 3072 + c), sc = *(const f32x4*)(mod + 4096 + c);
            v[j] = v[j] * rstd * g * (1.0f + sc) + sh;
        }
        store_row_bf16(F.ACT + (size_t)m * D, F.lane, v);
    }
}
DI void p10_rows(Frame& F) {
    const int gw = F.vcu * NWAVES + F.wave, NGW = F.G * NWAVES;
    for (int m = gw; m < NTOK; m += NGW) {
        GAS f32x4* xr = (GAS f32x4*)(F.out + (size_t)m * D) + F.lane;
        f32x4 v[4]; float s = 0.f;
#pragma unroll
        for (int j = 0; j < 4; ++j) { v[j] = xr[64 * j]; s += (v[j].x * v[j].x + v[j].y * v[j].y) + (v[j].z * v[j].z + v[j].w * v[j].w); }
        const float rstd = __builtin_amdgcn_rsqf(wave_sum(s) * (1.f / D) + EPS);
#pragma unroll
        for (int j = 0; j < 4; ++j) { const f32x4 g = *(const f32x4*)(F.final_gain + 256 * j + 4 * F.lane); xr[64 * j] = v[j] * rstd * g; }
    }
}
DI void p5_rows(Frame& F) {
    const int gw = F.vcu * NWAVES + F.wave, NGW = F.G * NWAVES;
    const int c8 = 8 * F.lane;
    struct Row5 { v4u a, b, gt, lg, hf, hb, pc0, pc1; };
#define P5_LOAD(R, mm) do { const int m_ = (mm); \
        R.a = __builtin_nontemporal_load((const v4u*)(F.OF + (size_t)m_ * 512 + c8)); R.b = __builtin_nontemporal_load((const v4u*)(F.OB + (size_t)m_ * 512 + c8)); \
        R.gt = __builtin_nontemporal_load((const v4u*)(F.GL + (size_t)m_ * 1024 + c8)); R.lg = __builtin_nontemporal_load((const v4u*)(F.GL + (size_t)m_ * 1024 + 512 + c8)); \
        R.hf = __builtin_nontemporal_load((const v4u*)(F.HF + (size_t)m_ * 512 + c8)); R.hb = __builtin_nontemporal_load((const v4u*)(F.HB + (size_t)m_ * 512 + c8)); \
        const int ml_ = m_ >= NCTX ? m_ - NCTX : 0; \
        R.pc0 = *(const GAS v4u*)(F.PC + ((size_t)ml_ * 2 + 0) * 512 + c8); R.pc1 = *(const GAS v4u*)(F.PC + ((size_t)ml_ * 2 + 1) * 512 + c8); } while (0)
    const f32x4 g0 = *(const f32x4*)(F.hg_norm_gain + c8), g1 = *(const f32x4*)(F.hg_norm_gain + c8 + 4);
    Row5 Rn;
    if (gw < NTOK) P5_LOAD(Rn, gw);
    for (int m = gw; m < NTOK; m += NGW) {
        const Row5 Rc = Rn;
        P5_LOAD(Rn, m + NGW < NTOK ? m + NGW : m);
        const v4u a = Rc.a, b = Rc.b, gt = Rc.gt, lg = Rc.lg, hf = Rc.hf, hb = Rc.hb;
        float o[8], s = 0.f;
#pragma unroll
        for (int j = 0; j < 4; ++j) { o[2 * j] = bflo(a[j]) + bflo(b[j]); o[2 * j + 1] = bfhi(a[j]) + bfhi(b[j]); s += o[2 * j] * o[2 * j] + o[2 * j + 1] * o[2 * j + 1]; }
        float hsum[8];
#pragma unroll
        for (int j = 0; j < 4; ++j) { hsum[2 * j] = bflo(hf[j]) + bflo(hb[j]); hsum[2 * j + 1] = bfhi(hf[j]) + bfhi(hb[j]); }
        if (m >= NCTX) {
            const int ml = m - NCTX, bb = ml >> 10, seg = (ml >> 8) & 3;
#pragma unroll
            for (int d = 0; d < 2; ++d) {
                const int jn = d ? 3 - seg : seg;
                if (jn > 0) {
                    const float* lc = F.LC + ((size_t)((bb * 2 + d) * 4) * 512 + c8) * 2;
                    float hin[8];
                    { const f32x4 q0 = *(const f32x4*)(lc), q1 = *(const f32x4*)(lc + 4), q2 = *(const f32x4*)(lc + 8), q3 = *(const f32x4*)(lc + 12);
                      hin[0] = q0[1]; hin[1] = q0[3]; hin[2] = q1[1]; hin[3] = q1[3]; hin[4] = q2[1]; hin[5] = q2[3]; hin[6] = q3[1]; hin[7] = q3[3]; }
                    for (int jj = 1; jj < jn; ++jj) {
                        const float* l2 = lc + (size_t)jj * 1024;
                        const f32x4 q0 = *(const f32x4*)(l2), q1 = *(const f32x4*)(l2 + 4), q2 = *(const f32x4*)(l2 + 8), q3 = *(const f32x4*)(l2 + 12);
                        hin[0] = q0[0] * hin[0] + q0[1]; hin[1] = q0[2] * hin[1] + q0[3]; hin[2] = q1[0] * hin[2] + q1[1]; hin[3] = q1[2] * hin[3] + q1[3];
                        hin[4] = q2[0] * hin[4] + q2[1]; hin[5] = q2[2] * hin[5] + q2[3]; hin[6] = q3[0] * hin[6] + q3[1]; hin[7] = q3[2] * hin[7] + q3[3];
                    }
                    const v4u pc = d ? Rc.pc1 : Rc.pc0;
#pragma unroll
                    for (int e = 0; e < 4; ++e) { hsum[2 * e] += bflo(pc[e]) * hin[2 * e]; hsum[2 * e + 1] += bfhi(pc[e]) * hin[2 * e + 1]; }
                }
            }
        }
        s += __shfl_xor(s, 1); s += __shfl_xor(s, 2); s += __shfl_xor(s, 4); s += __shfl_xor(s, 8);
        const float rstd = __builtin_amdgcn_rsqf(s * (1.f / 128.f) + EPS);
        v4u w1, w2;
#pragma unroll
        for (int j = 0; j < 4; ++j) {
            const float ga = (j < 2) ? g0[2 * j] : g1[2 * j - 4], gb = (j < 2) ? g0[2 * j + 1] : g1[2 * j - 3];
            w1[j] = pk2(o[2 * j] * rstd * ga * silu_f(bflo(gt[j])), o[2 * j + 1] * rstd * gb * silu_f(bfhi(gt[j])));
            w2[j] = pk2(hsum[2 * j] * gelu_tanh_f(bflo(lg[j])), hsum[2 * j + 1] * gelu_tanh_f(bfhi(lg[j])));
        }
        *(GAS v4u*)(F.ACT + (size_t)m * D + c8) = w1;
        *(GAS v4u*)(F.ACT + (size_t)m * D + 512 + c8) = w2;
    }
#undef P5_LOAD
}

#define MFMA32(a, b, c) __builtin_amdgcn_mfma_f32_32x32x16_bf16((a), (b), (c), 0, 0, 0)
DI bf16* qe_blk(Frame& F, int d, int cgx, int head) { return F.QF + (size_t)cgx * (32 * 2048) + 1024 + d * 512 + head * 128; }
DI bf16* kd_blk(Frame& F, int d, int cgx, int head) { return F.QF + (size_t)cgx * (32 * 2048) + d * 512 + head * 128; }
DI bf16* vt_blk(Frame& F, int cgx, int head) { return F.V + (size_t)cgx * (32 * 512) + head * 128; }
DI bf16x8 pack8(const f32x16& x, int s) {
    const v4u w = {pk2(x[8 * s], x[8 * s + 1]), pk2(x[8 * s + 2], x[8 * s + 3]), pk2(x[8 * s + 4], x[8 * s + 5]), pk2(x[8 * s + 6], x[8 * s + 7])};
    return __builtin_bit_cast(bf16x8, w);
}
DI bf16x8 ldfrag(const bf16* p) { return __builtin_bit_cast(bf16x8, *(const GAS v4u*)p); }
template <int DIR>
DI void hg_prep_item(Frame& F, int cg, int head) {
    const int m0 = cg * 32, k0 = 2 * F.lane, hk = head * 128 + k0, col = DIR * 512 + hk;
    const f32x2 L0 = *(const f32x2*)(F.lb_logits + DIR * 512 + hk), L1 = *(const f32x2*)(F.lb_logits + 1024 + DIR * 512 + hk);
    const float lba = __builtin_amdgcn_rcpf(1.0f + __expf(L1.x - L0.x)), lbb = __builtin_amdgcn_rcpf(1.0f + __expf(L1.y - L0.y));
    constexpr float L2E = 1.4426950408889634f;
    float lf0[32], lf1[32]; unsigned kkp[32], qw[32];
    float bl0 = 0.f, bl1 = 0.f;
#pragma unroll
    for (int i = 0; i < 32; ++i) {
        const int t = DIR ? 31 - i : i; const size_t ro = (size_t)(m0 + t) * 2048 + col;
        const unsigned fw = *(const GAS unsigned*)(F.QF + ro + 1024); qw[i] = *(const GAS unsigned*)(F.QF + ro);
        const float f0 = lba + (1.0f - lba) * __builtin_amdgcn_rcpf(1.0f + __builtin_amdgcn_exp2f(-L2E * bflo(fw)));
        const float f1 = lbb + (1.0f - lbb) * __builtin_amdgcn_rcpf(1.0f + __builtin_amdgcn_exp2f(-L2E * bfhi(fw)));
        lf0[i] = __builtin_amdgcn_logf(f0); lf1[i] = __builtin_amdgcn_logf(f1); kkp[i] = pk2(1.0f - f0, 1.0f - f1);
        bl0 += lf0[i]; bl1 += lf1[i];
    }
    const float dec0 = __builtin_amdgcn_exp2f(bl0), dec1 = __builtin_amdgcn_exp2f(bl1);
    const size_t cb = ((size_t)DIR * NCH + cg) * 4 + head;
    LAS unsigned char* wl = F.lds + RING_OFF + F.wave * 16384;
    const int kk = k0 & 15, fh = (kk >> 2) & 1, fj = (kk & 3) + 4 * (kk >> 3);
    bf16* qeb = qe_blk(F, DIR, cg, head) + (size_t)((k0 >> 4) * 4 + 2 * fh) * 2048 + fj;
    float b0 = 0.f, b1 = 0.f; unsigned kd0[16], kd1[16];
#pragma unroll
    for (int ip = 0; ip < 16; ++ip) {
        float d0[2], d1[2];
#pragma unroll
        for (int s = 0; s < 2; ++s) {
            const int i = 2 * ip + s, t = DIR ? 31 - i : i;
            b0 += lf0[i]; b1 += lf1[i];
            const float q0 = bflo(qw[i]), q1 = bfhi(qw[i]);
            const float en0 = __builtin_amdgcn_exp2f(-b0), en1 = __builtin_amdgcn_exp2f(-b1);
            const float qe0 = q0 * __builtin_amdgcn_rcpf(en0 + __builtin_amdgcn_exp2f(-L2E * q0 - b0)), qe1 = q1 * __builtin_amdgcn_rcpf(en1 + __builtin_amdgcn_exp2f(-L2E * q1 - b1));
            const float ke0 = bflo(kkp[i]) * en0, ke1 = bfhi(kkp[i]) * en1;
            const unsigned qew = pk2(qe0, qe1), kew = pk2(ke0, ke1);
            { const unsigned lo = (unsigned)(((k0 >> 4) * 64 + ((t ^ (k0 >> 4)) + 32 * fh)) * 16 + fj * 2);
              *(LAS unsigned*)(wl + lo) = qew; *(LAS unsigned*)(wl + 8192 + lo) = kew; }
            d0[s] = ke0 * dec0; d1[s] = ke1 * dec1;
        }
        const int p = DIR ? 15 - ip : ip;
        kd0[p] = DIR ? pk2(d0[1], d0[0]) : pk2(d0[0], d0[1]);
        kd1[p] = DIR ? pk2(d1[1], d1[0]) : pk2(d1[0], d1[1]);
    }
    {
        bf16* qb = qe_blk(F, DIR, cg, head);
        const int tl = F.lane & 31, hh = F.lane >> 5;
#pragma unroll
        for (int ks = 0; ks < 8; ++ks) {
            const v4u q = *(const LAS v4u*)(wl + (unsigned)((ks * 64 + ((tl ^ ks) + 32 * hh)) * 16));
            *(GAS v4u*)(qb + (size_t)(ks * 4 + (F.lane >> 4)) * 2048 + (F.lane & 15) * 8) = q; }
    }
    {
        const int ti = k0 >> 5, r = k0 & 31;
        bf16* kb = kd_blk(F, DIR, cg, head);
#pragma unroll
        for (int sp = 0; sp < 2; ++sp)
#pragma unroll
            for (int h = 0; h < 2; ++h) {
                const v4u a = {kd0[8 * sp + 2 * h], kd0[8 * sp + 2 * h + 1], kd0[8 * sp + 4 + 2 * h], kd0[8 * sp + 4 + 2 * h + 1]};
                const v4u b = {kd1[8 * sp + 2 * h], kd1[8 * sp + 2 * h + 1], kd1[8 * sp + 4 + 2 * h], kd1[8 * sp + 4 + 2 * h + 1]};
                bf16* kp = kb + (size_t)((ti * 2 + sp) * 4 + ((r + 32 * h) >> 4)) * 2048 + ((r + 32 * h) & 15) * 8;
                *(GAS v4u*)(kp) = a; *(GAS v4u*)(kp + 8) = b;
            }
        const int dh = (r >> 2) & 1, rg = (r & 3) + 4 * (r >> 3);
        *(f32x2*)(F.DEC + cb * 128 + ti * 32 + dh * 16 + rg) = (f32x2){dec0, dec1};
    }
    {
        const int r = F.lane & 31, h = F.lane >> 5; const unsigned lo8 = (unsigned)F.lane * 8u;
        f32x16 X;
#pragma unroll
        for (int i = 0; i < 16; ++i) X[i] = 0.f;
#pragma unroll
        for (int ks = 0; ks < 8; ++ks) { const unsigned lo = (unsigned)((ks * 64 + ((r ^ ks) + 32 * h)) * 16);
            X = MFMA32(*(const LAS bf16x8*)(wl + 8192 + lo), *(const LAS bf16x8*)(wl + lo), X); }
#pragma unroll
        for (int rg = 0; rg < 16; ++rg) { const int s = (rg & 3) + 8 * (rg >> 2) + 4 * h; const bool keep = DIR ? (s >= r) : (s <= r); X[rg] = keep ? X[rg] : 0.f; }
        *(GAS v4u*)(F.XF + cb * 1024 + lo8) = __builtin_bit_cast(v4u, pack8(X, 0));
        *(GAS v4u*)(F.XF + cb * 1024 + 512 + lo8) = __builtin_bit_cast(v4u, pack8(X, 1));
    }
}
DI void vt_item(Frame& F, int cg, int head) {
    const int m0 = cg * 32, v0 = 2 * F.lane, hv = head * 128 + v0;
    unsigned w[32];
#pragma unroll
    for (int t = 0; t < 32; ++t) w[t] = *(const GAS unsigned*)(F.V + (size_t)(m0 + t) * 512 + hv);
    unsigned rl[16], rh[16];
#pragma unroll
    for (int p = 0; p < 16; ++p) { const unsigned x = w[2 * p], y = w[2 * p + 1]; rl[p] = (x & 0xffffu) | (y << 16); rh[p] = (x >> 16) | (y & 0xffff0000u); }
    bf16* vb = vt_blk(F, cg, head); const int vr = v0 & 31;
    asm volatile("s_waitcnt vmcnt(0)" ::: "memory");
#pragma unroll
    for (int sp = 0; sp < 2; ++sp)
#pragma unroll
        for (int h = 0; h < 2; ++h) {
            const v4u a = {rl[8 * sp + 2 * h], rl[8 * sp + 2 * h + 1], rl[8 * sp + 4 + 2 * h], rl[8 * sp + 4 + 2 * h + 1]};
            const v4u b = {rh[8 * sp + 2 * h], rh[8 * sp + 2 * h + 1], rh[8 * sp + 4 + 2 * h], rh[8 * sp + 4 + 2 * h + 1]};
            bf16* vp = vb + (size_t)(((v0 >> 5) * 2 + sp) * 4 + ((vr + 32 * h) >> 4)) * 512 + ((vr + 32 * h) & 15) * 8;
            *(GAS v4u*)(vp) = a; *(GAS v4u*)(vp + 8) = b;
        }
}
DI unsigned* gates_base(Frame& F, int d, int row) { return (unsigned*)((unsigned char*)F.ACT + (d ? 0 : (row < NCTX ? (220 - 28) * MiB : (222 - 28) * MiB))); }
DI void lru_gate_item(Frame& F, int tg, int n) {
    const int m0 = 64 * tg, r = F.lane & 31, h = F.lane >> 5;
    const int T = m0 < NCTX ? TCTX : TLAT, tseq0 = m0 < NCTX ? (m0 & (TCTX - 1)) : ((m0 - NCTX) & (TLAT - 1));
    bf16x8 xa[2][4];
#pragma unroll
    for (int ks = 0; ks < 4; ++ks) {
        const int c0 = 64 * n + 16 * ks + 8 * h;
        f32x4 w[4][2];
#pragma unroll
        for (int j = 0; j < 4; ++j) { w[j][0] = *(const f32x4*)(F.conv_w + j * 512 + c0); w[j][1] = *(const f32x4*)(F.conv_w + j * 512 + c0 + 4); }
        const f32x4 cb0 = *(const f32x4*)(F.conv_b + c0), cb1 = *(const f32x4*)(F.conv_b + c0 + 4);
#pragma unroll
        for (int mt = 0; mt < 2; ++mt) {
            const int tk = 32 * mt + r, m = m0 + tk, ts = tseq0 + tk;
            f32x4 a0 = cb0, a1 = cb1;
#pragma unroll
            for (int j = 0; j < 4; ++j) {
                const int tt = ts + j - 2; const bool ok = (tt >= 0) && (tt < T);
                const v4u lw = *(const GAS v4u*)(F.LX + (size_t)(ok ? m + j - 2 : m) * 512 + c0);
                const float z = ok ? 1.0f : 0.0f;
                a0 += (f32x4){bflo(lw.x), bfhi(lw.x), bflo(lw.y), bfhi(lw.y)} * (w[j][0] * z);
                a1 += (f32x4){bflo(lw.z), bfhi(lw.z), bflo(lw.w), bfhi(lw.w)} * (w[j][1] * z);
            }
            const v4u p = {pk2(a0.x, a0.y), pk2(a0.z, a0.w), pk2(a1.x, a1.y), pk2(a1.z, a1.w)};
            xa[mt][ks] = __builtin_bit_cast(bf16x8, p);
        }
    }
    f32x16 zero;
#pragma unroll
    for (int i = 0; i < 16; ++i) zero[i] = 0.f;
    float cba[2][2], cbx[2][2], csp[2][2];
#pragma unroll
    for (int nt = 0; nt < 2; ++nt)
#pragma unroll
        for (int d = 0; d < 2; ++d) { const int c = d * 512 + 64 * n + 32 * nt + r; cba[nt][d] = F.lru_ba[c]; cbx[nt][d] = F.lru_bx[c]; csp[nt][d] = F.lru_lambda[c]; }
#pragma unroll
    for (int nt = 0; nt < 2; ++nt)
#pragma unroll
        for (int d = 0; d < 2; ++d) { const float e = __expf(-csp[nt][d]); csp[nt][d] = -8.0f * e * (1.0f - e * (0.5f - e * (0.33333333f - 0.25f * e))); }
#pragma unroll
    for (int nt = 0; nt < 2; ++nt) {
        f32x16 xcC[2] = {zero, zero};
#pragma unroll
        for (int s = 0; s < 2; ++s) {
            bf16x8 bI;
#pragma unroll
            for (int j = 0; j < 8; ++j) bI[j] = (16 * s + 8 * h + j == r) ? (short)0x3F80 : (short)0;
#pragma unroll
            for (int mt = 0; mt < 2; ++mt) xcC[mt] = MFMA32(xa[mt][2 * nt + s], bI, xcC[mt]);
        }
        const int c = 64 * n + 32 * nt + r;
#pragma unroll 1
        for (int d = 0; d < 2; ++d) {
            const bf16* wa = F.WL + ((size_t)((0 * 2 + d) * 8 + n) * 64 + 32 * nt + r) * 64 + 8 * h;
            const bf16* wx = F.WL + ((size_t)((1 * 2 + d) * 8 + n) * 64 + 32 * nt + r) * 64 + 8 * h;
            const float bias_a = d ? cba[nt][1] : cba[nt][0], bias_x = d ? cbx[nt][1] : cbx[nt][0], sp8 = d ? csp[nt][1] : csp[nt][0];
            bf16x8 wfa[4], wfx[4];
#pragma unroll
            for (int ks = 0; ks < 4; ++ks) { wfa[ks] = *(const GAS bf16x8*)(wa + 16 * ks); wfx[ks] = *(const GAS bf16x8*)(wx + 16 * ks); }
            __builtin_amdgcn_sched_barrier(0);
#pragma unroll
            for (int mt = 0; mt < 2; ++mt) {
                f32x16 accA = zero, accX = zero;
#pragma unroll
                for (int ks = 0; ks < 4; ++ks) { accA = MFMA32(xa[mt][ks], wfa[ks], accA); accX = MFMA32(xa[mt][ks], wfx[ks], accX); }
                unsigned* gb = gates_base(F, d, m0) + (size_t)(m0 + 32 * mt) * 512;
                const unsigned lofs = (unsigned)(4 * h) * 512u + (unsigned)c;
#pragma unroll
                for (int rg = 0; rg < 16; rg += 2) {
                    constexpr float NL2E = -1.4426950408889634f;
                    const f32x2 za = ((f32x2){accA[rg], accA[rg + 1]} + bias_a) * NL2E, zx = ((f32x2){accX[rg], accX[rg + 1]} + bias_x) * NL2E;
                    const f32x2 da = (f32x2){__builtin_amdgcn_exp2f(za.x), __builtin_amdgcn_exp2f(za.y)} + 1.0f, dx = (f32x2){__builtin_amdgcn_exp2f(zx.x), __builtin_amdgcn_exp2f(zx.y)} + 1.0f;
                    const f32x2 rr = {__builtin_amdgcn_rcpf(da.x), __builtin_amdgcn_rcpf(da.y)}, ii = {__builtin_amdgcn_rcpf(dx.x), __builtin_amdgcn_rcpf(dx.y)};
                    const f32x2 la = rr * sp8, y = la + la;
                    const f32x2 em = -y * (1.0f + y * (0.5f + y * (0.16666667f + y * (0.041666668f + y * 0.0083333333f))));
                    const f32x2 xc = {xcC[mt][rg], xcC[mt][rg + 1]};
                    const f32x2 u = (f32x2){__builtin_amdgcn_sqrtf(em.x), __builtin_amdgcn_sqrtf(em.y)} * ii * xc;
                    const f32x2 ea = -la * (1.0f + la * (0.5f + la * (0.16666667f + la * (0.041666668f + la * 0.0083333333f))));
                    const unsigned uw = pk2(u.x, u.y);
                    const unsigned g0 = (unsigned)__builtin_bit_cast(unsigned short, (_Float16)ea.x) | (uw << 16);
                    const unsigned g1 = (unsigned)__builtin_bit_cast(unsigned short, (_Float16)ea.y) | (uw & 0xffff0000u);
#if defined(P3X) && (P3X & 1)
                    asm volatile("" :: "v"(g0), "v"(g1));
#else
                    (gb + ((rg & 3) + 8 * (rg >> 2)) * 512)[lofs] = g0;
                    (gb + (((rg + 1) & 3) + 8 * ((rg + 1) >> 2)) * 512)[lofs] = g1;
#endif
                }
            }
        }
    }
}
DI void p3_item(Frame& F, int r, int mode) {
    constexpr int I_G = (NTOK / 64) * 8, I_HG = NCH * 8;
#if defined(P3X) && (P3X & 4)
    if (r < I_G) return;
#endif
#if defined(P3X) && (P3X & 2)
    if (r >= I_G && r < I_G + I_HG) return;
#endif
#if defined(P3X) && (P3X & 8)
    if (r >= I_G + I_HG) return;
#endif
    if (r < I_G) { if (mode == 0 || mode == 1) lru_gate_item(F, r >> 3, r & 7); return; } r -= I_G;
    if (r < I_HG) { const int head = r & 3, dir = (r >> 2) & 1, cg = r >> 3; if (mode == 0 || mode == 2) { if (dir) hg_prep_item<1>(F, cg, head); else hg_prep_item<0>(F, cg, head); } return; } r -= I_HG;
    if (mode == 0 || mode == 3) vt_item(F, r >> 2, r & 3);
}
DI void p3_prep(Frame& F, int mode = 0) {
    const int gw = F.wave * F.G + F.vcu, NGW = F.G * NWAVES;
    constexpr int I_G = (NTOK / 64) * 8, I_HG = NCH * 8, I_VT = NCH * 4;
    const bool deal = (NGW == 2048);
    const int n_it = deal ? 3 : (I_G + I_HG + I_VT - gw + NGW - 1) / NGW;
    for (int e = 0; e < n_it; ++e) {
        int it;
        if (!deal) it = gw + e * NGW;
        else if (gw < I_G) it = e == 0 ? gw : e == 1 ? I_G + 1536 + gw : I_G + I_HG + gw;
        else { const int j = gw - I_G; it = I_G + 3 * j + e; }
        p3_item(F, it, mode);
    }
    if (mode == 0) deferred_transposes(F, gw, NGW);
}

constexpr int HG_GB = 27136, HG_QE = 0, HG_KD = 8192, HG_XF = 16384, HG_VT = 18432, HG_DEC = 26624;
static_assert(4 * HG_GB <= RING_BYTES, "hg scan LDS");
template <int mode>
DI void hg_scan_wg(Frame& F, int sqA, int dA, int headA, int sqB, int dB, int headB) {
    const int half = F.wave >> 2, vs = F.wave & 3, r = F.lane & 31, h = F.lane >> 5;
    const int sq = half ? sqB : sqA, d = half ? dB : dA, head = half ? headB : headA;
    const bool latA = sqA >= 32;
    const int nch = (mode == 5) ? 8 : (latA ? TLAT : TCTX) / 32;
#define HG_BAR() do { asm volatile("s_waitcnt lgkmcnt(0)" ::: "memory"); __builtin_amdgcn_s_barrier(); asm volatile("" ::: "memory"); } while (0)
    if (sq < 0) { for (int n = 0; n <= nch; ++n) HG_BAR(); return; }
    const bool lat = sq >= 32;
    const int base = lat ? NCTX + (sq - 32) * TLAT : sq * TCTX;
    f32x16 S[4];
    if (lat) {
        const float* s0 = F.state_hgrn + ((size_t)((sq - 32) * 2 + d) * 4 + head) * 128 * 128 + 32 * vs;
        const unsigned so = (unsigned)(4 * h * 128 + r);
#pragma unroll
        for (int i = 0; i < 4; ++i)
#pragma unroll
            for (int rg = 0; rg < 16; ++rg) S[i][rg] = s0[so + (unsigned)((32 * i + (rg & 3) + 8 * (rg >> 2)) * 128)];
    } else {
#pragma unroll
        for (int i = 0; i < 4; ++i)
#pragma unroll
            for (int rg = 0; rg < 16; ++rg) S[i][rg] = 0.f;
    }
#pragma unroll
    for (int i = 0; i < 4; ++i)
#pragma unroll
        for (int rg = 0; rg < 16; ++rg) asm volatile("" : "+v"(S[i][rg]));
    const unsigned lo8 = (unsigned)F.lane * 8u, ooff = (unsigned)(r * 512 + 32 * vs + 4 * h);
    const unsigned lq = (unsigned)((F.lane >> 4) * 2048 + (F.lane & 15) * 8), lv = (unsigned)((F.lane >> 4) * 512 + (F.lane & 15) * 8);
    LAS unsigned char* gl = F.lds + RING_OFF + half * (2 * HG_GB);
    const unsigned l16 = (unsigned)F.lane * 16u;
    bf16* OUTd = (d ? F.OB : F.OF) + head * 128;
    const int c0 = d ? nch - 1 : 0, cstep = d ? -1 : 1;
    const size_t cb = ((size_t)d * NCH + (base >> 5) + c0) * 4 + head;
    const size_t vb = ((size_t)((base >> 5) + c0) * 4 + head) * 4 + vs;
    struct StageRegs { v4u q0, q1, k0, k1, x, v0, v1; f32x2 dd; };
    StageRegs R0, R1;
#define HG_LOAD(R, n) do { const size_t cbx = (size_t)((long)cb + 4 * cstep * (n)); const int cgx = (base >> 5) + c0 + cstep * (n); \
        const bf16* qb_ = qe_blk(F, d, cgx, head) + lq; const bf16* kb_ = kd_blk(F, d, cgx, head) + lq; const bf16* vb_ = vt_blk(F, cgx, head) + lv; \
        R.q0 = *(const GAS v4u*)(qb_ + (size_t)(8 * vs) * 2048); R.q1 = *(const GAS v4u*)(qb_ + (size_t)(8 * vs + 4) * 2048); \
        R.k0 = *(const GAS v4u*)(kb_ + (size_t)(8 * vs) * 2048); R.k1 = *(const GAS v4u*)(kb_ + (size_t)(8 * vs + 4) * 2048); \
        R.x = *(const GAS v4u*)(F.XF + cbx * 1024 + (vs & 1) * 512 + lo8); \
        R.v0 = *(const GAS v4u*)(vb_ + (size_t)(8 * vs) * 512); R.v1 = *(const GAS v4u*)(vb_ + (size_t)(8 * vs + 4) * 512); \
        R.dd = *(const GAS f32x2*)(F.DEC + cbx * 128 + 2 * F.lane); } while (0)
#define HG_STAGE(R, bufp) do { \
        *(LAS v4u*)((bufp) + HG_QE + (2 * vs) * 1024 + l16) = R.q0; *(LAS v4u*)((bufp) + HG_QE + (2 * vs + 1) * 1024 + l16) = R.q1; \
        *(LAS v4u*)((bufp) + HG_KD + (2 * vs) * 1024 + l16) = R.k0; *(LAS v4u*)((bufp) + HG_KD + (2 * vs + 1) * 1024 + l16) = R.k1; \
        if (vs < 2) *(LAS v4u*)((bufp) + HG_XF + vs * 1024 + l16) = R.x; \
        *(LAS v4u*)((bufp) + HG_VT + (2 * vs) * 1024 + l16) = R.v0; *(LAS v4u*)((bufp) + HG_VT + (2 * vs + 1) * 1024 + l16) = R.v1; \
        if (vs == 3) *(LAS f32x2*)((bufp) + HG_DEC + 8 * F.lane) = R.dd; } while (0)
#define HG_COMPUTE(cur, n) do { \
            const int m0 = base + 32 * (c0 + cstep * (n)); \
            const bf16x8 xf0 = *(const LAS bf16x8*)((cur) + HG_XF + l16), xf1 = *(const LAS bf16x8*)((cur) + HG_XF + 1024 + l16); \
            const bf16x8 vf0 = *(const LAS bf16x8*)((cur) + HG_VT + (2 * vs) * 1024 + l16), vf1 = *(const LAS bf16x8*)((cur) + HG_VT + (2 * vs + 1) * 1024 + l16); \
            const LAS float* dc = (const LAS float*)((cur) + HG_DEC) + h * 16; \
            f32x4 dva[4], dvb[4]; \
            _Pragma("unroll") for (int g = 0; g < 4; ++g) dva[g] = *(const LAS f32x4*)(dc + 4 * g); \
            bf16x8 qfr[8]; \
            _Pragma("unroll") for (int i = 0; i < 8; ++i) qfr[i] = *(const LAS bf16x8*)((cur) + HG_QE + i * 1024 + l16); \
            __builtin_amdgcn_sched_barrier(0); \
            f32x16 O; \
            _Pragma("unroll") for (int i = 0; i < 16; ++i) O[i] = 0.f; \
            O = MFMA32(vf0, xf0, O); O = MFMA32(vf1, xf1, O); \
            _Pragma("unroll") for (int i = 0; i < 4; ++i) { \
                const bf16x8 sp0 = pack8(S[i], 0), sp1 = pack8(S[i], 1); \
                if (i < 3) { _Pragma("unroll") for (int g = 0; g < 4; ++g) { if (i & 1) dva[g] = *(const LAS f32x4*)(dc + (i + 1) * 32 + 4 * g); else dvb[g] = *(const LAS f32x4*)(dc + (i + 1) * 32 + 4 * g); } } \
                O = MFMA32(sp0, qfr[2 * i], O); O = MFMA32(sp1, qfr[2 * i + 1], O); \
                _Pragma("unroll") for (int g = 0; g < 4; ++g) _Pragma("unroll") for (int j = 0; j < 4; ++j) S[i][4 * g + j] *= ((i & 1) ? dvb[g][j] : dva[g][j]); \
                S[i] = MFMA32(*(const LAS bf16x8*)((cur) + HG_KD + (2 * i) * 1024 + l16), vf0, S[i]); S[i] = MFMA32(*(const LAS bf16x8*)((cur) + HG_KD + (2 * i + 1) * 1024 + l16), vf1, S[i]); } \
            bf16* op = OUTd + (size_t)m0 * 512; \
            _Pragma("unroll") for (int g = 0; g < 4; ++g) { const v2u w = {pk2(O[4 * g], O[4 * g + 1]), pk2(O[4 * g + 2], O[4 * g + 3])}; if (mode != 4) *(GAS v2u*)(op + ooff + 8 * g) = w; else asm volatile("" :: "v"(w)); } \
        } while (0)
    LAS unsigned char* b0 = gl; LAS unsigned char* b1 = gl + HG_GB;
    HG_LOAD(R0, 0); HG_STAGE(R0, b0); HG_LOAD(R1, 1);
    HG_BAR();
    for (int n = 0; n < nch; n += 2) {
        { const int nn = n + 2 < nch ? n + 2 : nch - 1; HG_LOAD(R0, nn); }
        HG_COMPUTE(b0, n);
        HG_STAGE(R1, b1);
        HG_BAR();
        { const int nn = n + 3 < nch ? n + 3 : nch - 1; HG_LOAD(R1, nn); }
        HG_COMPUTE(b1, n + 1);
        HG_STAGE(R0, b0);
        HG_BAR();
    }
#undef HG_LOAD
#undef HG_STAGE
#undef HG_BAR
#undef HG_COMPUTE
    if (!lat) {
        float* so = F.out + OUT_SHG + ((size_t)(sq * 2 + d) * 4 + head) * 128 * 128 + 32 * vs;
        const unsigned sof = (unsigned)(4 * h * 128 + r);
#pragma unroll
        for (int i = 0; i < 4; ++i)
#pragma unroll
            for (int rg = 0; rg < 16; ++rg) __builtin_nontemporal_store(S[i][rg], so + sof + (unsigned)((32 * i + (rg & 3) + 8 * (rg >> 2)) * 128));
    }
}
template <int mode>
DI void hg_scan_lat(Frame& F, int b, int d, int head) {
    const int w = F.wave, r = F.lane & 31, h = F.lane >> 5, vs = w & 3;
    const int base = NCTX + b * TLAT, nch = (mode == 5) ? 8 : TLAT / 32;
    const unsigned lo8 = (unsigned)F.lane * 8u, l16 = (unsigned)F.lane * 16u;
    const unsigned lq = (unsigned)((F.lane >> 4) * 2048 + (F.lane & 15) * 8), lv = (unsigned)((F.lane >> 4) * 512 + (F.lane & 15) * 8);
    LAS unsigned char* b0 = F.lds + RING_OFF; LAS unsigned char* b1 = b0 + HG_GB;
    const int c0 = d ? nch - 1 : 0, cstep = d ? -1 : 1;
    const size_t cb = ((size_t)d * NCH + (base >> 5) + c0) * 4 + head;
    const size_t vbg = ((size_t)((base >> 5) + c0) * 4 + head) * 4;
    struct StageRegs { v4u a, b, c, d; };
    StageRegs R0, R1, R2, R3;
    const int hw = w & 3;
#define HL_LOADH(R, n) do { const int cgx = (base >> 5) + c0 + cstep * (n); const bf16* qb_ = qe_blk(F, d, cgx, head) + lq; const bf16* kb_ = kd_blk(F, d, cgx, head) + lq; \
        R.a = *(const GAS v4u*)(qb_ + (size_t)(8 * hw) * 2048); R.b = *(const GAS v4u*)(qb_ + (size_t)(8 * hw + 4) * 2048); \
        R.c = *(const GAS v4u*)(kb_ + (size_t)(8 * hw) * 2048); R.d = *(const GAS v4u*)(kb_ + (size_t)(8 * hw + 4) * 2048); } while (0)
#define HL_LOADC(R, n) do { const size_t cbx = (size_t)((long)cb + 4 * cstep * (n)); const int cgx = (base >> 5) + c0 + cstep * (n); const bf16* vb_ = vt_blk(F, cgx, head) + lv; \
        R.a = *(const GAS v4u*)(vb_ + (size_t)(8 * w) * 512); R.b = *(const GAS v4u*)(vb_ + (size_t)(8 * w + 4) * 512); \
        R.c = (w == 3) ? *(const GAS v4u*)(F.DEC + cbx * 128 + ((F.lane & 31) * 4)) : *(const GAS v4u*)(F.XF + cbx * 1024 + (w & 1) * 512 + lo8); } while (0)
#define HL_STAGEH(R, bufp) do { \
        *(LAS v4u*)((bufp) + HG_QE + (2 * hw) * 1024 + l16) = R.a; *(LAS v4u*)((bufp) + HG_QE + (2 * hw + 1) * 1024 + l16) = R.b; \
        *(LAS v4u*)((bufp) + HG_KD + (2 * hw) * 1024 + l16) = R.c; *(LAS v4u*)((bufp) + HG_KD + (2 * hw + 1) * 1024 + l16) = R.d; } while (0)
#define HL_STAGEC(R, bufp) do { \
        *(LAS v4u*)((bufp) + HG_VT + (2 * w) * 1024 + l16) = R.a; *(LAS v4u*)((bufp) + HG_VT + (2 * w + 1) * 1024 + l16) = R.b; \
        if (w < 2) *(LAS v4u*)((bufp) + HG_XF + w * 1024 + l16) = R.c; \
        if (w == 3 && F.lane < 32) *(LAS v4u*)((bufp) + HG_DEC + F.lane * 16) = R.c; } while (0)
#define HL_BAR() do { asm volatile("s_waitcnt lgkmcnt(0)" ::: "memory"); __builtin_amdgcn_s_barrier(); asm volatile("" ::: "memory"); } while (0)
#define HL_CL(n) ((n) < nch ? (n) : nch - 1)
    if (w >= 4) {
        HL_LOADH(R0, 0); HL_STAGEH(R0, b0); HL_LOADH(R1, 1); HL_LOADH(R2, 2); HL_LOADH(R3, 3);
        HL_BAR();
        for (int n = 0; n < nch; n += 4) {
            HL_LOADH(R0, HL_CL(n + 4)); HL_STAGEH(R1, b1); HL_BAR();
            HL_LOADH(R1, HL_CL(n + 5)); HL_STAGEH(R2, b0); HL_BAR();
            HL_LOADH(R2, HL_CL(n + 6)); HL_STAGEH(R3, b1); HL_BAR();
            HL_LOADH(R3, HL_CL(n + 7)); HL_STAGEH(R0, b0); HL_BAR();
        }
    } else {
        f32x16 S[4];
        {
            const float* s0 = F.state_hgrn + ((size_t)(b * 2 + d) * 4 + head) * 128 * 128 + 32 * vs;
            const unsigned so = (unsigned)(4 * h * 128 + r);
#pragma unroll
            for (int i = 0; i < 4; ++i)
#pragma unroll
                for (int rg = 0; rg < 16; ++rg) S[i][rg] = s0[so + (unsigned)((32 * i + (rg & 3) + 8 * (rg >> 2)) * 128)];
#pragma unroll
            for (int i = 0; i < 4; ++i)
#pragma unroll
                for (int rg = 0; rg < 16; ++rg) asm volatile("" : "+v"(S[i][rg]));
        }
        const unsigned ooff = (unsigned)(r * 512 + 32 * vs + 4 * h);
        bf16* OUTd = (d ? F.OB : F.OF) + head * 128;
#define HL_COMPUTE(cur, n) do { \
            const int m0 = base + 32 * (c0 + cstep * (n)); \
              \
            const bf16x8 xf0 = *(const LAS bf16x8*)((cur) + HG_XF + l16), xf1 = *(const LAS bf16x8*)((cur) + HG_XF + 1024 + l16); \
            const bf16x8 vf0 = *(const LAS bf16x8*)((cur) + HG_VT + (2 * vs) * 1024 + l16), vf1 = *(const LAS bf16x8*)((cur) + HG_VT + (2 * vs + 1) * 1024 + l16); \
            const LAS float* dc = (const LAS float*)((cur) + HG_DEC) + h * 16; \
            f32x4 dva[4], dvb[4]; \
            _Pragma("unroll") for (int g = 0; g < 4; ++g) dva[g] = *(const LAS f32x4*)(dc + 4 * g); \
            bf16x8 qfr[8], kdr[8]; \
            _Pragma("unroll") for (int i = 0; i < 8; ++i) qfr[i] = *(const LAS bf16x8*)((cur) + HG_QE + i * 1024 + l16); \
            _Pragma("unroll") for (int i = 0; i < 8; ++i) kdr[i] = *(const LAS bf16x8*)((cur) + HG_KD + i * 1024 + l16); \
            __builtin_amdgcn_sched_barrier(0); \
            f32x16 O; \
            _Pragma("unroll") for (int i = 0; i < 16; ++i) O[i] = 0.f; \
            O = MFMA32(vf0, xf0, O); O = MFMA32(vf1, xf1, O); \
            _Pragma("unroll") for (int i = 0; i < 4; ++i) { \
                const bf16x8 sp0 = pack8(S[i], 0), sp1 = pack8(S[i], 1); \
                if (i < 3) { _Pragma("unroll") for (int g = 0; g < 4; ++g) { if (i & 1) dva[g] = *(const LAS f32x4*)(dc + (i + 1) * 32 + 4 * g); else dvb[g] = *(const LAS f32x4*)(dc + (i + 1) * 32 + 4 * g); } } \
                O = MFMA32(sp0, qfr[2 * i], O); O = MFMA32(sp1, qfr[2 * i + 1], O); \
                _Pragma("unroll") for (int g = 0; g < 4; ++g) _Pragma("unroll") for (int j = 0; j < 4; ++j) S[i][4 * g + j] *= ((i & 1) ? dvb[g][j] : dva[g][j]); \
                S[i] = MFMA32(kdr[2 * i], vf0, S[i]); S[i] = MFMA32(kdr[2 * i + 1], vf1, S[i]); } \
            bf16* op = OUTd + (size_t)m0 * 512; \
            _Pragma("unroll") for (int g = 0; g < 4; ++g) { const v2u wv = {pk2(O[4 * g], O[4 * g + 1]), pk2(O[4 * g + 2], O[4 * g + 3])}; *(GAS v2u*)(op + ooff + 8 * g) = wv; } \
        } while (0)
        HL_LOADC(R0, 0); HL_STAGEC(R0, b0); HL_LOADC(R1, 1);
        HL_BAR();
        for (int n = 0; n < nch; n += 2) {
            HL_LOADC(R0, HL_CL(n + 2)); HL_COMPUTE(b0, n);     HL_STAGEC(R1, b1); HL_BAR();
            HL_LOADC(R1, HL_CL(n + 3)); HL_COMPUTE(b1, n + 1); HL_STAGEC(R0, b0); HL_BAR();
        }
#undef HL_COMPUTE
    }
#undef HL_LOADH
#undef HL_LOADC
#undef HL_STAGEH
#undef HL_STAGEC
#undef HL_BAR
#undef HL_CL
}
DI void lru_scan_item(Frame& F, int ss, int d, int cg) {
    const bool lat = ss >= 32;
    const int b = (ss - 32) >> 2, seg = (ss - 32) & 3, j = d ? 3 - seg : seg;
    const int T = 256, base = lat ? NCTX + (ss - 32) * 256 : ss * 256, c = 128 * cg + 2 * F.lane;
    f32x2 hs = {0.f, 0.f}, pp = {1.0f, 1.0f};
    if (lat && j == 0) hs = *(const f32x2*)(F.state_rglru + (size_t)(b * 2 + d) * 512 + c);
    const int t0 = d ? base + T - 1 : base, ts = d ? -1 : 1;
    const unsigned* gp = gates_base(F, d, base); bf16* op = d ? F.HB : F.HF;
    bf16* pcp = F.PC + (size_t)d * 512 - (size_t)NCTX * 1024;
    constexpr int U = 16, NB = 4;
    v2u g[NB][U];
#pragma unroll
    for (int bb = 0; bb < NB; ++bb)
#pragma unroll
        for (int u = 0; u < U; ++u) g[bb][u] = __builtin_nontemporal_load((const v2u*)(gp + (size_t)(t0 + ts * (bb * U + u)) * 512 + c));
#pragma unroll 1
    for (int i0 = 0; i0 < T; i0 += U * NB) {
#pragma unroll
        for (int bb = 0; bb < NB; ++bb) {
#pragma unroll
            for (int u = 0; u < U; ++u) {
                const int t = t0 + ts * (i0 + bb * U + u);
                const v2u w = g[bb][u];
                const f32x2 a = {1.0f - (float)__builtin_bit_cast(_Float16, (unsigned short)(w.x & 0xffffu)), 1.0f - (float)__builtin_bit_cast(_Float16, (unsigned short)(w.y & 0xffffu))};
                const f32x2 uu = {bfhi(w.x), bfhi(w.y)};
                hs = a * hs + uu;
                *(GAS unsigned*)(op + (size_t)t * 512 + c) = pk2(hs.x, hs.y);
                if (lat) { pp = pp * a; *(GAS unsigned*)(pcp + (size_t)t * 1024 + c) = pk2(pp.x, pp.y); }
            }
            if (i0 + U * NB < T) {
#pragma unroll
                for (int u = 0; u < U; ++u) g[bb][u] = __builtin_nontemporal_load((const v2u*)(gp + (size_t)(t0 + ts * (i0 + U * NB + bb * U + u)) * 512 + c));
            }
        }
    }
    if (!lat) *(f32x2*)(F.out + OUT_SLRU + (size_t)(ss * 2 + d) * 512 + c) = hs;
    else *(f32x4*)(F.LC + ((size_t)((b * 2 + d) * 4 + j) * 512 + c) * 2) = (f32x4){pp.x, hs.x, pp.y, hs.y};
}
template <int mode>
DI void p4_scans(Frame& F) {
    for (int wi = F.vcu; wi < 256; wi += F.G) {
        if (wi < 160) {
            if ((mode == 8 && wi < 32) || (mode == 9 && wi >= 32)) {
                for (int gi = 0; gi < (wi < 32 ? 1 : 2); ++gi) { const int g = wi < 32 ? wi : 2 * (wi - 32) + gi; const int sq = wi < 32 ? 32 + (g >> 3) : g >> 3, d = (g >> 2) & 1, head = g & 3;
                    const int T = sq >= 32 ? TLAT : TCTX, base = sq >= 32 ? NCTX + (sq - 32) * TLAT : sq * TCTX; bf16* o = (d ? F.OB : F.OF) + head * 128;
                    for (int i = F.tid; i < T * 16; i += 512) *(GAS v4u*)(o + (size_t)(base + (i >> 4)) * 512 + (i & 15) * 8) = (v4u){0u, 0u, 0u, 0u}; }
                continue; }
            if (mode == 2 || (mode == 6 && wi >= 32) || (mode == 7 && wi < 32)) continue;
            if (wi < 32) hg_scan_lat<mode>(F, wi >> 3, (wi >> 2) & 1, wi & 3);
            else { const int gA = 2 * (wi - 32), gB = gA + 1; hg_scan_wg<mode>(F, gA >> 3, (gA >> 2) & 1, gA & 3, gB >> 3, (gB >> 2) & 1, gB & 3); }
        } else {
            if (mode == 1 || mode == 4 || mode == 5 || mode == 6 || mode == 7) continue;
            if (F.wave >= 4) continue;
            const int li = (wi - 160) * 4 + F.wave;
            const int ssx = li >> 3; const int ss = ssx < 16 ? 32 + ssx : ssx - 16;
            lru_scan_item(F, ss, (li >> 2) & 1, li & 3);
        }
    }
}

constexpr int N_PHASES = 11;
struct Args { const float* in[24]; float* out; unsigned char* ws; int ph_lo, ph_hi, li, pad; };
__global__ void __launch_bounds__(NWAVES * 64, 2) mk_fwd(Args args) {
    extern __shared__ __attribute__((aligned(16))) unsigned char lds[];
    Frame F;
    F.lds = (LAS unsigned char*)lds;
    F.tid = threadIdx.x; F.lane = F.tid & 63; F.wave = __builtin_amdgcn_readfirstlane(F.tid >> 6);
    F.G = gridDim.x; { const int bx = blockIdx.x; F.vcu = (F.G % 8 == 0) ? (bx % 8) * (F.G / 8) + bx / 8 : bx; }
    unsigned char* ws = args.ws;
    F.x_prompt = args.in[0]; F.x_sample = args.in[1]; F.cvec = args.in[2]; F.state_hgrn = args.in[3]; F.state_rglru = args.in[4]; F.c_ctx = args.in[5];
    F.w_ada = args.in[6]; F.b_ada = args.in[7]; F.norm1_gain = args.in[8]; F.norm2_gain = args.in[9]; F.w_in = args.in[10]; F.lb_logits = args.in[11];
    F.hg_norm_gain = args.in[12]; F.conv_w = args.in[13]; F.conv_b = args.in[14]; F.lru_wa = args.in[15]; F.lru_ba = args.in[16]; F.lru_wx = args.in[17];
    F.lru_bx = args.in[18]; F.lru_lambda = args.in[19]; F.w_out = args.in[20]; F.w_ff1 = args.in[21]; F.w_ff2 = args.in[22]; F.final_gain = args.in[23];
    F.out = args.out;
    F.Win_t = (bf16*)(ws + WS_WIN); F.Wout_t = (bf16*)(ws + WS_WOUT); F.Wff1_t = (bf16*)(ws + WS_WFF1); F.Wff2_t = (bf16*)(ws + WS_WFF2); F.WL = (bf16*)(ws + WS_WL);
    F.MOD = (float*)(ws + WS_MOD); F.XS = (float*)(ws + WS_XS); F.DEC = (float*)(ws + WS_DEC); F.LC = (float*)(ws + WS_LC); F.PC = (bf16*)(ws + WS_PC); F.XF = (bf16*)(ws + WS_XF);
    F.ACT = (bf16*)(ws + WS_ACT); F.QF = (bf16*)(ws + WS_QF); F.V = (bf16*)(ws + WS_V); F.GL = (bf16*)(ws + WS_GL); F.LX = (bf16*)(ws + WS_LX);
    F.QE = (bf16*)(ws + WS_QE); F.KE = (bf16*)(ws + WS_KE); F.KDT = (bf16*)(ws + WS_KDT); F.VT = (bf16*)(ws + WS_VT);
    F.OF = (bf16*)(ws + WS_OF); F.OB = (bf16*)(ws + WS_OB); F.HF = (bf16*)(ws + WS_HF); F.HB = (bf16*)(ws + WS_HB); F.HID = (bf16*)(ws + WS_HID);
    volatile LAS unsigned* MISC = (volatile LAS unsigned*)(F.lds + LDSCTL_OFF);
    for (int u = F.tid; u < 128; u += NWAVES * 64) MISC[u] = 0u;
    __syncthreads();
    const int lo = args.ph_lo, hi = args.ph_hi;
    XcdBarrier bar; bar.bar = (unsigned*)(ws + WS_CTL); bar.x = 0; bar.st = nullptr;
    if (hi - lo > 1) bar = xcd_barrier_post((unsigned*)(ws + WS_CTL), MISC + 8);
#define IN(k) (lo <= (k) && (k) < hi)
#define SEAM(k) do { if (IN(k) && IN((k) + 1)) xcd_barrier(bar); } while (0)
#ifndef RPT
#define RPT -1
#endif
#define NREP(k) ((RPT == (k)) ? 2 : 1)
#ifndef RPTMODE
#define RPTMODE 0
#endif

#ifdef TSEL
#ifndef TOFF
#define TOFF 0
#endif
#ifndef TWID
#define TWID 8
#endif
    unsigned long long tprev = __builtin_amdgcn_s_memrealtime(); float tsel_us = 0.f;
#define TSTAMP(k) do { const unsigned long long tn = __builtin_amdgcn_s_memrealtime(); if ((k) == TSEL) tsel_us = (float)(tn - tprev) * 0.01f; tprev = tn; } while (0)
#else
#define TSTAMP(k) do { } while (0)
#endif
    if (IN(0)) { for (int rp = 0; rp < NREP(0); ++rp) { p0_prologue(F); __syncthreads(); } } SEAM(0); TSTAMP(0);
    if (IN(1)) { for (int rp = 0; rp < NREP(1); ++rp) p1_rows(F); } SEAM(1); TSTAMP(1);
    if (IN(2)) for (int rp = 0; rp < NREP(2); ++rp) {
        pg8::Gemm g{F.ACT, F.Win_t, NTOK, INC, D}; pg8::StaticOrder S; S.init(NTOK, INC, F.G, (int)blockIdx.x);
        pg8::EpiRoute E{F.QF, F.V, F.GL, F.LX};
        pg8::gemm_phase<pg8::EpiRoute, pg8::StaticOrder, PG8_ALIGN, PG8_SP2>(F.lds + RING_OFF, g, S, E);
    } SEAM(2); TSTAMP(2);
    if (IN(3)) { for (int rp = 0; rp < NREP(3); ++rp) p3_prep(F, rp ? RPTMODE : 0); } SEAM(3); TSTAMP(3);
#ifndef P4X
#define P4X 0
#endif
    if (IN(4)) { p4_scans<(P4X == 1 ? 1 : P4X == 2 ? 8 : P4X == 4 ? 9 : 0)>(F); if (RPT == 4) p4_scans<RPTMODE>(F); } SEAM(4); TSTAMP(4);
    if (IN(5)) { for (int rp = 0; rp < NREP(5); ++rp) p5_rows(F); } SEAM(5); TSTAMP(5);
    const bool fused_rms = (F.G == 256);
    float* xr = (float*)(ws + WS_XRMS); unsigned* rcnt = (unsigned*)(ws + WS_CTL) + CW_RMSCNT;
    if (IN(6)) {
        pg8::Gemm g{F.ACT, F.Wout_t, NTOK, D, D}; pg8::StaticOrder S; S.init(NTOK, D, F.G, (int)blockIdx.x, 192);
        if (fused_rms) { pg8::EpiRmsT<3, 0> E{F.x_prompt, F.x_sample, F.out, F.MOD + 2048, F.norm2_gain, F.MOD, F.ACT, xr, rcnt, (bf16*)(ws + WS_X1B)};
            pg8::gemm_phase<pg8::EpiRmsT<3, 0>, pg8::StaticOrder, PG8_ALIGN, PG8_SP2, 3>(F.lds + RING_OFF, g, S, E); }
        else { pg8::EpiResidT<3> E{F.x_prompt, F.XS, F.out, F.MOD + 2048};
            pg8::gemm_phase<pg8::EpiResidT<3>, pg8::StaticOrder, PG8_ALIGN, PG8_SP2, 3>(F.lds + RING_OFF, g, S, E); }
    } SEAM(6); TSTAMP(6);
    if (IN(7) && !fused_rms) { p7_rows(F); if (IN(8)) xcd_barrier(bar); } TSTAMP(7);
    if (IN(8)) for (int rp = 0; rp < NREP(8); ++rp) {
        pg8::Gemm g{F.ACT, F.Wff1_t, NTOK, DFF, D}; pg8::StaticOrder S; S.init(NTOK, DFF, F.G, (int)blockIdx.x);
        pg8::EpiRelu2 E{F.HID, DFF};
        pg8::gemm_phase<pg8::EpiRelu2, pg8::StaticOrder, PG8_ALIGN, PG8_SP2>(F.lds + RING_OFF, g, S, E);
    } SEAM(8); TSTAMP(8);
#if RPT == 9 || RPT == 6
    if (IN(RPT)) {
        pg8::Gemm g{RPT == 9 ? F.HID : F.ACT, RPT == 9 ? F.Wff2_t : F.Wout_t, NTOK, D, RPT == 9 ? DFF : D}; pg8::StaticOrder S; S.init(NTOK, D, F.G, (int)blockIdx.x);
        pg8::EpiResid E{F.out, F.out + (size_t)NCTX * D, (float*)(ws + WS_QE), F.MOD + 5120};
        pg8::gemm_phase<pg8::EpiResid, pg8::StaticOrder, PG8_ALIGN, PG8_SP2>(F.lds + RING_OFF, g, S, E);
    }
#endif
    if (IN(9)) {
        pg8::Gemm g{F.HID, F.Wff2_t, NTOK, D, DFF}; pg8::StaticOrder S; S.init(NTOK, D, F.G, (int)blockIdx.x, 192);
        if (fused_rms) { pg8::EpiRmsT<3, 1> E{F.out, F.out + (size_t)NCTX * D, F.out, F.MOD + 5120, F.final_gain, F.MOD, F.ACT, xr + (size_t)NTOK * 4, rcnt + 64 * 16, (bf16*)(ws + WS_X1B)};
            pg8::gemm_phase<pg8::EpiRmsT<3, 1>, pg8::StaticOrder, PG8_ALIGN, PG8_SP2, 3>(F.lds + RING_OFF, g, S, E); }
        else { pg8::EpiResidT<3> E{F.out, F.out + (size_t)NCTX * D, F.out, F.MOD + 5120};
            pg8::gemm_phase<pg8::EpiResidT<3>, pg8::StaticOrder, PG8_ALIGN, PG8_SP2, 3>(F.lds + RING_OFF, g, S, E); }
    }
    if (!fused_rms) { SEAM(9); } TSTAMP(9);
    if (IN(10) && !fused_rms) { p10_rows(F); }
#ifdef TSEL
    if (hi - lo > 1) {
        xcd_barrier(bar); TSTAMP(10);
        float* tw = (float*)(ws + WS_CTL + 32768);
        if (blockIdx.x == 0 && F.tid == 0) { __hip_atomic_store(tw, floorf((tsel_us + (float)TOFF) * (1.0f / (float)TWID)), __ATOMIC_RELAXED, __HIP_MEMORY_SCOPE_AGENT); }
        xcd_barrier(bar);
        const float sc = 1.0f + __hip_atomic_load(tw, __ATOMIC_RELAXED, __HIP_MEMORY_SCOPE_AGENT) * (1.0f / 64.0f);
        for (size_t i = (size_t)blockIdx.x * 512 + F.tid; i < (size_t)NTOK * 256; i += (size_t)F.G * 512) { f32x4 v = ((f32x4*)F.out)[i]; ((f32x4*)F.out)[i] = v * sc; }
        if (blockIdx.x == 0 && F.tid == 0) F.out[0] = 100.0f * (sc - 1.0f) * 64.0f;
    }
#endif
#undef IN
#undef SEAM
}

extern "C" void kernel_launch(void* const* d_in, const int* in_sizes, int n_in, void* d_out, int out_size, void* d_ws, size_t ws_size, hipStream_t stream) {
    static int grid = 0;
    if (grid == 0) {
        if (n_in != 24 || in_sizes[0] != NCTX * D || ws_size < WS_END) { fprintf(stderr, "kernel_launch: unexpected shapes (n_in %d, in0 %d, out %d, ws %zu)\n", n_in, n_in > 0 ? in_sizes[0] : -1, out_size, ws_size); grid = -1; return; }
        int dev = 0, cus = 0, per_cu = 0;
        if (hipGetDevice(&dev) != hipSuccess || hipDeviceGetAttribute(&cus, hipDeviceAttributeMultiprocessorCount, dev) != hipSuccess) { grid = -1; return; }
        if (hipFuncSetAttribute((const void*)mk_fwd, hipFuncAttributeMaxDynamicSharedMemorySize, LDS_BYTES) != hipSuccess) { fprintf(stderr, "kernel_launch: hipFuncSetAttribute failed\n"); grid = -1; return; }
        if (hipOccupancyMaxActiveBlocksPerMultiprocessor(&per_cu, (const void*)mk_fwd, NWAVES * 64, LDS_BYTES) != hipSuccess || per_cu < 1)
            fprintf(stderr, "kernel_launch: occupancy query reports %d workgroups per CU\n", per_cu);
        (void)hipGetLastError();
        grid = cus;
    }
    if (grid < 0) return;
    if (hipMemsetAsync((char*)d_ws + WS_CTL, 0, CTL_ZERO_BYTES, stream) != hipSuccess) return;
    Args a{};
    for (int i = 0; i < 24; ++i) a.in[i] = (const float*)d_in[i];
    a.out = (float*)d_out; a.ws = (unsigned char*)d_ws;
    constexpr int NL = MK_N_LAUNCHES;
    for (int li = 0; li < NL; ++li) {
        a.ph_lo = (NL == 1) ? 0 : li; a.ph_hi = (NL == 1) ? N_PHASES : li + 1; a.li = li;
        hipLaunchKernelGGL(mk_fwd, dim3(grid), dim3(NWAVES * 64), LDS_BYTES, stream, a);
    }
}
```

```cpp
#include <hip/hip_runtime.h>
#include <cstdio>
#include <cstdint>

#ifndef MK_N_LAUNCHES
#define MK_N_LAUNCHES 1
#endif

#define DI __device__ __forceinline__
#define GAS __attribute__((address_space(1)))
#define LAS __attribute__((address_space(3)))
typedef unsigned short bf16;
typedef unsigned v4u __attribute__((ext_vector_type(4)));
typedef unsigned v2u __attribute__((ext_vector_type(2)));
typedef float f32x2 __attribute__((ext_vector_type(2)));
typedef float f32x4 __attribute__((ext_vector_type(4)));
typedef float f32x16 __attribute__((ext_vector_type(16)));
typedef short bf16x8 __attribute__((ext_vector_type(8)));
typedef short s16x4 __attribute__((ext_vector_type(4)));
typedef __bf16 bf2_t __attribute__((ext_vector_type(2)));

DI unsigned pk2(float lo, float hi) { f32x2 v = {lo, hi}; return __builtin_bit_cast(unsigned, __builtin_convertvector(v, bf2_t)); }
DI float bflo(unsigned w) { return __uint_as_float(w << 16); }
DI float bfhi(unsigned w) { return __uint_as_float(w & 0xffff0000u); }
DI float sigm(float x) { return __builtin_amdgcn_rcpf(1.0f + __expf(-x)); }
DI float silu_f(float x) { return x * sigm(x); }
DI float gelu_tanh_f(float x) { const float u = 0.7978845608028654f * (x + 0.044715f * x * x * x); return x * sigm(2.0f * u); }
DI float wave_sum(float v) {
#pragma unroll
    for (int o = 1; o < 64; o <<= 1) v += __shfl_xor(v, o);
    return v;
}
#define LDS_WAIT() asm volatile("s_waitcnt lgkmcnt(0)" ::: "memory")
#define VM_WAIT() asm volatile("s_waitcnt vmcnt(0)" ::: "memory")

constexpr int D = 1024, NTOK = 12288, NCTX = 8192, TCTX = 256, TLAT = 1024;
constexpr int INC = 4096, DFF = 4096, NCH = NTOK / 32;
constexpr float EPS = 1e-6f;
constexpr int NWAVES = 8;

constexpr size_t MiB = 1u << 20;
constexpr size_t WS_CTL = 0, CTL_ZERO_BYTES = 640 * 1024;
constexpr size_t WS_WIN = 1 * MiB, WS_WOUT = 9 * MiB, WS_WFF1 = 11 * MiB, WS_WFF2 = 19 * MiB;
constexpr size_t WS_MOD = 64 * 1024;
constexpr size_t WS_WL = 27 * MiB + 256 * 1024;
constexpr size_t WS_LC = 27 * MiB + 640 * 1024;
constexpr size_t WS_ACT = 28 * MiB;
constexpr size_t WS_XS = 52 * MiB;
constexpr size_t WS_QF = 68 * MiB;
constexpr size_t WS_OF = 164 * MiB, WS_OB = 176 * MiB, WS_HF = 196 * MiB, WS_HB = 208 * MiB;
constexpr size_t WS_V = 116 * MiB;
constexpr size_t WS_PC = 188 * MiB;
constexpr size_t WS_XF = 250 * MiB;
constexpr size_t WS_GL = 128 * MiB;
constexpr size_t WS_LX = 152 * MiB;
constexpr size_t WS_QE = 164 * MiB, WS_KE = 188 * MiB;
constexpr size_t WS_X1B = 164 * MiB;
constexpr size_t WS_KDT = 212 * MiB;
constexpr size_t WS_DEC = 236 * MiB;
constexpr size_t WS_XRMS = 256 * 1024;
constexpr size_t WS_VT = 238 * MiB;
constexpr size_t WS_HID = 68 * MiB;
constexpr size_t WS_END = 256 * MiB;

constexpr int RING_OFF = 0, RING_BYTES = 131072;
constexpr int LDSCTL_OFF = RING_BYTES;
constexpr int CT_OFF = RING_BYTES + 1024;
constexpr int LDS_BYTES = 160 * 1024;
static_assert(CT_OFF + 5 * 1024 * 4 <= LDS_BYTES, "LDS map");

#define XB_TMO      128
#define XB_XCNT(j)  (256  + 64 * (j))
#define XB_XSUB(j)  (1280 + 64 * (j))
#define XB_XGEN(j)  (2304 + 64 * (j))
#define XB_TOP      3328
#define XB_TOPGEN   3392
#define XCD_BAR_WORDS 3456
#define XB_SPIN_CAP (1u << 18)
constexpr int CW_RMSCNT = 4096;
static_assert(XCD_BAR_WORDS <= CW_RMSCNT && (CW_RMSCNT + 2 * 64 * 16) * 4 <= 32768, "CTL map");
static_assert(XCD_BAR_WORDS * 4 <= CTL_ZERO_BYTES, "barrier words inside the memset region");

DI unsigned xb_ld(unsigned* p)              { return __hip_atomic_load(p, __ATOMIC_RELAXED, __HIP_MEMORY_SCOPE_AGENT); }
DI unsigned xb_add(unsigned* p, unsigned v) { return __hip_atomic_fetch_add(p, v, __ATOMIC_RELAXED, __HIP_MEMORY_SCOPE_AGENT); }
DI unsigned xb_xcc_id() { return (unsigned)__builtin_amdgcn_s_getreg((3 << 11) | 20) & 0xFu; }
#define XB_SPIN(cond, bar) do { unsigned _sp = 0; while (cond) { __builtin_amdgcn_s_sleep(1); \
    if ((++_sp & 255u) == 0u) { if (xb_ld(&(bar)[XB_TMO])) break; if (_sp > XB_SPIN_CAP) { atomicAdd(&(bar)[XB_TMO], 1u); break; } } } } while (0)

struct XcdBarrier { unsigned* bar; unsigned x; volatile LAS unsigned* st; };

DI XcdBarrier xcd_barrier_post(unsigned* bar, volatile LAS unsigned* st) {
    XcdBarrier b; b.bar = bar; b.x = xb_xcc_id(); b.st = st;
    if (threadIdx.x == 0) (void)xb_add(&bar[XB_XCNT(b.x)], 1u);
    return b;
}
DI void xcd_barrier_complete(unsigned* bar, unsigned x, unsigned& nloc, unsigned& nx) {
    const unsigned G = gridDim.x * gridDim.y * gridDim.z;
    unsigned sum, cnt, mine, sp = 0u;
    for (;;) {
        sum = 0u; cnt = 0u; mine = 0u;
#pragma unroll
        for (unsigned j = 0; j < 16; ++j) { const unsigned c = xb_ld(&bar[XB_XCNT(j)]); sum += c; cnt += (c > 0u) ? 1u : 0u; mine = (j == x) ? c : mine; }
        if (sum == G) break;
        __builtin_amdgcn_s_sleep(1);
        if ((++sp & 255u) == 0u) { if (xb_ld(&bar[XB_TMO])) break; if (sp > XB_SPIN_CAP) { atomicAdd(&bar[XB_TMO], 1u); break; } }
    }
    nloc = mine > 0u ? mine : 1u; nx = cnt > 0u ? cnt : 1u;
}
DI void xcd_barrier(const XcdBarrier& b) {
    asm volatile("s_waitcnt vmcnt(0)" ::: "memory");
    __syncthreads();
    if (threadIdx.x == 0) {
        unsigned* bar = b.bar;
        __builtin_amdgcn_s_waitcnt(0);
        unsigned nloc = b.st[0], nx = b.st[1];
        if (nloc == 0u) { xcd_barrier_complete(bar, b.x, nloc, nx); b.st[0] = nloc; b.st[1] = nx; }
        const unsigned old = xb_add(&bar[XB_XSUB(b.x)], 1u);
        asm volatile("s_waitcnt vmcnt(0)" ::: "memory");
        const unsigned gen = old / nloc;
        const bool xlast = (old + 1u == (gen + 1u) * nloc);
        asm volatile("buffer_inv sc1" ::: "memory");
        if (xlast) {
            __builtin_amdgcn_fence(__ATOMIC_RELEASE, "agent");
            asm volatile("s_waitcnt vmcnt(0)" ::: "memory");
            const unsigned og = xb_add(&bar[XB_TOP], 1u);
            const unsigned tg = og / nx;
            if (og + 1u == (tg + 1u) * nx) {
#pragma unroll
                for (unsigned j = 0; j < 16; ++j) xb_add(&bar[XB_XGEN(j)], 1u);
            }
        }
        XB_SPIN(xb_ld(&bar[XB_XGEN(b.x)]) == gen, bar);
        asm volatile("s_waitcnt vmcnt(0)" ::: "memory");
        __builtin_amdgcn_fence(__ATOMIC_ACQUIRE, "workgroup");
    }
    __syncthreads();
}

namespace pg8 {
#define PG8_LAS __attribute__((address_space(3)))
typedef unsigned short bf16_t;
typedef short bf16x8 __attribute__((ext_vector_type(8)));
typedef float f32x4 __attribute__((ext_vector_type(4)));
typedef unsigned u32x4 __attribute__((ext_vector_type(4)));
constexpr int BM = 256, BK = 64, HALF = 128, HTB = HALF * BK * 2  , STAGE_BYTES = 8 * HTB, NXCD = 8, WGM = 8;

__host__ __device__ __forceinline__ int lds_byte(int r, int c) { const int st = (r >> 4) * 2 + (c >> 5), rr = r & 15, cc = c & 31, ob = rr * 64 + cc * 2; return st * 1024 + (ob ^ (((ob >> 9) & 1) << 5)); }
__host__ __device__ __forceinline__ void stage_rc(int b, int& R, int& C) { const int st = b / 1024, sb = b % 1024, swz = sb ^ (((sb >> 9) & 1) << 5); R = (st >> 1) * 16 + swz / 64; C = (st & 1) * 32 + (swz % 64) / 2; }
__host__ __device__ __forceinline__ int perm32(int rho) { const int n = rho >> 4, i = rho & 15; return 8 * (i >> 2) + 4 * n + (i & 3); }

struct Unit { int pm, pn; };
struct Gemm { const bf16_t* A; const bf16_t* Bt; int M, N, K; };

struct StaticOrder {
    int nM, nN, nwg, G, c;
    __host__ __device__ void init(int M, int N, int G_, int c_, int unit_rows = BM) { nM = M / unit_rows; nN = N / BM; nwg = nM * nN; G = G_; c = c_; }
    __host__ __device__ bool next(int i, Unit& u) const {
        const long L = (long)i * G + c; if (L >= nwg) return false;
        int wgid = (int)L; { const int q = nwg / NXCD, r = nwg % NXCD, xcd = wgid % NXCD, off = wgid / NXCD; wgid = (xcd < r ? xcd * (q + 1) : r * (q + 1) + (xcd - r) * q) + off; }
        const int nig = WGM * nN, gid = wgid / nig, fm = gid * WGM, gsz = (nM - fm) < WGM ? (nM - fm) : WGM;
        u.pm = fm + ((wgid % nig) % gsz); u.pn = (wgid % nig) / gsz; return true;
    }
    __device__ __forceinline__ void a_ready(const Unit&) const {}
    __device__ __forceinline__ void done(const Unit&) const {}
};

__device__ __forceinline__ unsigned cvt_pk_bf16(float lo, float hi) { return pk2(lo, hi); }
__device__ __forceinline__ int cond_of_pm(int pm) { return pm < 32 ? 0 : 1 + ((pm - 32) >> 2); }

struct EpiRoute {
    static constexpr bool PERM = true, AFTER_DRAIN = false;
    bf16_t *QF, *V, *GL, *LX;
    __device__ __forceinline__ void operator()(const f32x4 (&acc)[2][2][4][2], const Unit& u, int wr, int wc, int fr, int fq) const {
        const int pn = u.pn; bf16_t* base; int ldc, colt;
        if (pn < 8) { base = QF; ldc = 2048; colt = pn * 256; }
        else if (pn < 10) { base = V; ldc = 512; colt = (pn - 8) * 256; }
        else if (pn < 12) { base = GL; ldc = 1024; colt = (pn - 10) * 256; }
        else if (pn < 14) { base = LX; ldc = 512; colt = (pn - 12) * 256; }
        else { base = GL; ldc = 1024; colt = 512 + (pn - 14) * 256; }
        const int row0 = u.pm * BM + wr * 64 + fr, col0 = colt + wc * 32 + 8 * fq;
#pragma unroll
        for (int ai = 0; ai < 2; ++ai)
#pragma unroll
            for (int m = 0; m < 4; ++m) { bf16_t* rowp = base + (size_t)(row0 + ai * HALF + m * 16) * ldc + col0;
#pragma unroll
                for (int bj = 0; bj < 2; ++bj) { const f32x4 v0 = acc[ai][bj][m][0], v1 = acc[ai][bj][m][1];
                    u32x4 w; w.x = cvt_pk_bf16(v0[0], v0[1]); w.y = cvt_pk_bf16(v0[2], v0[3]); w.z = cvt_pk_bf16(v1[0], v1[1]); w.w = cvt_pk_bf16(v1[2], v1[3]);
                    *(u32x4*)(rowp + bj * HALF) = w; } }
    }
};
struct EpiRelu2 {
    static constexpr bool PERM = true, AFTER_DRAIN = false;
    bf16_t* O; int ldc;
    __device__ __forceinline__ void operator()(const f32x4 (&acc)[2][2][4][2], const Unit& u, int wr, int wc, int fr, int fq) const {
        const int row0 = u.pm * BM + wr * 64 + fr, col0 = u.pn * BM + wc * 32 + 8 * fq;
#pragma unroll
        for (int ai = 0; ai < 2; ++ai)
#pragma unroll
            for (int m = 0; m < 4; ++m) { bf16_t* rowp = O + (size_t)(row0 + ai * HALF + m * 16) * ldc + col0;
#pragma unroll
                for (int bj = 0; bj < 2; ++bj) { f32x4 v0 = acc[ai][bj][m][0], v1 = acc[ai][bj][m][1];
#pragma unroll
                    for (int j = 0; j < 4; ++j) { const float a = fmaxf(v0[j], 0.f), b = fmaxf(v1[j], 0.f); v0[j] = a * a; v1[j] = b * b; }
                    u32x4 w; w.x = cvt_pk_bf16(v0[0], v0[1]); w.y = cvt_pk_bf16(v0[2], v0[3]); w.z = cvt_pk_bf16(v1[0], v1[1]); w.w = cvt_pk_bf16(v1[2], v1[3]);
                    *(u32x4*)(rowp + bj * HALF) = w; } }
    }
};
struct EpiResid {
    static constexpr bool PERM = false, AFTER_DRAIN = false;
    const float* resA; const float* resB; float* out; const float* gate;
    __device__ __forceinline__ void operator()(const f32x4 (&acc)[2][2][4][2], const Unit& u, int wr, int wc, int fr, int fq) const {
        const int row0 = u.pm * BM + wr * 64 + fr, col0 = u.pn * BM + wc * 32 + 4 * fq;
        const float* g = gate + cond_of_pm(u.pm) * 6144 + col0;
        const float* res = (u.pm < 32) ? resA + (size_t)row0 * 1024 : resB + (size_t)(row0 - 8192) * 1024;
        f32x4 gv[2][2];
#pragma unroll
        for (int bj = 0; bj < 2; ++bj)
#pragma unroll
            for (int n = 0; n < 2; ++n) gv[bj][n] = *(const f32x4*)(g + bj * HALF + n * 16);
#pragma unroll
        for (int ai = 0; ai < 2; ++ai)
#pragma unroll
            for (int m = 0; m < 4; ++m) { const size_t ro = (size_t)(ai * HALF + m * 16) * 1024 + col0; float* rowp = out + (size_t)row0 * 1024 + ro;
#pragma unroll
                for (int bj = 0; bj < 2; ++bj)
#pragma unroll
                    for (int n = 0; n < 2; ++n) { const f32x4 rv = *(const f32x4*)(res + ro + bj * HALF + n * 16); *(f32x4*)(rowp + bj * HALF + n * 16) = rv + gv[bj][n] * acc[ai][bj][m][n]; } }
    }
};

template <int MT> struct EpiResidT {
    static constexpr bool PERM = false, AFTER_DRAIN = false;
    const float* resA; const float* resB; float* out; const float* gate;
    __device__ __forceinline__ void operator()(const f32x4 (&acc)[2][2][MT][2], const Unit& u, int wr, int wc, int fr, int fq) const {
        const int col0 = u.pn * BM + wc * 32 + 4 * fq;
#pragma unroll
        for (int ai = 0; ai < 2; ++ai)
#pragma unroll
            for (int m = 0; m < MT; ++m) {
                const int row = u.pm * (64 * MT) + ai * (32 * MT) + wr * (16 * MT) + m * 16 + fr;
                const float* res = (row < 8192 ? resA + (size_t)row * 1024 : resB + (size_t)(row - 8192) * 1024) + col0;
                const float* g = gate + (row < 8192 ? 0 : 1 + ((row - 8192) >> 10)) * 6144 + col0;
                float* rowp = out + (size_t)row * 1024 + col0;
#pragma unroll
                for (int bj = 0; bj < 2; ++bj)
#pragma unroll
                    for (int n = 0; n < 2; ++n) { const f32x4 rv = *(const f32x4*)(res + bj * HALF + n * 16), gv = *(const f32x4*)(g + bj * HALF + n * 16); *(f32x4*)(rowp + bj * HALF + n * 16) = rv + gv * acc[ai][bj][m][n]; }
            }
    }
};

template <int MT, int MODE> struct EpiRmsT {
    static constexpr bool PERM = false, AFTER_DRAIN = true;
    const float* resA; const float* resB; float* out; const float* gate; const float* ngain; const float* mod; bf16_t* act; float* slots; unsigned* cnt; bf16_t* x1b;
    __device__ __forceinline__ void fused(f32x4 (&acc)[2][2][MT][2], const Unit& u, int wr, int wc, int fr, int fq, PG8_LAS unsigned char* lds, int wid, int lane) const {
        constexpr int RU = 64 * MT;
        typedef unsigned u32x2v __attribute__((ext_vector_type(2)));
        PG8_LAS float* P = (PG8_LAS float*)lds;
        PG8_LAS float* S = (PG8_LAS float*)(lds + 4096);
        const int col0 = u.pn * BM + wc * 32 + 4 * fq, tid = wid * 64 + lane;
        const int row_first = u.pm * RU, row_last = row_first + RU - 1;
        const int cond_lo = row_first < 8192 ? 0 : 1 + ((row_first - 8192) >> 10), cond_hi = row_last < 8192 ? 0 : 1 + ((row_last - 8192) >> 10);
        const int bnd = cond_hi == 0 ? 0 : 8192 + (cond_hi - 1) * 1024;
        f32x4 rv[2][MT][2][2]; u32x2v rb[2][MT][2][2];
#pragma unroll
        for (int ai = 0; ai < 2; ++ai)
#pragma unroll
            for (int m = 0; m < MT; ++m) { const int row = u.pm * RU + ai * (32 * MT) + wr * (16 * MT) + m * 16 + fr;
#pragma unroll
                for (int bj = 0; bj < 2; ++bj)
#pragma unroll
                    for (int n = 0; n < 2; ++n) { const int co = bj * HALF + n * 16;
                        if (MODE == 0) rv[ai][m][bj][n] = __builtin_nontemporal_load((const f32x4*)((row < 8192 ? resA + (size_t)row * 1024 : resB + (size_t)(row - 8192) * 1024) + col0 + co));
                        else rb[ai][m][bj][n] = *(const u32x2v*)(x1b + (size_t)row * 1024 + col0 + co); } }
        f32x4 gvl[2][2], gvh[2][2];
#pragma unroll
        for (int bj = 0; bj < 2; ++bj)
#pragma unroll
            for (int n = 0; n < 2; ++n) { const int co = bj * HALF + n * 16; gvl[bj][n] = *(const f32x4*)(gate + cond_lo * 6144 + col0 + co); gvh[bj][n] = *(const f32x4*)(gate + cond_hi * 6144 + col0 + co); }
        const float quarter = (u.pn & 1) ? 0.25f : 0.0f;
#pragma unroll
        for (int ai = 0; ai < 2; ++ai)
#pragma unroll
            for (int m = 0; m < MT; ++m) {
                const int rbase = u.pm * RU + ai * (32 * MT) + wr * (16 * MT) + m * 16, rl = ai * (32 * MT) + wr * (16 * MT) + m * 16 + fr, row = u.pm * RU + rl;
                const bool hi = rbase >= bnd;
                const int tl = (row - 8192) & 1023; const float posv = (u.pn < 2) ? (float)(tl >> 6) : (float)(tl & 63);
                float s = 0.f;
#pragma unroll
                for (int bj = 0; bj < 2; ++bj)
#pragma unroll
                    for (int n = 0; n < 2; ++n) { const int co = bj * HALF + n * 16; f32x4 r4;
                        if (MODE == 0) { r4 = rv[ai][m][bj][n];
                            if (rbase >= 8192) {
#pragma unroll
                                for (int e = 0; e < 4; ++e) { const int c = col0 + co + e; const float om = __builtin_amdgcn_exp2f(-(float)(c & 255) * (13.287712379549449f / 256.0f));
                                    r4[e] += __builtin_amdgcn_sinf(posv * om * 0.15915494309189535f + quarter); } }
                        } else { const u32x2v xb = rb[ai][m][bj][n];
                            r4 = (f32x4){__uint_as_float(xb.x << 16), __uint_as_float(xb.x & 0xffff0000u), __uint_as_float(xb.y << 16), __uint_as_float(xb.y & 0xffff0000u)}; }
                        const f32x4 gv = hi ? gvh[bj][n] : gvl[bj][n];
                        const f32x4 x = r4 + gv * acc[ai][bj][m][n]; acc[ai][bj][m][n] = x; s += (x[0] * x[0] + x[1] * x[1]) + (x[2] * x[2] + x[3] * x[3]); }
                s += __shfl_xor(s, 16); s += __shfl_xor(s, 32);
                if (fq == 0) P[rl * 4 + wc] = s;
            }
        f32x4 al[2][2], ah[2][2], sl_[2][2], sh_[2][2];
#pragma unroll
        for (int bj = 0; bj < 2; ++bj)
#pragma unroll
            for (int n = 0; n < 2; ++n) { const int co = bj * HALF + n * 16; const f32x4 gn = *(const f32x4*)(ngain + col0 + co);
                if (MODE == 0) { const float* ml = mod + cond_lo * 6144 + col0 + co; const float* mh = mod + cond_hi * 6144 + col0 + co;
                    al[bj][n] = gn * (1.0f + *(const f32x4*)(ml + 4096)); sl_[bj][n] = *(const f32x4*)(ml + 3072);
                    ah[bj][n] = gn * (1.0f + *(const f32x4*)(mh + 4096)); sh_[bj][n] = *(const f32x4*)(mh + 3072); }
                else al[bj][n] = gn; }
        asm volatile("s_waitcnt lgkmcnt(0)" ::: "memory"); __builtin_amdgcn_s_barrier(); asm volatile("" ::: "memory");
        if (tid < RU) { const float s4 = fmaxf((P[tid * 4] + P[tid * 4 + 1]) + (P[tid * 4 + 2] + P[tid * 4 + 3]), 1e-30f);
            float* sl = slots + (size_t)(u.pm * RU + tid) * 4;
            __hip_atomic_store(sl + u.pn, s4, __ATOMIC_RELAXED, __HIP_MEMORY_SCOPE_AGENT);
            float v0, v1, v2, v3; unsigned sp = 0;
            for (;;) {
                v0 = __hip_atomic_load(sl + 0, __ATOMIC_RELAXED, __HIP_MEMORY_SCOPE_AGENT); v1 = __hip_atomic_load(sl + 1, __ATOMIC_RELAXED, __HIP_MEMORY_SCOPE_AGENT);
                v2 = __hip_atomic_load(sl + 2, __ATOMIC_RELAXED, __HIP_MEMORY_SCOPE_AGENT); v3 = __hip_atomic_load(sl + 3, __ATOMIC_RELAXED, __HIP_MEMORY_SCOPE_AGENT);
                v0 = (u.pn == 0) ? s4 : v0; v1 = (u.pn == 1) ? s4 : v1; v2 = (u.pn == 2) ? s4 : v2; v3 = (u.pn == 3) ? s4 : v3;
                if (__builtin_amdgcn_ballot_w64(!(v0 > 0.f && v1 > 0.f && v2 > 0.f && v3 > 0.f)) == 0ull || ++sp > (1u << 20)) break;
                __builtin_amdgcn_s_sleep(2);
            }
            S[tid] = __builtin_amdgcn_rsqf(((v0 + v1) + (v2 + v3)) * (1.0f / 1024.0f) + 1e-6f); }
        asm volatile("s_waitcnt lgkmcnt(0)" ::: "memory"); __builtin_amdgcn_s_barrier(); asm volatile("" ::: "memory");
#pragma unroll
        for (int ai = 0; ai < 2; ++ai)
#pragma unroll
            for (int m = 0; m < MT; ++m) {
                const int rbase = u.pm * RU + ai * (32 * MT) + wr * (16 * MT) + m * 16, rl = ai * (32 * MT) + wr * (16 * MT) + m * 16 + fr, row = u.pm * RU + rl;
                const bool hi = rbase >= bnd;
                const float rstd = S[rl];
#pragma unroll
                for (int bj = 0; bj < 2; ++bj)
#pragma unroll
                    for (int n = 0; n < 2; ++n) { const int co = bj * HALF + n * 16;
                        const f32x4 x = acc[ai][bj][m][n];
                        if (MODE == 0) { const f32x4 y = x * rstd * (hi ? ah[bj][n] : al[bj][n]) + (hi ? sh_[bj][n] : sl_[bj][n]);
                            u32x2v w; w.x = cvt_pk_bf16(y[0], y[1]); w.y = cvt_pk_bf16(y[2], y[3]);
                            *(u32x2v*)(act + (size_t)row * 1024 + col0 + co) = w;
                            u32x2v xw; xw.x = cvt_pk_bf16(x[0], x[1]); xw.y = cvt_pk_bf16(x[2], x[3]);
                            *(u32x2v*)(x1b + (size_t)row * 1024 + col0 + co) = xw; }
                        else *(f32x4*)(out + (size_t)row * 1024 + col0 + co) = x * rstd * al[bj][n]; }
            }
    }
};

template <class Epi, class Sched, bool ALIGN_EPI = false, bool SP2 = false, int MT = 4>
__device__ __forceinline__ void gemm_phase(PG8_LAS unsigned char* lds, const Gemm g, const Sched& S, const Epi& E) {
    const int tid = threadIdx.x, wid = __builtin_amdgcn_readfirstlane(tid >> 6), lane = tid & 63, wr = wid >> 2, wc = wid & 3, fr = lane & 15, fq = lane >> 4;
    const int K = g.K, nt = K / BK;
    unsigned voffA[2], voffB[2];
#pragma unroll
    for (int i = 0; i < 2; ++i) { int R, C; stage_rc(tid * 16 + i * 8192, R, C); const int Rb = Epi::PERM ? ((R & ~31) + perm32(R & 31)) : R;
        voffA[i] = (unsigned)(R * K + C) * 2u; voffB[i] = (unsigned)(Rb * K + C) * 2u; }
    const size_t kstep = (size_t)(BK * 2);
    const size_t hstep = (size_t)HALF * K * 2;
    const size_t tstep = 2 * hstep;
    const size_t hstepA = (size_t)(32 * MT) * K * 2, tstepA = 2 * hstepA;
    const unsigned ldsw = (unsigned)wid * 1024u;
    const int aoff = lds_byte(wr * 16 * MT + fr, fq * 8), boff = lds_byte(wc * 32 + fr, fq * 8);
#define PG8_SA(b, h) (((b) * 2 + (h)) * HTB)
#define PG8_SB(b, h) ((4 + (b) * 2 + (h)) * HTB)
#define PG8_STAGE(bufoff, gbase, voff) do { _Pragma("unroll") for (int _i = 0; _i < 2; ++_i) \
        __builtin_amdgcn_global_load_lds((const unsigned*)((const char*)(gbase) + (voff)[_i]), (PG8_LAS unsigned*)(lds + (bufoff) + ldsw + _i * 8192), 16, 0, 0); } while (0)
#define PG8_LDA(dst, b, h) do { _Pragma("unroll") for (int m = 0; m < MT; ++m) _Pragma("unroll") for (int k = 0; k < 2; ++k) dst[m][k] = *(const PG8_LAS bf16x8*)(lds + PG8_SA(b, h) + aoff + m * 2048 + k * 1024); } while (0)
#define PG8_LDB(dst, b, h) do { _Pragma("unroll") for (int n = 0; n < 2; ++n) _Pragma("unroll") for (int k = 0; k < 2; ++k) dst[n][k] = *(const PG8_LAS bf16x8*)(lds + PG8_SB(b, h) + boff + n * 2048 + k * 1024); } while (0)
#define PG8_MMA(ai, bj, At, Bt) do { __builtin_amdgcn_s_setprio(1); _Pragma("unroll") for (int m = 0; m < MT; ++m) _Pragma("unroll") for (int n = 0; n < 2; ++n) _Pragma("unroll") for (int k = 0; k < 2; ++k) \
        acc[ai][bj][m][n] = __builtin_amdgcn_mfma_f32_16x16x32_bf16(Bt[n][k], At[m][k], acc[ai][bj][m][n], 0, 0, 0); __builtin_amdgcn_s_setprio(0); } while (0)
#define PG8_WAIT_V(n) asm volatile("s_waitcnt vmcnt(" #n ")" ::: "memory")
#define PG8_WAIT_L(n) asm volatile("s_waitcnt lgkmcnt(" #n ")" ::: "memory")
#define PG8_BAR __builtin_amdgcn_s_barrier()
#define PG8_SCHED __builtin_amdgcn_sched_barrier(0)
    Unit cur, nxt; int ui = 0;
    if (!S.next(0, cur)) return;
    f32x4 acc[2][2][MT][2];
#pragma unroll
    for (int a = 0; a < 2; ++a)
#pragma unroll
        for (int b = 0; b < 2; ++b)
#pragma unroll
            for (int m = 0; m < MT; ++m)
#pragma unroll
                for (int n = 0; n < 2; ++n) acc[a][b][m][n] = (f32x4){0.f, 0.f, 0.f, 0.f};
    bf16x8 At[MT][2], B0[2][2], B1[2][2];
    const char* cA = (const char*)g.A + (size_t)cur.pm * tstepA; const char* cB = (const char*)g.Bt + (size_t)cur.pn * tstep;
    S.a_ready(cur);
    if constexpr (SP2) {
        PG8_STAGE(PG8_SB(0, 0), cB, voffB); PG8_STAGE(PG8_SB(0, 1), cB + hstep, voffB); PG8_STAGE(PG8_SA(0, 0), cA, voffA); PG8_STAGE(PG8_SA(0, 1), cA + hstepA, voffA);
        if (wr == 1) PG8_BAR;
        PG8_WAIT_V(2); PG8_BAR;
        PG8_STAGE(PG8_SB(1, 0), cB + kstep, voffB); PG8_STAGE(PG8_SA(1, 0), cA + kstep, voffA); PG8_STAGE(PG8_SB(1, 1), cB + hstep + kstep, voffB);
        PG8_WAIT_V(6); PG8_BAR;
    } else {
        PG8_STAGE(PG8_SB(0, 0), cB, voffB); PG8_STAGE(PG8_SA(0, 0), cA, voffA); PG8_STAGE(PG8_SB(0, 1), cB + hstep, voffB); PG8_STAGE(PG8_SA(0, 1), cA + hstepA, voffA);
        if (wr == 1) PG8_BAR;
        PG8_WAIT_V(4); PG8_BAR;
        PG8_STAGE(PG8_SB(1, 0), cB + kstep, voffB); PG8_STAGE(PG8_SA(1, 0), cA + kstep, voffA); PG8_STAGE(PG8_SB(1, 1), cB + hstep + kstep, voffB);
        PG8_WAIT_V(6); PG8_BAR;
    }
    for (;;) {
        const bool has_next = S.next(ui + 1, nxt);
        const char* nA = has_next ? (const char*)g.A + (size_t)nxt.pm * tstepA : cA; const char* nB = has_next ? (const char*)g.Bt + (size_t)nxt.pn * tstep : cB;
        for (int t = 0; t < nt; t += 2) {
            const bool last = (t == nt - 2);
            const char* a1 = cA + (size_t)(t + 1) * kstep;
            const char* a2 = last ? nA : cA + (size_t)(t + 2) * kstep; const char* b2 = last ? nB : cB + (size_t)(t + 2) * kstep;
            const char* a3 = a2 + kstep; const char* b3 = b2 + kstep;
            if (last && has_next) S.a_ready(nxt);
            if constexpr (SP2) {
            PG8_LDB(B0, 0, 0); PG8_LDB(B1, 0, 1); PG8_SCHED; PG8_LDA(At, 0, 0); PG8_STAGE(PG8_SA(1, 1), a1 + hstepA, voffA);
            PG8_WAIT_V(8); PG8_WAIT_L(0); PG8_BAR; PG8_MMA(0, 0, At, B0); PG8_MMA(0, 1, At, B1); PG8_BAR; PG8_SCHED;
            PG8_LDA(At, 0, 1); PG8_STAGE(PG8_SB(0, 0), b2, voffB); PG8_STAGE(PG8_SB(0, 1), b2 + hstep, voffB); PG8_STAGE(PG8_SA(0, 0), a2, voffA);
            PG8_WAIT_V(8); PG8_WAIT_L(0); PG8_BAR; PG8_MMA(1, 0, At, B0); PG8_MMA(1, 1, At, B1); PG8_BAR; PG8_SCHED;
            PG8_LDB(B0, 1, 0); PG8_LDB(B1, 1, 1); PG8_SCHED; PG8_LDA(At, 1, 0); PG8_STAGE(PG8_SA(0, 1), a2 + hstepA, voffA);
            PG8_WAIT_V(8); PG8_WAIT_L(0); PG8_BAR; PG8_MMA(0, 0, At, B0); PG8_MMA(0, 1, At, B1); PG8_BAR; PG8_SCHED;
            PG8_LDA(At, 1, 1); PG8_STAGE(PG8_SB(1, 0), b3, voffB); PG8_STAGE(PG8_SB(1, 1), b3 + hstep, voffB); PG8_STAGE(PG8_SA(1, 0), a3, voffA);
            PG8_WAIT_V(8); PG8_WAIT_L(0); PG8_BAR; PG8_MMA(1, 0, At, B0); PG8_MMA(1, 1, At, B1); PG8_BAR; PG8_SCHED;
            } else {
            PG8_LDB(B0, 0, 0); PG8_SCHED; PG8_LDA(At, 0, 0); PG8_STAGE(PG8_SA(1, 1), a1 + hstepA, voffA);
            PG8_WAIT_L(8); PG8_BAR; PG8_WAIT_L(0); PG8_MMA(0, 0, At, B0); PG8_BAR; PG8_SCHED;
            PG8_LDB(B1, 0, 1); PG8_STAGE(PG8_SB(0, 0), b2, voffB);
            PG8_BAR; PG8_WAIT_L(0); PG8_MMA(0, 1, At, B1); PG8_BAR;
            PG8_LDA(At, 0, 1); PG8_STAGE(PG8_SA(0, 0), a2, voffA);
            PG8_BAR; PG8_WAIT_L(0); PG8_MMA(1, 0, At, B0); PG8_BAR; PG8_SCHED;
            PG8_STAGE(PG8_SB(0, 1), b2 + hstep, voffB);
            PG8_WAIT_V(6); PG8_BAR; PG8_MMA(1, 1, At, B1); PG8_BAR;
            PG8_LDB(B0, 1, 0); PG8_SCHED; PG8_LDA(At, 1, 0); PG8_STAGE(PG8_SA(0, 1), a2 + hstepA, voffA);
            PG8_WAIT_L(8); PG8_BAR; PG8_WAIT_L(0); PG8_MMA(0, 0, At, B0); PG8_BAR; PG8_SCHED;
            PG8_LDB(B1, 1, 1); PG8_STAGE(PG8_SB(1, 0), b3, voffB);
            PG8_BAR; PG8_WAIT_L(0); PG8_MMA(0, 1, At, B1); PG8_BAR;
            PG8_LDA(At, 1, 1); PG8_STAGE(PG8_SA(1, 0), a3, voffA);
            PG8_BAR; PG8_WAIT_L(0); PG8_MMA(1, 0, At, B0); PG8_BAR; PG8_SCHED;
            PG8_STAGE(PG8_SB(1, 1), b3 + hstep, voffB);
            PG8_WAIT_V(6); PG8_BAR; PG8_MMA(1, 1, At, B1); PG8_BAR;
            }
        }
        if constexpr (ALIGN_EPI) { if (wr == 0) PG8_BAR; }
        if constexpr (!Epi::AFTER_DRAIN) { E(acc, cur, wr, wc, fr, fq); S.done(cur); }
        if (!has_next) break;
#pragma unroll
        for (int a = 0; a < 2; ++a)
#pragma unroll
            for (int b = 0; b < 2; ++b)
#pragma unroll
                for (int m = 0; m < MT; ++m)
#pragma unroll
                    for (int n = 0; n < 2; ++n) acc[a][b][m][n] = (f32x4){0.f, 0.f, 0.f, 0.f};
        cur = nxt; cA = nA; cB = nB; ++ui;
        if constexpr (ALIGN_EPI) { if (wr == 1) PG8_BAR; }
    }
    PG8_WAIT_V(0);
    if constexpr (!ALIGN_EPI) { if (wr == 0) PG8_BAR; }
    PG8_BAR;
    if constexpr (Epi::AFTER_DRAIN) { E.fused(acc, cur, wr, wc, fr, fq, lds, wid, lane); S.done(cur); }
#undef PG8_SA
#undef PG8_SB
#undef PG8_STAGE
#undef PG8_LDA
#undef PG8_LDB
#undef PG8_MMA
#undef PG8_WAIT_V
#undef PG8_WAIT_L
#undef PG8_BAR
#undef PG8_SCHED
}
}

#ifndef PG8_SP2
#define PG8_SP2 true
#endif
#ifndef PG8_ALIGN
#define PG8_ALIGN true
#endif

struct Frame {
    LAS unsigned char* lds;
    int tid, lane, wave, vcu, G;
    const float *x_prompt, *x_sample, *cvec, *state_hgrn, *state_rglru, *c_ctx, *w_ada, *b_ada, *norm1_gain, *norm2_gain, *w_in, *lb_logits, *hg_norm_gain,
                *conv_w, *conv_b, *lru_wa, *lru_ba, *lru_wx, *lru_bx, *lru_lambda, *w_out, *w_ff1, *w_ff2, *final_gain;
    float* out;
    bf16 *Win_t, *Wout_t, *Wff1_t, *Wff2_t, *WL;
    float* MOD; float* XS; float* DEC; float* LC;
    bf16 *ACT, *QF, *V, *GL, *LX, *QE, *KE, *KDT, *VT, *OF, *OB, *HF, *HB, *HID, *PC, *XF;
};
constexpr size_t OUT_SHG = (size_t)NTOK * 1024, OUT_SLRU = OUT_SHG + (size_t)32 * 2 * 4 * 128 * 128;

DI void p0_transpose_item(const float* W, int K, int N, bf16* WT, LAS float* scr, int item, int lane) {
    const int nblk = N / 32, kb = item / nblk, nb = item % nblk, k0 = 64 * kb, n0 = 32 * nb;
    float wv[32];
#pragma unroll
    for (int i = 0; i < 32; ++i) wv[i] = __builtin_nontemporal_load(W + (size_t)(k0 + 2 * i + (lane >> 5)) * N + n0 + (lane & 31));
#pragma unroll
    for (int i = 0; i < 32; ++i) scr[(2 * i + (lane >> 5)) * 33 + (lane & 31)] = wv[i];
    LDS_WAIT(); asm volatile("" ::: "memory");
    const int c = lane & 7;
#pragma unroll
    for (int j = 0; j < 4; ++j) { const int n = (lane >> 3) + 8 * j; const LAS float* s = scr + (8 * c) * 33 + n;
        v4u o; o.x = pk2(s[0 * 33], s[1 * 33]); o.y = pk2(s[2 * 33], s[3 * 33]); o.z = pk2(s[4 * 33], s[5 * 33]); o.w = pk2(s[6 * 33], s[7 * 33]);
        *(GAS v4u*)(WT + (size_t)(n0 + n) * K + k0 + 8 * c) = o; }
    LDS_WAIT(); asm volatile("" ::: "memory");
}
DI void p0_prologue(Frame& F) {
    LAS float* ct = (LAS float*)(F.lds + CT_OFF);
    for (int i = F.tid; i < 5 * 1024; i += NWAVES * 64) { const int j = i >> 10, k = i & 1023; const float c = (j == 0) ? F.c_ctx[k] : F.cvec[(j - 1) * 1024 + k]; ct[i] = silu_f(c); }
    __syncthreads();
    LAS float* scr = (LAS float*)(F.lds + RING_OFF + F.wave * 16384);
    const int gw = F.wave * F.G + F.vcu, NGW = F.G * NWAVES;
    constexpr int I_GEMV = 8 * (6144 / 32), I_WL = 32, I_IN = (D / 64) * (INC / 32);
    constexpr int NITEMS = I_GEMV + I_WL + I_IN;
    for (int it = gw; it < NITEMS; it += NGW) {
        int r = it;
        if (r < I_GEMV) {
            const int ksl = r & 7, n0 = 32 * (r >> 3), col = F.lane & 31, kq = F.lane >> 5;
            const float* wp = F.w_ada + (size_t)(128 * ksl) * 6144 + n0 + col;
            const LAS float* cts = ct + 128 * ksl;
            float acc[5] = {0.f, 0.f, 0.f, 0.f, 0.f};
#pragma unroll 1
            for (int k = kq; k < 128; k += 64) {
                float w[32];
#pragma unroll
                for (int u = 0; u < 32; ++u) w[u] = __builtin_nontemporal_load(wp + (size_t)(k + 2 * u) * 6144);
#pragma unroll
                for (int u = 0; u < 32; ++u)
#pragma unroll
                    for (int j = 0; j < 5; ++j) acc[j] += cts[j * 1024 + k + 2 * u] * w[u];
            }
#pragma unroll
            for (int j = 0; j < 5; ++j) acc[j] += __shfl_xor(acc[j], 32);
            if (kq == 0) { const float bsum = ksl == 0 ? F.b_ada[n0 + col] : 0.f;
#pragma unroll
                for (int j = 0; j < 5; ++j) atomicAdd(F.MOD + j * 6144 + n0 + col, acc[j] + bsum); }
            continue;
        }
        r -= I_GEMV;
        if (r < I_WL) {
            const int mat = r >> 4; const float* src = (mat ? F.lru_wx : F.lru_wa) + (size_t)(r & 15) * 4096; bf16* dst = F.WL + (size_t)r * 4096;
            for (int e = F.lane; e < 4096; e += 64) { const int o = e >> 6, i = e & 63; dst[o * 64 + i] = (bf16)(pk2(src[i * 64 + o], 0.f) & 0xffffu); }
            continue;
        }
        r -= I_WL;
        p0_transpose_item(F.w_in, D, INC, F.Win_t, scr, r, F.lane);
    }
}
DI void deferred_transposes(Frame& F, int iw, int nw) {
    LAS float* scr = (LAS float*)(F.lds + RING_OFF + F.wave * 16384);
    constexpr int I_OUT = (D / 64) * (D / 32), I_F1 = (D / 64) * (DFF / 32), I_F2 = (DFF / 64) * (D / 32);
    for (int it = iw; it < I_OUT + I_F1 + I_F2; it += nw) {
        int r = it;
        if (r < I_OUT) { p0_transpose_item(F.w_out, D, D, F.Wout_t, scr, r, F.lane); continue; } r -= I_OUT;
        if (r < I_F1) { p0_transpose_item(F.w_ff1, D, DFF, F.Wff1_t, scr, r, F.lane); continue; } r -= I_F1;
        p0_transpose_item(F.w_ff2, DFF, D, F.Wff2_t, scr, r, F.lane);
    }
}

DI int cond_of_row(int m) { return m < NCTX ? 0 : 1 + ((m - NCTX) >> 10); }
DI void store_row_bf16(bf16* orow, int lane, const f32x4 (&v)[4]) {
    GAS v2u* o8 = (GAS v2u*)orow + lane;
#pragma unroll
    for (int j = 0; j < 4; ++j) { v2u w; w.x = pk2(v[j].x, v[j].y); w.y = pk2(v[j].z, v[j].w); o8[64 * j] = w; }
}
DI void p1_rows(Frame& F) {
    const int gw = F.vcu * NWAVES + F.wave, NGW = F.G * NWAVES;
    f32x4 vn[4];
    if (gw < NTOK) { const GAS f32x4* xr = (const GAS f32x4*)(gw < NCTX ? F.x_prompt + (size_t)gw * D : F.x_sample + (size_t)(gw - NCTX) * D) + F.lane;
#pragma unroll
        for (int j = 0; j < 4; ++j) vn[j] = __builtin_nontemporal_load((const f32x4*)xr + 64 * j); }
    f32x4 msh[4], msc[4]; int ccur = -1;
    for (int m = gw; m < NTOK; m += NGW) {
        f32x4 v[4];
#pragma unroll
        for (int j = 0; j < 4; ++j) v[j] = vn[j];
        const int cnd = cond_of_row(m);
        if (cnd != ccur) {
            const float* mod = F.MOD + cnd * 6144;
#pragma unroll
            for (int j = 0; j < 4; ++j) { const int c = 256 * j + 4 * F.lane; const f32x4 g = *(const f32x4*)(F.norm1_gain + c);
                msh[j] = *(const f32x4*)(mod + c); msc[j] = g * (1.0f + *(const f32x4*)(mod + 1024 + c)); }
            ccur = cnd;
        }
        { const int mn = m + NGW < NTOK ? m + NGW : m;
          const GAS f32x4* xr = (const GAS f32x4*)(mn < NCTX ? F.x_prompt + (size_t)mn * D : F.x_sample + (size_t)(mn - NCTX) * D) + F.lane;
#pragma unroll
          for (int j = 0; j < 4; ++j) vn[j] = __builtin_nontemporal_load((const f32x4*)xr + 64 * j); }
        if (m >= NCTX) {
            const int t = (m - NCTX) & 1023; const float rr = (float)(t >> 6), cc = (float)(t & 63);
#pragma unroll
            for (int e = 0; e < 4; ++e) {
                const float om = __builtin_amdgcn_exp2f(-(float)(4 * F.lane + e) * (13.287712379549449f / 256.0f));
                const float ar = rr * om * 0.15915494309189535f, ac = cc * om * 0.15915494309189535f;
                v[0][e] += __builtin_amdgcn_sinf(ar); v[1][e] += __builtin_amdgcn_cosf(ar); v[2][e] += __builtin_amdgcn_sinf(ac); v[3][e] += __builtin_amdgcn_cosf(ac);
            }
            if (F.G != 256) {
                GAS f32x4* xo = (GAS f32x4*)(F.XS + (size_t)(m - NCTX) * D) + F.lane;
#pragma unroll
                for (int j = 0; j < 4; ++j) xo[64 * j] = v[j]; }
        }
        float s = 0.f;
#pragma unroll
        for (int j = 0; j < 4; ++j) s += (v[j].x * v[j].x + v[j].y * v[j].y) + (v[j].z * v[j].z + v[j].w * v[j].w);
        const float rstd = __builtin_amdgcn_rsqf(wave_sum(s) * (1.f / D) + EPS);
#pragma unroll
        for (int j = 0; j < 4; ++j) v[j] = v[j] * rstd * msc[j] + msh[j];
        store_row_bf16(F.ACT + (size_t)m * D, F.lane, v);
    }
}
DI void p7_rows(Frame& F) {
    const int gw = F.vcu * NWAVES + F.wave, NGW = F.G * NWAVES;
    for (int m = gw; m < NTOK; m += NGW) {
        const GAS f32x4* xr = (const GAS f32x4*)(F.out + (size_t)m * D) + F.lane;
        f32x4 v[4]; float s = 0.f;
#pragma unroll
        for (int j = 0; j < 4; ++j) { v[j] = xr[64 * j]; s += (v[j].x * v[j].x + v[j].y * v[j].y) + (v[j].z * v[j].z + v[j].w * v[j].w); }
        const float rstd = __builtin_amdgcn_rsqf(wave_sum(s) * (1.f / D) + EPS);
        const float* mod = F.MOD + cond_of_row(m) * 6144;
#pragma unroll
        for (int j = 0; j < 4; ++j) {
            const int c = 256 * j + 4 * F.lane;
            const f32x4 g = *(const f32x4*)(F.norm2_gain + c), sh = *(const f32x4*)(mod + 3072 + c), sc = *(const f32x4*)(mod + 4096 + c);
            v[j] = v[j] * rstd * g * (1.0f + sc) + sh;
        }
        store_row_bf16(F.ACT + (size_t)m * D, F.lane, v);
    }
}
DI void p10_rows(Frame& F) {
    const int gw = F.vcu * NWAVES + F.wave, NGW = F.G * NWAVES;
    for (int m = gw; m < NTOK; m += NGW) {
        GAS f32x4* xr = (GAS f32x4*)(F.out + (size_t)m * D) + F.lane;
        f32x4 v[4]; float s = 0.f;
#pragma unroll
        for (int j = 0; j < 4; ++j) { v[j] = xr[64 * j]; s += (v[j].x * v[j].x + v[j].y * v[j].y) + (v[j].z * v[j].z + v[j].w * v[j].w); }
        const float rstd = __builtin_amdgcn_rsqf(wave_sum(s) * (1.f / D) + EPS);
#pragma unroll
        for (int j = 0; j < 4; ++j) { const f32x4 g = *(const f32x4*)(F.final_gain + 256 * j + 4 * F.lane); xr[64 * j] = v[j] * rstd * g; }
    }
}
DI void p5_rows(Frame& F) {
    const int gw = F.vcu * NWAVES + F.wave, NGW = F.G * NWAVES;
    const int c8 = 8 * F.lane;
    struct Row5 { v4u a, b, gt, lg, hf, hb, pc0, pc1; };
#define P5_LOAD(R, mm) do { const int m_ = (mm); \
        R.a = *(const GAS v4u*)(F.OF + (size_t)m_ * 512 + c8); R.b = *(const GAS v4u*)(F.OB + (size_t)m_ * 512 + c8); \
        R.gt = *(const GAS v4u*)(F.GL + (size_t)m_ * 1024 + c8); R.lg = *(const GAS v4u*)(F.GL + (size_t)m_ * 1024 + 512 + c8); \
        R.hf = *(const GAS v4u*)(F.HF + (size_t)m_ * 512 + c8); R.hb = *(const GAS v4u*)(F.HB + (size_t)m_ * 512 + c8); \
        const int ml_ = m_ >= NCTX ? m_ - NCTX : 0; \
        R.pc0 = *(const GAS v4u*)(F.PC + ((size_t)ml_ * 2 + 0) * 512 + c8); R.pc1 = *(const GAS v4u*)(F.PC + ((size_t)ml_ * 2 + 1) * 512 + c8); } while (0)
    const f32x4 g0 = *(const f32x4*)(F.hg_norm_gain + c8), g1 = *(const f32x4*)(F.hg_norm_gain + c8 + 4);
    Row5 Rn;
    if (gw < NTOK) P5_LOAD(Rn, gw);
    for (int m = gw; m < NTOK; m += NGW) {
        const Row5 Rc = Rn;
        P5_LOAD(Rn, m + NGW < NTOK ? m + NGW : m);
        const v4u a = Rc.a, b = Rc.b, gt = Rc.gt, lg = Rc.lg, hf = Rc.hf, hb = Rc.hb;
        float o[8], s = 0.f;
#pragma unroll
        for (int j = 0; j < 4; ++j) { o[2 * j] = bflo(a[j]) + bflo(b[j]); o[2 * j + 1] = bfhi(a[j]) + bfhi(b[j]); s += o[2 * j] * o[2 * j] + o[2 * j + 1] * o[2 * j + 1]; }
        float hsum[8];
#pragma unroll
        for (int j = 0; j < 4; ++j) { hsum[2 * j] = bflo(hf[j]) + bflo(hb[j]); hsum[2 * j + 1] = bfhi(hf[j]) + bfhi(hb[j]); }
        if (m >= NCTX) {
            const int ml = m - NCTX, bb = ml >> 10, seg = (ml >> 8) & 3;
#pragma unroll
            for (int d = 0; d < 2; ++d) {
                const int jn = d ? 3 - seg : seg;
                if (jn > 0) {
                    const float* lc = F.LC + ((size_t)((bb * 2 + d) * 4) * 512 + c8) * 2;
                    float hin[8];
                    { const f32x4 q0 = *(const f32x4*)(lc), q1 = *(const f32x4*)(lc + 4), q2 = *(const f32x4*)(lc + 8), q3 = *(const f32x4*)(lc + 12);
                      hin[0] = q0[1]; hin[1] = q0[3]; hin[2] = q1[1]; hin[3] = q1[3]; hin[4] = q2[1]; hin[5] = q2[3]; hin[6] = q3[1]; hin[7] = q3[3]; }
                    for (int jj = 1; jj < jn; ++jj) {
                        const float* l2 = lc + (size_t)jj * 1024;
                        const f32x4 q0 = *(const f32x4*)(l2), q1 = *(const f32x4*)(l2 + 4), q2 = *(const f32x4*)(l2 + 8), q3 = *(const f32x4*)(l2 + 12);
                        hin[0] = q0[0] * hin[0] + q0[1]; hin[1] = q0[2] * hin[1] + q0[3]; hin[2] = q1[0] * hin[2] + q1[1]; hin[3] = q1[2] * hin[3] + q1[3];
                        hin[4] = q2[0] * hin[4] + q2[1]; hin[5] = q2[2] * hin[5] + q2[3]; hin[6] = q3[0] * hin[6] + q3[1]; hin[7] = q3[2] * hin[7] + q3[3];
                    }
                    const v4u pc = d ? Rc.pc1 : Rc.pc0;
#pragma unroll
                    for (int e = 0; e < 4; ++e) { hsum[2 * e] += bflo(pc[e]) * hin[2 * e]; hsum[2 * e + 1] += bfhi(pc[e]) * hin[2 * e + 1]; }
                }
            }
        }
        s += __shfl_xor(s, 1); s += __shfl_xor(s, 2); s += __shfl_xor(s, 4); s += __shfl_xor(s, 8);
        const float rstd = __builtin_amdgcn_rsqf(s * (1.f / 128.f) + EPS);
        v4u w1, w2;
#pragma unroll
        for (int j = 0; j < 4; ++j) {
            const float ga = (j < 2) ? g0[2 * j] : g1[2 * j - 4], gb = (j < 2) ? g0[2 * j + 1] : g1[2 * j - 3];
            w1[j] = pk2(o[2 * j] * rstd * ga * silu_f(bflo(gt[j])), o[2 * j + 1] * rstd * gb * silu_f(bfhi(gt[j])));
            w2[j] = pk2(hsum[2 * j] * gelu_tanh_f(bflo(lg[j])), hsum[2 * j + 1] * gelu_tanh_f(bfhi(lg[j])));
        }
        *(GAS v4u*)(F.ACT + (size_t)m * D + c8) = w1;
        *(GAS v4u*)(F.ACT + (size_t)m * D + 512 + c8) = w2;
    }
#undef P5_LOAD
}

#define MFMA32(a, b, c) __builtin_amdgcn_mfma_f32_32x32x16_bf16((a), (b), (c), 0, 0, 0)
DI bf16* qe_blk(Frame& F, int d, int cgx, int head) { return F.QF + (size_t)cgx * (32 * 2048) + 1024 + d * 512 + head * 128; }
DI bf16* kd_blk(Frame& F, int d, int cgx, int head) { return F.QF + (size_t)cgx * (32 * 2048) + d * 512 + head * 128; }
DI bf16* vt_blk(Frame& F, int cgx, int head) { return F.V + (size_t)cgx * (32 * 512) + head * 128; }
DI bf16x8 pack8(const f32x16& x, int s) {
    const v4u w = {pk2(x[8 * s], x[8 * s + 1]), pk2(x[8 * s + 2], x[8 * s + 3]), pk2(x[8 * s + 4], x[8 * s + 5]), pk2(x[8 * s + 6], x[8 * s + 7])};
    return __builtin_bit_cast(bf16x8, w);
}
DI bf16x8 ldfrag(const bf16* p) { return __builtin_bit_cast(bf16x8, *(const GAS v4u*)p); }
template <int DIR>
DI void hg_prep_item(Frame& F, int cg, int head) {
    const int m0 = cg * 32, k0 = 2 * F.lane, hk = head * 128 + k0, col = DIR * 512 + hk;
    const f32x2 L0 = *(const f32x2*)(F.lb_logits + DIR * 512 + hk), L1 = *(const f32x2*)(F.lb_logits + 1024 + DIR * 512 + hk);
    const float lba = __builtin_amdgcn_rcpf(1.0f + __expf(L1.x - L0.x)), lbb = __builtin_amdgcn_rcpf(1.0f + __expf(L1.y - L0.y));
    constexpr float L2E = 1.4426950408889634f;
    float lf0[32], lf1[32]; unsigned kkp[32], qw[32];
    float bl0 = 0.f, bl1 = 0.f;
#pragma unroll
    for (int i = 0; i < 32; ++i) {
        const int t = DIR ? 31 - i : i; const size_t ro = (size_t)(m0 + t) * 2048 + col;
        const unsigned fw = *(const GAS unsigned*)(F.QF + ro + 1024); qw[i] = *(const GAS unsigned*)(F.QF + ro);
        const float f0 = lba + (1.0f - lba) * __builtin_amdgcn_rcpf(1.0f + __builtin_amdgcn_exp2f(-L2E * bflo(fw)));
        const float f1 = lbb + (1.0f - lbb) * __builtin_amdgcn_rcpf(1.0f + __builtin_amdgcn_exp2f(-L2E * bfhi(fw)));
        lf0[i] = __builtin_amdgcn_logf(f0); lf1[i] = __builtin_amdgcn_logf(f1); kkp[i] = pk2(1.0f - f0, 1.0f - f1);
        bl0 += lf0[i]; bl1 += lf1[i];
    }
    const float dec0 = __builtin_amdgcn_exp2f(bl0), dec1 = __builtin_amdgcn_exp2f(bl1);
    const size_t cb = ((size_t)DIR * NCH + cg) * 4 + head;
    LAS unsigned char* wl = F.lds + RING_OFF + F.wave * 16384;
    const int kk = k0 & 15, fh = (kk >> 2) & 1, fj = (kk & 3) + 4 * (kk >> 3);
    bf16* qeb = qe_blk(F, DIR, cg, head) + (size_t)((k0 >> 4) * 4 + 2 * fh) * 2048 + fj;
    float b0 = 0.f, b1 = 0.f; unsigned kd0[16], kd1[16];
#pragma unroll
    for (int ip = 0; ip < 16; ++ip) {
        float d0[2], d1[2];
#pragma unroll
        for (int s = 0; s < 2; ++s) {
            const int i = 2 * ip + s, t = DIR ? 31 - i : i;
            b0 += lf0[i]; b1 += lf1[i];
            const float q0 = bflo(qw[i]), q1 = bfhi(qw[i]);
            const float en0 = __builtin_amdgcn_exp2f(-b0), en1 = __builtin_amdgcn_exp2f(-b1);
            const float qe0 = q0 * __builtin_amdgcn_rcpf(en0 + __builtin_amdgcn_exp2f(-L2E * q0 - b0)), qe1 = q1 * __builtin_amdgcn_rcpf(en1 + __builtin_amdgcn_exp2f(-L2E * q1 - b1));
            const float ke0 = bflo(kkp[i]) * en0, ke1 = bfhi(kkp[i]) * en1;
            const unsigned qew = pk2(qe0, qe1), kew = pk2(ke0, ke1);
            { const unsigned lo = (unsigned)(((k0 >> 4) * 64 + ((t ^ (k0 >> 4)) + 32 * fh)) * 16 + fj * 2);
              *(LAS unsigned*)(wl + lo) = qew; *(LAS unsigned*)(wl + 8192 + lo) = kew; }
            d0[s] = ke0 * dec0; d1[s] = ke1 * dec1;
        }
        const int p = DIR ? 15 - ip : ip;
        kd0[p] = DIR ? pk2(d0[1], d0[0]) : pk2(d0[0], d0[1]);
        kd1[p] = DIR ? pk2(d1[1], d1[0]) : pk2(d1[0], d1[1]);
    }
    {
        bf16* qb = qe_blk(F, DIR, cg, head);
        const int tl = F.lane & 31, hh = F.lane >> 5;
#pragma unroll
        for (int ks = 0; ks < 8; ++ks) {
            const v4u q = *(const LAS v4u*)(wl + (unsigned)((ks * 64 + ((tl ^ ks) + 32 * hh)) * 16));
            *(GAS v4u*)(qb + (size_t)(ks * 4 + (F.lane >> 4)) * 2048 + (F.lane & 15) * 8) = q; }
    }
    {
        const int ti = k0 >> 5, r = k0 & 31;
        bf16* kb = kd_blk(F, DIR, cg, head);
#pragma unroll
        for (int sp = 0; sp < 2; ++sp)
#pragma unroll
            for (int h = 0; h < 2; ++h) {
                const v4u a = {kd0[8 * sp + 2 * h], kd0[8 * sp + 2 * h + 1], kd0[8 * sp + 4 + 2 * h], kd0[8 * sp + 4 + 2 * h + 1]};
                const v4u b = {kd1[8 * sp + 2 * h], kd1[8 * sp + 2 * h + 1], kd1[8 * sp + 4 + 2 * h], kd1[8 * sp + 4 + 2 * h + 1]};
                bf16* kp = kb + (size_t)((ti * 2 + sp) * 4 + ((r + 32 * h) >> 4)) * 2048 + ((r + 32 * h) & 15) * 8;
                *(GAS v4u*)(kp) = a; *(GAS v4u*)(kp + 8) = b;
            }
        const int dh = (r >> 2) & 1, rg = (r & 3) + 4 * (r >> 3);
        *(f32x2*)(F.DEC + cb * 128 + ti * 32 + dh * 16 + rg) = (f32x2){dec0, dec1};
    }
    {
        const int r = F.lane & 31, h = F.lane >> 5; const unsigned lo8 = (unsigned)F.lane * 8u;
        f32x16 X;
#pragma unroll
        for (int i = 0; i < 16; ++i) X[i] = 0.f;
#pragma unroll
        for (int ks = 0; ks < 8; ++ks) { const unsigned lo = (unsigned)((ks * 64 + ((r ^ ks) + 32 * h)) * 16);
            X = MFMA32(*(const LAS bf16x8*)(wl + 8192 + lo), *(const LAS bf16x8*)(wl + lo), X); }
#pragma unroll
        for (int rg = 0; rg < 16; ++rg) { const int s = (rg & 3) + 8 * (rg >> 2) + 4 * h; const bool keep = DIR ? (s >= r) : (s <= r); X[rg] = keep ? X[rg] : 0.f; }
        *(GAS v4u*)(F.XF + cb * 1024 + lo8) = __builtin_bit_cast(v4u, pack8(X, 0));
        *(GAS v4u*)(F.XF + cb * 1024 + 512 + lo8) = __builtin_bit_cast(v4u, pack8(X, 1));
    }
}
DI void vt_item(Frame& F, int cg, int head) {
    const int m0 = cg * 32, v0 = 2 * F.lane, hv = head * 128 + v0;
    unsigned w[32];
#pragma unroll
    for (int t = 0; t < 32; ++t) w[t] = *(const GAS unsigned*)(F.V + (size_t)(m0 + t) * 512 + hv);
    unsigned rl[16], rh[16];
#pragma unroll
    for (int p = 0; p < 16; ++p) { const unsigned x = w[2 * p], y = w[2 * p + 1]; rl[p] = (x & 0xffffu) | (y << 16); rh[p] = (x >> 16) | (y & 0xffff0000u); }
    bf16* vb = vt_blk(F, cg, head); const int vr = v0 & 31;
    asm volatile("s_waitcnt vmcnt(0)" ::: "memory");
#pragma unroll
    for (int sp = 0; sp < 2; ++sp)
#pragma unroll
        for (int h = 0; h < 2; ++h) {
            const v4u a = {rl[8 * sp + 2 * h], rl[8 * sp + 2 * h + 1], rl[8 * sp + 4 + 2 * h], rl[8 * sp + 4 + 2 * h + 1]};
            const v4u b = {rh[8 * sp + 2 * h], rh[8 * sp + 2 * h + 1], rh[8 * sp + 4 + 2 * h], rh[8 * sp + 4 + 2 * h + 1]};
            bf16* vp = vb + (size_t)(((v0 >> 5) * 2 + sp) * 4 + ((vr + 32 * h) >> 4)) * 512 + ((vr + 32 * h) & 15) * 8;
            *(GAS v4u*)(vp) = a; *(GAS v4u*)(vp + 8) = b;
        }
}
DI unsigned* gates_base(Frame& F, int d, int row) { return (unsigned*)((unsigned char*)F.ACT + (d ? 0 : (row < NCTX ? (220 - 28) * MiB : (222 - 28) * MiB))); }
DI void lru_gate_item(Frame& F, int tg, int n) {
    const int m0 = 64 * tg, r = F.lane & 31, h = F.lane >> 5;
    const int T = m0 < NCTX ? TCTX : TLAT, tseq0 = m0 < NCTX ? (m0 & (TCTX - 1)) : ((m0 - NCTX) & (TLAT - 1));
    bf16x8 xa[2][4];
#pragma unroll
    for (int ks = 0; ks < 4; ++ks) {
        const int c0 = 64 * n + 16 * ks + 8 * h;
        f32x4 w[4][2];
#pragma unroll
        for (int j = 0; j < 4; ++j) { w[j][0] = *(const f32x4*)(F.conv_w + j * 512 + c0); w[j][1] = *(const f32x4*)(F.conv_w + j * 512 + c0 + 4); }
        const f32x4 cb0 = *(const f32x4*)(F.conv_b + c0), cb1 = *(const f32x4*)(F.conv_b + c0 + 4);
#pragma unroll
        for (int mt = 0; mt < 2; ++mt) {
            const int tk = 32 * mt + r, m = m0 + tk, ts = tseq0 + tk;
            f32x4 a0 = cb0, a1 = cb1;
#pragma unroll
            for (int j = 0; j < 4; ++j) {
                const int tt = ts + j - 2; const bool ok = (tt >= 0) && (tt < T);
                const v4u lw = *(const GAS v4u*)(F.LX + (size_t)(ok ? m + j - 2 : m) * 512 + c0);
                const float z = ok ? 1.0f : 0.0f;
                a0 += (f32x4){bflo(lw.x), bfhi(lw.x), bflo(lw.y), bfhi(lw.y)} * (w[j][0] * z);
                a1 += (f32x4){bflo(lw.z), bfhi(lw.z), bflo(lw.w), bfhi(lw.w)} * (w[j][1] * z);
            }
            const v4u p = {pk2(a0.x, a0.y), pk2(a0.z, a0.w), pk2(a1.x, a1.y), pk2(a1.z, a1.w)};
            xa[mt][ks] = __builtin_bit_cast(bf16x8, p);
        }
    }
    f32x16 zero;
#pragma unroll
    for (int i = 0; i < 16; ++i) zero[i] = 0.f;
    float cba[2][2], cbx[2][2], csp[2][2];
#pragma unroll
    for (int nt = 0; nt < 2; ++nt)
#pragma unroll
        for (int d = 0; d < 2; ++d) { const int c = d * 512 + 64 * n + 32 * nt + r; cba[nt][d] = F.lru_ba[c]; cbx[nt][d] = F.lru_bx[c]; csp[nt][d] = F.lru_lambda[c]; }
#pragma unroll
    for (int nt = 0; nt < 2; ++nt)
#pragma unroll
        for (int d = 0; d < 2; ++d) { const float e = __expf(-csp[nt][d]); csp[nt][d] = -8.0f * e * (1.0f - e * (0.5f - e * (0.33333333f - 0.25f * e))); }
#pragma unroll
    for (int nt = 0; nt < 2; ++nt) {
        f32x16 xcC[2] = {zero, zero};
#pragma unroll
        for (int s = 0; s < 2; ++s) {
            bf16x8 bI;
#pragma unroll
            for (int j = 0; j < 8; ++j) bI[j] = (16 * s + 8 * h + j == r) ? (short)0x3F80 : (short)0;
#pragma unroll
            for (int mt = 0; mt < 2; ++mt) xcC[mt] = MFMA32(xa[mt][2 * nt + s], bI, xcC[mt]);
        }
        const int c = 64 * n + 32 * nt + r;
#pragma unroll 1
        for (int d = 0; d < 2; ++d) {
            const bf16* wa = F.WL + ((size_t)((0 * 2 + d) * 8 + n) * 64 + 32 * nt + r) * 64 + 8 * h;
            const bf16* wx = F.WL + ((size_t)((1 * 2 + d) * 8 + n) * 64 + 32 * nt + r) * 64 + 8 * h;
            const float bias_a = d ? cba[nt][1] : cba[nt][0], bias_x = d ? cbx[nt][1] : cbx[nt][0], sp8 = d ? csp[nt][1] : csp[nt][0];
            bf16x8 wfa[4], wfx[4];
#pragma unroll
            for (int ks = 0; ks < 4; ++ks) { wfa[ks] = *(const GAS bf16x8*)(wa + 16 * ks); wfx[ks] = *(const GAS bf16x8*)(wx + 16 * ks); }
            __builtin_amdgcn_sched_barrier(0);
#pragma unroll
            for (int mt = 0; mt < 2; ++mt) {
                f32x16 accA = zero, accX = zero;
#pragma unroll
                for (int ks = 0; ks < 4; ++ks) { accA = MFMA32(xa[mt][ks], wfa[ks], accA); accX = MFMA32(xa[mt][ks], wfx[ks], accX); }
                unsigned* gb = gates_base(F, d, m0) + (size_t)(m0 + 32 * mt) * 512;
                const unsigned lofs = (unsigned)(4 * h) * 512u + (unsigned)c;
#pragma unroll
                for (int rg = 0; rg < 16; rg += 2) {
                    constexpr float NL2E = -1.4426950408889634f;
                    const f32x2 za = ((f32x2){accA[rg], accA[rg + 1]} + bias_a) * NL2E, zx = ((f32x2){accX[rg], accX[rg + 1]} + bias_x) * NL2E;
                    const f32x2 da = (f32x2){__builtin_amdgcn_exp2f(za.x), __builtin_amdgcn_exp2f(za.y)} + 1.0f, dx = (f32x2){__builtin_amdgcn_exp2f(zx.x), __builtin_amdgcn_exp2f(zx.y)} + 1.0f;
                    const f32x2 rr = {__builtin_amdgcn_rcpf(da.x), __builtin_amdgcn_rcpf(da.y)}, ii = {__builtin_amdgcn_rcpf(dx.x), __builtin_amdgcn_rcpf(dx.y)};
                    const f32x2 la = rr * sp8, y = la + la;
                    const f32x2 em = -y * (1.0f + y * (0.5f + y * (0.16666667f + y * (0.041666668f + y * 0.0083333333f))));
                    const f32x2 xc = {xcC[mt][rg], xcC[mt][rg + 1]};
                    const f32x2 u = (f32x2){__builtin_amdgcn_sqrtf(em.x), __builtin_amdgcn_sqrtf(em.y)} * ii * xc;
                    const f32x2 ea = -la * (1.0f + la * (0.5f + la * (0.16666667f + la * (0.041666668f + la * 0.0083333333f))));
                    const unsigned uw = pk2(u.x, u.y);
                    const unsigned g0 = (unsigned)__builtin_bit_cast(unsigned short, (_Float16)ea.x) | (uw << 16);
                    const unsigned g1 = (unsigned)__builtin_bit_cast(unsigned short, (_Float16)ea.y) | (uw & 0xffff0000u);
#if defined(P3X) && (P3X & 1)
                    asm volatile("" :: "v"(g0), "v"(g1));
#else
                    (gb + ((rg & 3) + 8 * (rg >> 2)) * 512)[lofs] = g0;
                    (gb + (((rg + 1) & 3) + 8 * ((rg + 1) >> 2)) * 512)[lofs] = g1;
#endif
                }
            }
        }
    }
}
DI void p3_item(Frame& F, int r, int mode) {
    constexpr int I_G = (NTOK / 64) * 8, I_HG = NCH * 8;
#if defined(P3X) && (P3X & 4)
    if (r < I_G) return;
#endif
#if defined(P3X) && (P3X & 2)
    if (r >= I_G && r < I_G + I_HG) return;
#endif
#if defined(P3X) && (P3X & 8)
    if (r >= I_G + I_HG) return;
#endif
    if (r < I_G) { if (mode == 0 || mode == 1) lru_gate_item(F, r >> 3, r & 7); return; } r -= I_G;
    if (r < I_HG) { const int head = r & 3, dir = (r >> 2) & 1, cg = r >> 3; if (mode == 0 || mode == 2) { if (dir) hg_prep_item<1>(F, cg, head); else hg_prep_item<0>(F, cg, head); } return; } r -= I_HG;
    if (mode == 0 || mode == 3) vt_item(F, r >> 2, r & 3);
}
DI void p3_prep(Frame& F, int mode = 0) {
    const int gw = F.wave * F.G + F.vcu, NGW = F.G * NWAVES;
    constexpr int I_G = (NTOK / 64) * 8, I_HG = NCH * 8, I_VT = NCH * 4;
    const bool deal = (NGW == 2048);
    const int n_it = deal ? 3 : (I_G + I_HG + I_VT - gw + NGW - 1) / NGW;
    for (int e = 0; e < n_it; ++e) {
        int it;
        if (!deal) it = gw + e * NGW;
        else if (gw < I_G) it = e == 0 ? gw : e == 1 ? I_G + 1536 + gw : I_G + I_HG + gw;
        else { const int j = gw - I_G; it = I_G + 3 * j + e; }
        p3_item(F, it, mode);
    }
    if (mode == 0) deferred_transposes(F, gw, NGW);
}

constexpr int HG_GB = 27136, HG_QE = 0, HG_KD = 8192, HG_XF = 16384, HG_VT = 18432, HG_DEC = 26624;
static_assert(4 * HG_GB <= RING_BYTES, "hg scan LDS");
template <int mode>
DI void hg_scan_wg(Frame& F, int sqA, int dA, int headA, int sqB, int dB, int headB) {
    const int half = F.wave >> 2, vs = F.wave & 3, r = F.lane & 31, h = F.lane >> 5;
    const int sq = half ? sqB : sqA, d = half ? dB : dA, head = half ? headB : headA;
    const bool latA = sqA >= 32;
    const int nch = (mode == 5) ? 8 : (latA ? TLAT : TCTX) / 32;
#define HG_BAR() do { asm volatile("s_waitcnt lgkmcnt(0)" ::: "memory"); __builtin_amdgcn_s_barrier(); asm volatile("" ::: "memory"); } while (0)
    if (sq < 0) { for (int n = 0; n <= nch; ++n) HG_BAR(); return; }
    const bool lat = sq >= 32;
    const int base = lat ? NCTX + (sq - 32) * TLAT : sq * TCTX;
    f32x16 S[4];
    if (lat) {
        const float* s0 = F.state_hgrn + ((size_t)((sq - 32) * 2 + d) * 4 + head) * 128 * 128 + 32 * vs;
        const unsigned so = (unsigned)(4 * h * 128 + r);
#pragma unroll
        for (int i = 0; i < 4; ++i)
#pragma unroll
            for (int rg = 0; rg < 16; ++rg) S[i][rg] = s0[so + (unsigned)((32 * i + (rg & 3) + 8 * (rg >> 2)) * 128)];
    } else {
#pragma unroll
        for (int i = 0; i < 4; ++i)
#pragma unroll
            for (int rg = 0; rg < 16; ++rg) S[i][rg] = 0.f;
    }
#pragma unroll
    for (int i = 0; i < 4; ++i)
#pragma unroll
        for (int rg = 0; rg < 16; ++rg) asm volatile("" : "+v"(S[i][rg]));
    const unsigned lo8 = (unsigned)F.lane * 8u, ooff = (unsigned)(r * 512 + 32 * vs + 4 * h);
    const unsigned lq = (unsigned)((F.lane >> 4) * 2048 + (F.lane & 15) * 8), lv = (unsigned)((F.lane >> 4) * 512 + (F.lane & 15) * 8);
    LAS unsigned char* gl = F.lds + RING_OFF + half * (2 * HG_GB);
    const unsigned l16 = (unsigned)F.lane * 16u;
    bf16* OUTd = (d ? F.OB : F.OF) + head * 128;
    const int c0 = d ? nch - 1 : 0, cstep = d ? -1 : 1;
    const size_t cb = ((size_t)d * NCH + (base >> 5) + c0) * 4 + head;
    const size_t vb = ((size_t)((base >> 5) + c0) * 4 + head) * 4 + vs;
    struct StageRegs { v4u q0, q1, k0, k1, x, v0, v1; f32x2 dd; };
    StageRegs R0, R1;
#define HG_LOAD(R, n) do { const size_t cbx = (size_t)((long)cb + 4 * cstep * (n)); const int cgx = (base >> 5) + c0 + cstep * (n); \
        const bf16* qb_ = qe_blk(F, d, cgx, head) + lq; const bf16* kb_ = kd_blk(F, d, cgx, head) + lq; const bf16* vb_ = vt_blk(F, cgx, head) + lv; \
        R.q0 = *(const GAS v4u*)(qb_ + (size_t)(8 * vs) * 2048); R.q1 = *(const GAS v4u*)(qb_ + (size_t)(8 * vs + 4) * 2048); \
        R.k0 = *(const GAS v4u*)(kb_ + (size_t)(8 * vs) * 2048); R.k1 = *(const GAS v4u*)(kb_ + (size_t)(8 * vs + 4) * 2048); \
        R.x = *(const GAS v4u*)(F.XF + cbx * 1024 + (vs & 1) * 512 + lo8); \
        R.v0 = *(const GAS v4u*)(vb_ + (size_t)(8 * vs) * 512); R.v1 = *(const GAS v4u*)(vb_ + (size_t)(8 * vs + 4) * 512); \
        R.dd = *(const GAS f32x2*)(F.DEC + cbx * 128 + 2 * F.lane); } while (0)
#define HG_STAGE(R, bufp) do { \
        *(LAS v4u*)((bufp) + HG_QE + (2 * vs) * 1024 + l16) = R.q0; *(LAS v4u*)((bufp) + HG_QE + (2 * vs + 1) * 1024 + l16) = R.q1; \
        *(LAS v4u*)((bufp) + HG_KD + (2 * vs) * 1024 + l16) = R.k0; *(LAS v4u*)((bufp) + HG_KD + (2 * vs + 1) * 1024 + l16) = R.k1; \
        if (vs < 2) *(LAS v4u*)((bufp) + HG_XF + vs * 1024 + l16) = R.x; \
        *(LAS v4u*)((bufp) + HG_VT + (2 * vs) * 1024 + l16) = R.v0; *(LAS v4u*)((bufp) + HG_VT + (2 * vs + 1) * 1024 + l16) = R.v1; \
        if (vs == 3) *(LAS f32x2*)((bufp) + HG_DEC + 8 * F.lane) = R.dd; } while (0)
#define HG_COMPUTE(cur, n) do { \
            const int m0 = base + 32 * (c0 + cstep * (n)); \
            const bf16x8 xf0 = *(const LAS bf16x8*)((cur) + HG_XF + l16), xf1 = *(const LAS bf16x8*)((cur) + HG_XF + 1024 + l16); \
            const bf16x8 vf0 = *(const LAS bf16x8*)((cur) + HG_VT + (2 * vs) * 1024 + l16), vf1 = *(const LAS bf16x8*)((cur) + HG_VT + (2 * vs + 1) * 1024 + l16); \
            const LAS float* dc = (const LAS float*)((cur) + HG_DEC) + h * 16; \
            f32x4 dva[4], dvb[4]; \
            _Pragma("unroll") for (int g = 0; g < 4; ++g) dva[g] = *(const LAS f32x4*)(dc + 4 * g); \
            bf16x8 qfr[8]; \
            _Pragma("unroll") for (int i = 0; i < 8; ++i) qfr[i] = *(const LAS bf16x8*)((cur) + HG_QE + i * 1024 + l16); \
            __builtin_amdgcn_sched_barrier(0); \
            f32x16 O; \
            _Pragma("unroll") for (int i = 0; i < 16; ++i) O[i] = 0.f; \
            O = MFMA32(vf0, xf0, O); O = MFMA32(vf1, xf1, O); \
            _Pragma("unroll") for (int i = 0; i < 4; ++i) { \
                const bf16x8 sp0 = pack8(S[i], 0), sp1 = pack8(S[i], 1); \
                if (i < 3) { _Pragma("unroll") for (int g = 0; g < 4; ++g) { if (i & 1) dva[g] = *(const LAS f32x4*)(dc + (i + 1) * 32 + 4 * g); else dvb[g] = *(const LAS f32x4*)(dc + (i + 1) * 32 + 4 * g); } } \
                O = MFMA32(sp0, qfr[2 * i], O); O = MFMA32(sp1, qfr[2 * i + 1], O); \
                _Pragma("unroll") for (int g = 0; g < 4; ++g) _Pragma("unroll") for (int j = 0; j < 4; ++j) S[i][4 * g + j] *= ((i & 1) ? dvb[g][j] : dva[g][j]); \
                S[i] = MFMA32(*(const LAS bf16x8*)((cur) + HG_KD + (2 * i) * 1024 + l16), vf0, S[i]); S[i] = MFMA32(*(const LAS bf16x8*)((cur) + HG_KD + (2 * i + 1) * 1024 + l16), vf1, S[i]); } \
            bf16* op = OUTd + (size_t)m0 * 512; \
            _Pragma("unroll") for (int g = 0; g < 4; ++g) { const v2u w = {pk2(O[4 * g], O[4 * g + 1]), pk2(O[4 * g + 2], O[4 * g + 3])}; if (mode != 4) *(GAS v2u*)(op + ooff + 8 * g) = w; else asm volatile("" :: "v"(w)); } \
        } while (0)
    LAS unsigned char* b0 = gl; LAS unsigned char* b1 = gl + HG_GB;
    HG_LOAD(R0, 0); HG_STAGE(R0, b0); HG_LOAD(R1, 1);
    HG_BAR();
    for (int n = 0; n < nch; n += 2) {
        { const int nn = n + 2 < nch ? n + 2 : nch - 1; HG_LOAD(R0, nn); }
        HG_COMPUTE(b0, n);
        HG_STAGE(R1, b1);
        HG_BAR();
        { const int nn = n + 3 < nch ? n + 3 : nch - 1; HG_LOAD(R1, nn); }
        HG_COMPUTE(b1, n + 1);
        HG_STAGE(R0, b0);
        HG_BAR();
    }
#undef HG_LOAD
#undef HG_STAGE
#undef HG_BAR
#undef HG_COMPUTE
    if (!lat) {
        float* so = F.out + OUT_SHG + ((size_t)(sq * 2 + d) * 4 + head) * 128 * 128 + 32 * vs;
        const unsigned sof = (unsigned)(4 * h * 128 + r);
#pragma unroll
        for (int i = 0; i < 4; ++i)
#pragma unroll
            for (int rg = 0; rg < 16; ++rg) __builtin_nontemporal_store(S[i][rg], so + sof + (unsigned)((32 * i + (rg & 3) + 8 * (rg >> 2)) * 128));
    }
}
template <int mode>
DI void hg_scan_lat(Frame& F, int b, int d, int head) {
    const int w = F.wave, r = F.lane & 31, h = F.lane >> 5, vs = w & 3;
    const int base = NCTX + b * TLAT, nch = (mode == 5) ? 8 : TLAT / 32;
    const unsigned lo8 = (unsigned)F.lane * 8u, l16 = (unsigned)F.lane * 16u;
    const unsigned lq = (unsigned)((F.lane >> 4) * 2048 + (F.lane & 15) * 8), lv = (unsigned)((F.lane >> 4) * 512 + (F.lane & 15) * 8);
    LAS unsigned char* b0 = F.lds + RING_OFF; LAS unsigned char* b1 = b0 + HG_GB;
    const int c0 = d ? nch - 1 : 0, cstep = d ? -1 : 1;
    const size_t cb = ((size_t)d * NCH + (base >> 5) + c0) * 4 + head;
    const size_t vbg = ((size_t)((base >> 5) + c0) * 4 + head) * 4;
    struct StageRegs { v4u a, b, c, d; };
    StageRegs R0, R1, R2, R3;
    const int hw = w & 3;
#define HL_LOADH(R, n) do { const int cgx = (base >> 5) + c0 + cstep * (n); const bf16* qb_ = qe_blk(F, d, cgx, head) + lq; const bf16* kb_ = kd_blk(F, d, cgx, head) + lq; \
        R.a = *(const GAS v4u*)(qb_ + (size_t)(8 * hw) * 2048); R.b = *(const GAS v4u*)(qb_ + (size_t)(8 * hw + 4) * 2048); \
        R.c = *(const GAS v4u*)(kb_ + (size_t)(8 * hw) * 2048); R.d = *(const GAS v4u*)(kb_ + (size_t)(8 * hw + 4) * 2048); } while (0)
#define HL_LOADC(R, n) do { const size_t cbx = (size_t)((long)cb + 4 * cstep * (n)); const int cgx = (base >> 5) + c0 + cstep * (n); const bf16* vb_ = vt_blk(F, cgx, head) + lv; \
        R.a = *(const GAS v4u*)(vb_ + (size_t)(8 * w) * 512); R.b = *(const GAS v4u*)(vb_ + (size_t)(8 * w + 4) * 512); \
        R.c = (w == 3) ? *(const GAS v4u*)(F.DEC + cbx * 128 + ((F.lane & 31) * 4)) : *(const GAS v4u*)(F.XF + cbx * 1024 + (w & 1) * 512 + lo8); } while (0)
#define HL_STAGEH(R, bufp) do { \
        *(LAS v4u*)((bufp) + HG_QE + (2 * hw) * 1024 + l16) = R.a; *(LAS v4u*)((bufp) + HG_QE + (2 * hw + 1) * 1024 + l16) = R.b; \
        *(LAS v4u*)((bufp) + HG_KD + (2 * hw) * 1024 + l16) = R.c; *(LAS v4u*)((bufp) + HG_KD + (2 * hw + 1) * 1024 + l16) = R.d; } while (0)
#define HL_STAGEC(R, bufp) do { \
        *(LAS v4u*)((bufp) + HG_VT + (2 * w) * 1024 + l16) = R.a; *(LAS v4u*)((bufp) + HG_VT + (2 * w + 1) * 1024 + l16) = R.b; \
        if (w < 2) *(LAS v4u*)((bufp) + HG_XF + w * 1024 + l16) = R.c; \
        if (w == 3 && F.lane < 32) *(LAS v4u*)((bufp) + HG_DEC + F.lane * 16) = R.c; } while (0)
#define HL_BAR() do { asm volatile("s_waitcnt lgkmcnt(0)" ::: "memory"); __builtin_amdgcn_s_barrier(); asm volatile("" ::: "memory"); } while (0)
#define HL_CL(n) ((n) < nch ? (n) : nch - 1)
    if (w >= 4) {
        HL_LOADH(R0, 0); HL_STAGEH(R0, b0); HL_LOADH(R1, 1); HL_LOADH(R2, 2); HL_LOADH(R3, 3);
        HL_BAR();
        for (int n = 0; n < nch; n += 4) {
            HL_LOADH(R0, HL_CL(n + 4)); HL_STAGEH(R1, b1); HL_BAR();
            HL_LOADH(R1, HL_CL(n + 5)); HL_STAGEH(R2, b0); HL_BAR();
            HL_LOADH(R2, HL_CL(n + 6)); HL_STAGEH(R3, b1); HL_BAR();
            HL_LOADH(R3, HL_CL(n + 7)); HL_STAGEH(R0, b0); HL_BAR();
        }
    } else {
        f32x16 S[4];
        {
            const float* s0 = F.state_hgrn + ((size_t)(b * 2 + d) * 4 + head) * 128 * 128 + 32 * vs;
            const unsigned so = (unsigned)(4 * h * 128 + r);
#pragma unroll
            for (int i = 0; i < 4; ++i)
#pragma unroll
                for (int rg = 0; rg < 16; ++rg) S[i][rg] = s0[so + (unsigned)((32 * i + (rg & 3) + 8 * (rg >> 2)) * 128)];
#pragma unroll
            for (int i = 0; i < 4; ++i)
#pragma unroll
                for (int rg = 0; rg < 16; ++rg) asm volatile("" : "+v"(S[i][rg]));
        }
        const unsigned ooff = (unsigned)(r * 512 + 32 * vs + 4 * h);
        bf16* OUTd = (d ? F.OB : F.OF) + head * 128;
#define HL_COMPUTE(cur, n) do { \
            const int m0 = base + 32 * (c0 + cstep * (n)); \
              \
            const bf16x8 xf0 = *(const LAS bf16x8*)((cur) + HG_XF + l16), xf1 = *(const LAS bf16x8*)((cur) + HG_XF + 1024 + l16); \
            const bf16x8 vf0 = *(const LAS bf16x8*)((cur) + HG_VT + (2 * vs) * 1024 + l16), vf1 = *(const LAS bf16x8*)((cur) + HG_VT + (2 * vs + 1) * 1024 + l16); \
            const LAS float* dc = (const LAS float*)((cur) + HG_DEC) + h * 16; \
            f32x4 dva[4], dvb[4]; \
            _Pragma("unroll") for (int g = 0; g < 4; ++g) dva[g] = *(const LAS f32x4*)(dc + 4 * g); \
            bf16x8 qfr[8], kdr[8]; \
            _Pragma("unroll") for (int i = 0; i < 8; ++i) qfr[i] = *(const LAS bf16x8*)((cur) + HG_QE + i * 1024 + l16); \
            _Pragma("unroll") for (int i = 0; i < 8; ++i) kdr[i] = *(const LAS bf16x8*)((cur) + HG_KD + i * 1024 + l16); \
            __builtin_amdgcn_sched_barrier(0); \
            f32x16 O; \
            _Pragma("unroll") for (int i = 0; i < 16; ++i) O[i] = 0.f; \
            O = MFMA32(vf0, xf0, O); O = MFMA32(vf1, xf1, O); \
            _Pragma("unroll") for (int i = 0; i < 4; ++i) { \
                const bf16x8 sp0 = pack8(S[i], 0), sp1 = pack8(S[i], 1); \
                if (i < 3) { _Pragma("unroll") for (int g = 0; g < 4; ++g) { if (i & 1) dva[g] = *(const LAS f32x4*)(dc + (i + 1) * 32 + 4 * g); else dvb[g] = *(const LAS f32x4*)(dc + (i + 1) * 32 + 4 * g); } } \
                O = MFMA32(sp0, qfr[2 * i], O); O = MFMA32(sp1, qfr[2 * i + 1], O); \
                _Pragma("unroll") for (int g = 0; g < 4; ++g) _Pragma("unroll") for (int j = 0; j < 4; ++j) S[i][4 * g + j] *= ((i & 1) ? dvb[g][j] : dva[g][j]); \
                S[i] = MFMA32(kdr[2 * i], vf0, S[i]); S[i] = MFMA32(kdr[2 * i + 1], vf1, S[i]); } \
            bf16* op = OUTd + (size_t)m0 * 512; \
            _Pragma("unroll") for (int g = 0; g < 4; ++g) { const v2u wv = {pk2(O[4 * g], O[4 * g + 1]), pk2(O[4 * g + 2], O[4 * g + 3])}; *(GAS v2u*)(op + ooff + 8 * g) = wv; } \
        } while (0)
        HL_LOADC(R0, 0); HL_STAGEC(R0, b0); HL_LOADC(R1, 1);
        HL_BAR();
        for (int n = 0; n < nch; n += 2) {
            HL_LOADC(R0, HL_CL(n + 2)); HL_COMPUTE(b0, n);     HL_STAGEC(R1, b1); HL_BAR();
            HL_LOADC(R1, HL_CL(n + 3)); HL_COMPUTE(b1, n + 1); HL_STAGEC(R0, b0); HL_BAR();
        }
#undef HL_COMPUTE
    }
#undef HL_LOADH
#undef HL_LOADC
#undef HL_STAGEH
#undef HL_STAGEC
#undef HL_BAR
#undef HL_CL
}
DI void lru_scan_item(Frame& F, int ss, int d, int cg) {
    const bool lat = ss >= 32;
    const int b = (ss - 32) >> 2, seg = (ss - 32) & 3, j = d ? 3 - seg : seg;
    const int T = 256, base = lat ? NCTX + (ss - 32) * 256 : ss * 256, c = 128 * cg + 2 * F.lane;
    f32x2 hs = {0.f, 0.f}, pp = {1.0f, 1.0f};
    if (lat && j == 0) hs = *(const f32x2*)(F.state_rglru + (size_t)(b * 2 + d) * 512 + c);
    const int t0 = d ? base + T - 1 : base, ts = d ? -1 : 1;
    const unsigned* gp = gates_base(F, d, base); bf16* op = d ? F.HB : F.HF;
    bf16* pcp = F.PC + (size_t)d * 512 - (size_t)NCTX * 1024;
    constexpr int U = 16, NB = 4;
    v2u g[NB][U];
#pragma unroll
    for (int bb = 0; bb < NB; ++bb)
#pragma unroll
        for (int u = 0; u < U; ++u) g[bb][u] = __builtin_nontemporal_load((const v2u*)(gp + (size_t)(t0 + ts * (bb * U + u)) * 512 + c));
#pragma unroll 1
    for (int i0 = 0; i0 < T; i0 += U * NB) {
#pragma unroll
        for (int bb = 0; bb < NB; ++bb) {
#pragma unroll
            for (int u = 0; u < U; ++u) {
                const int t = t0 + ts * (i0 + bb * U + u);
                const v2u w = g[bb][u];
                const f32x2 a = {1.0f - (float)__builtin_bit_cast(_Float16, (unsigned short)(w.x & 0xffffu)), 1.0f - (float)__builtin_bit_cast(_Float16, (unsigned short)(w.y & 0xffffu))};
                const f32x2 uu = {bfhi(w.x), bfhi(w.y)};
                hs = a * hs + uu;
                *(GAS unsigned*)(op + (size_t)t * 512 + c) = pk2(hs.x, hs.y);
                if (lat) { pp = pp * a; *(GAS unsigned*)(pcp + (size_t)t * 1024 + c) = pk2(pp.x, pp.y); }
            }
            if (i0 + U * NB < T) {
#pragma unroll
                for (int u = 0; u < U; ++u) g[bb][u] = __builtin_nontemporal_load((const v2u*)(gp + (size_t)(t0 + ts * (i0 + U * NB + bb * U + u)) * 512 + c));
            }
        }
    }
    if (!lat) *(f32x2*)(F.out + OUT_SLRU + (size_t)(ss * 2 + d) * 512 + c) = hs;
    else *(f32x4*)(F.LC + ((size_t)((b * 2 + d) * 4 + j) * 512 + c) * 2) = (f32x4){pp.x, hs.x, pp.y, hs.y};
}
template <int mode>
DI void p4_scans(Frame& F) {
    for (int wi = (int)blockIdx.x; wi < 256; wi += F.G) {
        if (wi < 160) {
            if ((mode == 8 && wi < 32) || (mode == 9 && wi >= 32)) {
                for (int gi = 0; gi < (wi < 32 ? 1 : 2); ++gi) { const int g = wi < 32 ? wi : 2 * (wi - 32) + gi; const int sq = wi < 32 ? 32 + (g >> 3) : g >> 3, d = (g >> 2) & 1, head = g & 3;
                    const int T = sq >= 32 ? TLAT : TCTX, base = sq >= 32 ? NCTX + (sq - 32) * TLAT : sq * TCTX; bf16* o = (d ? F.OB : F.OF) + head * 128;
                    for (int i = F.tid; i < T * 16; i += 512) *(GAS v4u*)(o + (size_t)(base + (i >> 4)) * 512 + (i & 15) * 8) = (v4u){0u, 0u, 0u, 0u}; }
                continue; }
            if (mode == 2 || (mode == 6 && wi >= 32) || (mode == 7 && wi < 32)) continue;
            if (wi < 32) hg_scan_lat<mode>(F, wi >> 3, (wi >> 2) & 1, wi & 3);
            else { const int gA = 2 * (wi - 32), gB = gA + 1; hg_scan_wg<mode>(F, gA >> 3, (gA >> 2) & 1, gA & 3, gB >> 3, (gB >> 2) & 1, gB & 3); }
        } else {
            if (mode == 1 || mode == 4 || mode == 5 || mode == 6 || mode == 7) continue;
            if (F.wave >= 4) continue;
            const int li = (wi - 160) * 4 + F.wave;
            const int ssx = li >> 3; const int ss = ssx < 16 ? 32 + ssx : ssx - 16;
            lru_scan_item(F, ss, (li >> 2) & 1, li & 3);
        }
    }
}

constexpr int N_PHASES = 11;
struct Args { const float* in[24]; float* out; unsigned char* ws; int ph_lo, ph_hi, li, pad; };
__global__ void __launch_bounds__(NWAVES * 64, 2) mk_fwd(Args args) {
    extern __shared__ __attribute__((aligned(16))) unsigned char lds[];
    Frame F;
    F.lds = (LAS unsigned char*)lds;
    F.tid = threadIdx.x; F.lane = F.tid & 63; F.wave = __builtin_amdgcn_readfirstlane(F.tid >> 6);
    F.G = gridDim.x; { const int bx = blockIdx.x; F.vcu = (F.G % 8 == 0) ? (bx % 8) * (F.G / 8) + bx / 8 : bx; }
    unsigned char* ws = args.ws;
    F.x_prompt = args.in[0]; F.x_sample = args.in[1]; F.cvec = args.in[2]; F.state_hgrn = args.in[3]; F.state_rglru = args.in[4]; F.c_ctx = args.in[5];
    F.w_ada = args.in[6]; F.b_ada = args.in[7]; F.norm1_gain = args.in[8]; F.norm2_gain = args.in[9]; F.w_in = args.in[10]; F.lb_logits = args.in[11];
    F.hg_norm_gain = args.in[12]; F.conv_w = args.in[13]; F.conv_b = args.in[14]; F.lru_wa = args.in[15]; F.lru_ba = args.in[16]; F.lru_wx = args.in[17];
    F.lru_bx = args.in[18]; F.lru_lambda = args.in[19]; F.w_out = args.in[20]; F.w_ff1 = args.in[21]; F.w_ff2 = args.in[22]; F.final_gain = args.in[23];
    F.out = args.out;
    F.Win_t = (bf16*)(ws + WS_WIN); F.Wout_t = (bf16*)(ws + WS_WOUT); F.Wff1_t = (bf16*)(ws + WS_WFF1); F.Wff2_t = (bf16*)(ws + WS_WFF2); F.WL = (bf16*)(ws + WS_WL);
    F.MOD = (float*)(ws + WS_MOD); F.XS = (float*)(ws + WS_XS); F.DEC = (float*)(ws + WS_DEC); F.LC = (float*)(ws + WS_LC); F.PC = (bf16*)(ws + WS_PC); F.XF = (bf16*)(ws + WS_XF);
    F.ACT = (bf16*)(ws + WS_ACT); F.QF = (bf16*)(ws + WS_QF); F.V = (bf16*)(ws + WS_V); F.GL = (bf16*)(ws + WS_GL); F.LX = (bf16*)(ws + WS_LX);
    F.QE = (bf16*)(ws + WS_QE); F.KE = (bf16*)(ws + WS_KE); F.KDT = (bf16*)(ws + WS_KDT); F.VT = (bf16*)(ws + WS_VT);
    F.OF = (bf16*)(ws + WS_OF); F.OB = (bf16*)(ws + WS_OB); F.HF = (bf16*)(ws + WS_HF); F.HB = (bf16*)(ws + WS_HB); F.HID = (bf16*)(ws + WS_HID);
    volatile LAS unsigned* MISC = (volatile LAS unsigned*)(F.lds + LDSCTL_OFF);
    for (int u = F.tid; u < 128; u += NWAVES * 64) MISC[u] = 0u;
    __syncthreads();
    const int lo = args.ph_lo, hi = args.ph_hi;
    XcdBarrier bar; bar.bar = (unsigned*)(ws + WS_CTL); bar.x = 0; bar.st = nullptr;
    if (hi - lo > 1) bar = xcd_barrier_post((unsigned*)(ws + WS_CTL), MISC + 8);
#define IN(k) (lo <= (k) && (k) < hi)
#define SEAM(k) do { if (IN(k) && IN((k) + 1)) xcd_barrier(bar); } while (0)
#ifndef RPT
#define RPT -1
#endif
#define NREP(k) ((RPT == (k)) ? 2 : 1)
#ifndef RPTMODE
#define RPTMODE 0
#endif

#ifdef TSEL
#ifndef TOFF
#define TOFF 0
#endif
#ifndef TWID
#define TWID 8
#endif
    unsigned long long tprev = __builtin_amdgcn_s_memrealtime(); float tsel_us = 0.f;
#define TSTAMP(k) do { const unsigned long long tn = __builtin_amdgcn_s_memrealtime(); if ((k) == TSEL) tsel_us = (float)(tn - tprev) * 0.01f; tprev = tn; } while (0)
#else
#define TSTAMP(k) do { } while (0)
#endif
    if (IN(0)) { for (int rp = 0; rp < NREP(0); ++rp) { p0_prologue(F); __syncthreads(); } } SEAM(0); TSTAMP(0);
    if (IN(1)) { for (int rp = 0; rp < NREP(1); ++rp) p1_rows(F); } SEAM(1); TSTAMP(1);
    if (IN(2)) for (int rp = 0; rp < NREP(2); ++rp) {
        pg8::Gemm g{F.ACT, F.Win_t, NTOK, INC, D}; pg8::StaticOrder S; S.init(NTOK, INC, F.G, (int)blockIdx.x);
        pg8::EpiRoute E{F.QF, F.V, F.GL, F.LX};
        pg8::gemm_phase<pg8::EpiRoute, pg8::StaticOrder, PG8_ALIGN, PG8_SP2>(F.lds + RING_OFF, g, S, E);
    } SEAM(2); TSTAMP(2);
    if (IN(3)) { for (int rp = 0; rp < NREP(3); ++rp) p3_prep(F, rp ? RPTMODE : 0); } SEAM(3); TSTAMP(3);
#ifndef P4X
#define P4X 0
#endif
    if (IN(4)) { p4_scans<(P4X == 1 ? 1 : P4X == 2 ? 8 : P4X == 4 ? 9 : 0)>(F); if (RPT == 4) p4_scans<RPTMODE>(F); } SEAM(4); TSTAMP(4);
    if (IN(5)) { for (int rp = 0; rp < NREP(5); ++rp) p5_rows(F); } SEAM(5); TSTAMP(5);
    const bool fused_rms = (F.G == 256);
    float* xr = (float*)(ws + WS_XRMS); unsigned* rcnt = (unsigned*)(ws + WS_CTL) + CW_RMSCNT;
    if (IN(6)) {
        pg8::Gemm g{F.ACT, F.Wout_t, NTOK, D, D}; pg8::StaticOrder S; S.init(NTOK, D, F.G, (int)blockIdx.x, 192);
        if (fused_rms) { pg8::EpiRmsT<3, 0> E{F.x_prompt, F.x_sample, F.out, F.MOD + 2048, F.norm2_gain, F.MOD, F.ACT, xr, rcnt, (bf16*)(ws + WS_X1B)};
            pg8::gemm_phase<pg8::EpiRmsT<3, 0>, pg8::StaticOrder, PG8_ALIGN, PG8_SP2, 3>(F.lds + RING_OFF, g, S, E); }
        else { pg8::EpiResidT<3> E{F.x_prompt, F.XS, F.out, F.MOD + 2048};
            pg8::gemm_phase<pg8::EpiResidT<3>, pg8::StaticOrder, PG8_ALIGN, PG8_SP2, 3>(F.lds + RING_OFF, g, S, E); }
    } SEAM(6); TSTAMP(6);
    if (IN(7) && !fused_rms) { p7_rows(F); if (IN(8)) xcd_barrier(bar); } TSTAMP(7);
    if (IN(8)) for (int rp = 0; rp < NREP(8); ++rp) {
        pg8::Gemm g{F.ACT, F.Wff1_t, NTOK, DFF, D}; pg8::StaticOrder S; S.init(NTOK, DFF, F.G, (int)blockIdx.x);
        pg8::EpiRelu2 E{F.HID, DFF};
        pg8::gemm_phase<pg8::EpiRelu2, pg8::StaticOrder, PG8_ALIGN, PG8_SP2>(F.lds + RING_OFF, g, S, E);
    } SEAM(8); TSTAMP(8);
#if RPT == 9 || RPT == 6
    if (IN(RPT)) {
        pg8::Gemm g{RPT == 9 ? F.HID : F.ACT, RPT == 9 ? F.Wff2_t : F.Wout_t, NTOK, D, RPT == 9 ? DFF : D}; pg8::StaticOrder S; S.init(NTOK, D, F.G, (int)blockIdx.x);
        pg8::EpiResid E{F.out, F.out + (size_t)NCTX * D, (float*)(ws + WS_QE), F.MOD + 5120};
        pg8::gemm_phase<pg8::EpiResid, pg8::StaticOrder, PG8_ALIGN, PG8_SP2>(F.lds + RING_OFF, g, S, E);
    }
#endif
    if (IN(9)) {
        pg8::Gemm g{F.HID, F.Wff2_t, NTOK, D, DFF}; pg8::StaticOrder S; S.init(NTOK, D, F.G, (int)blockIdx.x, 192);
        if (fused_rms) { pg8::EpiRmsT<3, 1> E{F.out, F.out + (size_t)NCTX * D, F.out, F.MOD + 5120, F.final_gain, F.MOD, F.ACT, xr + (size_t)NTOK * 4, rcnt + 64 * 16, (bf16*)(ws + WS_X1B)};
            pg8::gemm_phase<pg8::EpiRmsT<3, 1>, pg8::StaticOrder, PG8_ALIGN, PG8_SP2, 3>(F.lds + RING_OFF, g, S, E); }
        else { pg8::EpiResidT<3> E{F.out, F.out + (size_t)NCTX * D, F.out, F.MOD + 5120};
            pg8::gemm_phase<pg8::EpiResidT<3>, pg8::StaticOrder, PG8_ALIGN, PG8_SP2, 3>(F.lds + RING_OFF, g, S, E); }
    }
    if (!fused_rms) { SEAM(9); } TSTAMP(9);
    if (IN(10) && !fused_rms) { p10_rows(F); }
#ifdef TSEL
    if (hi - lo > 1) {
        xcd_barrier(bar); TSTAMP(10);
        float* tw = (float*)(ws + WS_CTL + 32768);
        if (blockIdx.x == 0 && F.tid == 0) { __hip_atomic_store(tw, floorf((tsel_us + (float)TOFF) * (1.0f / (float)TWID)), __ATOMIC_RELAXED, __HIP_MEMORY_SCOPE_AGENT); }
        xcd_barrier(bar);
        const float sc = 1.0f + __hip_atomic_load(tw, __ATOMIC_RELAXED, __HIP_MEMORY_SCOPE_AGENT) * (1.0f / 64.0f);
        for (size_t i = (size_t)blockIdx.x * 512 + F.tid; i < (size_t)NTOK * 256; i += (size_t)F.G * 512) { f32x4 v = ((f32x4*)F.out)[i]; ((f32x4*)F.out)[i] = v * sc; }
        if (blockIdx.x == 0 && F.tid == 0) F.out[0] = 100.0f * (sc - 1.0f) * 64.0f;
    }
#endif
#undef IN
#undef SEAM
}

extern "C" void kernel_launch(void* const* d_in, const int* in_sizes, int n_in, void* d_out, int out_size, void* d_ws, size_t ws_size, hipStream_t stream) {
    static int grid = 0;
    if (grid == 0) {
        if (n_in != 24 || in_sizes[0] != NCTX * D || ws_size < WS_END) { fprintf(stderr, "kernel_launch: unexpected shapes (n_in %d, in0 %d, out %d, ws %zu)\n", n_in, n_in > 0 ? in_sizes[0] : -1, out_size, ws_size); grid = -1; return; }
        int dev = 0, cus = 0, per_cu = 0;
        if (hipGetDevice(&dev) != hipSuccess || hipDeviceGetAttribute(&cus, hipDeviceAttributeMultiprocessorCount, dev) != hipSuccess) { grid = -1; return; }
        if (hipFuncSetAttribute((const void*)mk_fwd, hipFuncAttributeMaxDynamicSharedMemorySize, LDS_BYTES) != hipSuccess) { fprintf(stderr, "kernel_launch: hipFuncSetAttribute failed\n"); grid = -1; return; }
        if (hipOccupancyMaxActiveBlocksPerMultiprocessor(&per_cu, (const void*)mk_fwd, NWAVES * 64, LDS_BYTES) != hipSuccess || per_cu < 1)
            fprintf(stderr, "kernel_launch: occupancy query reports %d workgroups per CU\n", per_cu);
        (void)hipGetLastError();
        grid = cus;
    }
    if (grid < 0) return;
    if (hipMemsetAsync((char*)d_ws + WS_CTL, 0, CTL_ZERO_BYTES, stream) != hipSuccess) return;
    Args a{};
    for (int i = 0; i < 24; ++i) a.in[i] = (const float*)d_in[i];
    a.out = (float*)d_out; a.ws = (unsigned char*)d_ws;
    constexpr int NL = MK_N_LAUNCHES;
    for (int li = 0; li < NL; ++li) {
        a.ph_lo = (NL == 1) ? 0 : li; a.ph_hi = (NL == 1) ? N_PHASES : li + 1; a.li = li;
        hipLaunchKernelGGL(mk_fwd, dim3(grid), dim3(NWAVES * 64), LDS_BYTES, stream, a);
    }
}
```
